# Optimizing an MI355X kernel written in HIP

```python
import math
import jax, jax.numpy as jnp
from jax import lax
import numpy as np

D_MODEL = 1024
BATCH = 2
SEQ = 8192
DEPTH = 1

CHUNK = 64
LEFT_CHUNKS = 8
BAND = LEFT_CHUNKS + 1
ATTN_HEADS = 8
HEAD_DIM = 64
ATTN_WIDTH = ATTN_HEADS * HEAD_DIM
REL_MAX = 256
REL_SIZE = (CHUNK - 1) + REL_MAX + 1
SSM_WIDTH = D_MODEL // 2
SSM_GROUP = 16
SSM_GROUPS = SSM_WIDTH // SSM_GROUP
SSM_STATE = 64
DT_MIN = 0.001
DT_MAX = 0.1
N_BRANCHES = 2
IN_WIDTH = 3 * ATTN_WIDTH + SSM_WIDTH + N_BRANCHES * D_MODEL
N_EXPERTS = 32
TOP_K = 4
D_EXPERT = D_MODEL
SWIGLU_LIMIT = 7.0
SWIGLU_ALPHA = 1.702
EXPERT_BLOCK = 256
LN_EPS = 1e-5
DEEPNORM_ALPHA = (2 * DEPTH) ** 0.25
DEEPNORM_BETA = (8 * DEPTH) ** -0.25
NEG_INF = -1e30

kernel_name = "streaming_hybrid_relattn_s5_moe"


def layer_norm(x, g, b):
    xf = x.astype(jnp.float32)
    mu = jnp.mean(xf, axis=-1, keepdims=True)
    var = jnp.mean(jnp.square(xf - mu), axis=-1, keepdims=True)
    y = (xf - mu) * lax.rsqrt(var + LN_EPS) * g.astype(jnp.float32) + b.astype(jnp.float32)
    return y.astype(x.dtype)


def chunked_rel_attention(q, k, v, rel_bias):
    bsz, s, _ = q.shape
    nc = s // CHUNK
    shp = (bsz, nc, CHUNK, ATTN_HEADS, HEAD_DIM)
    q = q.reshape(shp) * (HEAD_DIM ** -0.5)
    k = k.reshape(shp)
    v = v.reshape(shp)
    pad = ((0, 0), (LEFT_CHUNKS, 0), (0, 0), (0, 0), (0, 0))
    k_pad = jnp.pad(k, pad)
    v_pad = jnp.pad(v, pad)
    k_band = jnp.concatenate([k_pad[:, j:j + nc] for j in range(BAND)], axis=2)
    v_band = jnp.concatenate([v_pad[:, j:j + nc] for j in range(BAND)], axis=2)
    qc = jnp.arange(CHUNK)[:, None]
    kk = jnp.arange(BAND * CHUNK)[None, :]
    dist = qc - (kk - LEFT_CHUNKS * CHUNK)
    idx = jnp.clip(dist, -(CHUNK - 1), REL_MAX) + (CHUNK - 1)
    bias = rel_bias.astype(jnp.float32)[:, idx]
    key_chunk = jnp.arange(nc)[:, None] - LEFT_CHUNKS + jnp.arange(BAND * CHUNK)[None, :] // CHUNK
    valid = key_chunk >= 0
    scores = jnp.einsum('bnqhd,bnkhd->bnhqk', q, k_band,
                        preferred_element_type=jnp.float32) + bias[None, None]
    scores = jnp.where(valid[None, :, None, None, :], scores, NEG_INF)
    p = jax.nn.softmax(scores, axis=-1).astype(v.dtype)
    o = jnp.einsum('bnhqk,bnkhd->bnqhd', p, v_band)
    return o.reshape(bsz, s, ATTN_WIDTH)


def s5_ssm(u, lam_re, lam_im, log_dt, b_re, b_im, c_re, c_im, d_skip):
    bsz, s, _ = u.shape
    f32 = jnp.float32
    uf = u.astype(f32).reshape(bsz, s, SSM_GROUPS, SSM_GROUP)
    lam = lax.complex(lam_re.astype(f32), lam_im.astype(f32))
    dt = jnp.exp(log_dt.astype(f32))[:, None]
    lam_bar = jnp.exp(lam * dt)
    b_mat = lax.complex(b_re.astype(f32), b_im.astype(f32))
    b_bar = ((lam_bar - 1.0) / lam)[..., None] * b_mat
    c_mat = lax.complex(c_re.astype(f32), c_im.astype(f32))
    bu = jnp.einsum('bsgc,gpc->bsgp', uf.astype(jnp.complex64), b_bar)
    a = jnp.broadcast_to(lam_bar, bu.shape)

    def combine(e1, e2):
        a1, x1 = e1
        a2, x2 = e2
        return a1 * a2, a2 * x1 + x2

    _, states = lax.associative_scan(combine, (a, bu), axis=1)
    y = jnp.einsum('bsgp,gcp->bsgc', states, c_mat).real
    y = y + d_skip.astype(f32).reshape(SSM_GROUPS, SSM_GROUP) * uf
    return y.reshape(bsz, s, SSM_WIDTH).astype(u.dtype)


def moe_ffn(h, router_w, router_b, w_gate_up, b_gate_up, w_down, b_down):
    bsz, s, d = h.shape
    t = bsz * s
    hf = h.reshape(t, d)
    logits = (hf @ router_w + router_b).astype(jnp.float32)
    top_vals, top_idx = lax.top_k(logits, TOP_K)
    gates = jax.nn.softmax(top_vals, axis=-1)
    n_assign = t * TOP_K
    flat_e = top_idx.reshape(-1)
    flat_tok = jnp.repeat(jnp.arange(t, dtype=jnp.int32), TOP_K)
    flat_g = gates.reshape(-1)
    order = jnp.argsort(flat_e)
    sorted_e = flat_e[order]
    counts = jnp.bincount(flat_e, length=N_EXPERTS)
    starts = jnp.cumsum(counts) - counts
    padded = ((counts + EXPERT_BLOCK - 1) // EXPERT_BLOCK) * EXPERT_BLOCK
    pends = jnp.cumsum(padded)
    pstarts = pends - padded
    rank = jnp.arange(n_assign) - starts[sorted_e]
    dest = pstarts[sorted_e] + rank
    n_rows = ((n_assign + N_EXPERTS * EXPERT_BLOCK + EXPERT_BLOCK - 1) // EXPERT_BLOCK) * EXPERT_BLOCK
    n_blocks = n_rows // EXPERT_BLOCK
    tok_pad = jnp.full((n_rows,), t, jnp.int32).at[dest].set(flat_tok[order])
    gate_pad = jnp.zeros((n_rows,), jnp.float32).at[dest].set(flat_g[order])
    blk_start = jnp.arange(n_blocks) * EXPERT_BLOCK
    blk_expert = jnp.minimum(jnp.searchsorted(pends, blk_start, side='right'), N_EXPERTS - 1)
    x_tok = jnp.concatenate([hf, jnp.zeros((1, d), hf.dtype)], axis=0)
    xb = x_tok[tok_pad].reshape(n_blocks, EXPERT_BLOCK, d)

    def expert_block(args):
        xblk, e = args
        gu = xblk @ w_gate_up[e] + b_gate_up[e]
        x_glu, x_lin = jnp.split(gu, 2, axis=-1)
        x_glu = jnp.minimum(x_glu, SWIGLU_LIMIT)
        x_lin = jnp.clip(x_lin, -SWIGLU_LIMIT, SWIGLU_LIMIT)
        act = x_glu * jax.nn.sigmoid(SWIGLU_ALPHA * x_glu) * (x_lin + 1.0)
        return act @ w_down[e] + b_down[e]

    yb = lax.map(expert_block, (xb, blk_expert)).reshape(n_rows, d)
    y = jnp.zeros((t + 1, d), yb.dtype).at[tok_pad].add(yb * gate_pad[:, None].astype(yb.dtype))
    return y[:t].reshape(bsz, s, d)


def setup_inputs(seed: int = 0) -> dict:
    key = jax.random.key(seed)
    ks = jax.random.split(key, 32)
    f32 = jnp.float32

    def nrm(k, shape, scale):
        return jax.random.normal(k, shape, f32) * scale

    L, D, E = DEPTH, D_MODEL, N_EXPERTS
    G, P, Hg = SSM_GROUPS, SSM_STATE, SSM_GROUP
    lam_im0 = jnp.pi * jnp.arange(P, dtype=f32)
    return {
        'x': nrm(ks[0], (BATCH, SEQ, D), 1.0),
        'ln_in_g': 1.0 + nrm(ks[1], (D,), 0.02),
        'ln_in_b': nrm(ks[2], (D,), 0.02),
        'w_in': nrm(ks[3], (L, D, IN_WIDTH), D ** -0.5),
        'b_gate': nrm(ks[4], (L, N_BRANCHES * D), 0.02),
        'rel_bias': nrm(ks[5], (L, ATTN_HEADS, REL_SIZE), 0.2),
        'lam_re': -0.5 + nrm(ks[6], (L, G, P), 0.01),
        'lam_im': lam_im0 + nrm(ks[7], (L, G, P), 0.01),
        'log_dt': jax.random.uniform(ks[8], (L, G), f32, math.log(DT_MIN), math.log(DT_MAX)),
        'ssm_b_re': nrm(ks[9], (L, G, P, Hg), (2 * Hg) ** -0.5),
        'ssm_b_im': nrm(ks[10], (L, G, P, Hg), (2 * Hg) ** -0.5),
        'ssm_c_re': nrm(ks[11], (L, G, Hg, P), (2 * P) ** -0.5),
        'ssm_c_im': nrm(ks[12], (L, G, Hg, P), (2 * P) ** -0.5),
        'ssm_d': nrm(ks[13], (L, SSM_WIDTH), 1.0),
        'w_glu': nrm(ks[14], (L, SSM_WIDTH, 2 * SSM_WIDTH), SSM_WIDTH ** -0.5),
        'w_up_attn': nrm(ks[15], (L, ATTN_WIDTH, D), ATTN_WIDTH ** -0.5),
        'w_up_ssm': nrm(ks[16], (L, SSM_WIDTH, D), SSM_WIDTH ** -0.5),
        'w_o': nrm(ks[17], (L, D, D), DEEPNORM_BETA * D ** -0.5),
        'ln1_g': 1.0 + nrm(ks[18], (L, D), 0.02),
        'ln1_b': nrm(ks[19], (L, D), 0.02),
        'router_w': nrm(ks[20], (L, D, E), D ** -0.5),
        'router_b': nrm(ks[21], (L, E), 0.01),
        'w_gate_up': nrm(ks[22], (L, E, D, 2 * D_EXPERT), D ** -0.5),
        'b_gate_up': nrm(ks[23], (L, E, 2 * D_EXPERT), 0.01),
        'w_down': nrm(ks[24], (L, E, D_EXPERT, D), DEEPNORM_BETA * D_EXPERT ** -0.5),
        'b_down': nrm(ks[25], (L, E, D), 0.01),
        'ln2_g': 1.0 + nrm(ks[26], (L, D), 0.02),
        'ln2_b': nrm(ks[27], (L, D), 0.02),
    }


def reference(x, ln_in_g, ln_in_b, w_in, b_gate, rel_bias, lam_re, lam_im, log_dt,
              ssm_b_re, ssm_b_im, ssm_c_re, ssm_c_im, ssm_d, w_glu, w_up_attn, w_up_ssm,
              w_o, ln1_g, ln1_b, router_w, router_b, w_gate_up, b_gate_up, w_down, b_down,
              ln2_g, ln2_b):
    splits = [ATTN_WIDTH, 2 * ATTN_WIDTH, 3 * ATTN_WIDTH, 3 * ATTN_WIDTH + SSM_WIDTH]
    h = layer_norm(x, ln_in_g, ln_in_b)
    for l in range(DEPTH):
        proj = h @ w_in[l]
        q, k, v, u, gate_logits = jnp.split(proj, splits, axis=-1)
        gates = jax.nn.sigmoid(gate_logits + b_gate[l])
        g_attn, g_ssm = jnp.split(gates, 2, axis=-1)
        y_attn = chunked_rel_attention(q, k, v, rel_bias[l]) @ w_up_attn[l]
        y_s = s5_ssm(u, lam_re[l], lam_im[l], log_dt[l], ssm_b_re[l], ssm_b_im[l],
                     ssm_c_re[l], ssm_c_im[l], ssm_d[l])
        glu_a, glu_b = jnp.split(jax.nn.gelu(y_s) @ w_glu[l], 2, axis=-1)
        y_ssm = (glu_a * jax.nn.sigmoid(glu_b)) @ w_up_ssm[l]
        mix = (g_attn * y_attn + g_ssm * y_ssm) @ w_o[l]
        h = layer_norm(DEEPNORM_ALPHA * h + mix, ln1_g[l], ln1_b[l])
        ffn = moe_ffn(h, router_w[l], router_b[l], w_gate_up[l], b_gate_up[l],
                      w_down[l], b_down[l])
        h = layer_norm(DEEPNORM_ALPHA * h + ffn, ln2_g[l], ln2_b[l])
    return h
```

```cpp
#include <hip/hip_runtime.h>
#include <cstdio>
#include <cstdint>

#ifndef MK_ONE_LAUNCH
#define MK_ONE_LAUNCH 0
#endif

#define GAS __attribute__((address_space(1)))
#define LAS __attribute__((address_space(3)))
typedef unsigned short bf16_t;
typedef short bf16x8 __attribute__((ext_vector_type(8)));
typedef float f32x4 __attribute__((ext_vector_type(4)));
typedef unsigned u32x4 __attribute__((ext_vector_type(4)));
typedef unsigned u32x2 __attribute__((ext_vector_type(2)));

constexpr int BATCH = 2, SEQ = 8192, T = BATCH * SEQ, DM = 1024;
constexpr int CHUNK = 64, LEFT = 8, NCH = SEQ / CHUNK;
constexpr int NH = 8, HD = 64, AW = 512, RELMAX = 256, RELSIZE = 320;
constexpr int SW = 512, GSZ = 16, NG = 32, NP = 64;
constexpr int INW = 4096;
constexpr int NE = 32, TOPK = 4, DE = 1024, EB = 256;
constexpr int NASSIGN = T * TOPK;
constexpr int NROWS = NASSIGN + NE * EB;
constexpr float LN_EPS = 1e-5f;
constexpr float ALPHA = 1.189207115002721f;
constexpr float SWIGLU_LIMIT = 7.0f, SWIGLU_ALPHA = 1.702f;
constexpr int NWAVES = 8;

constexpr size_t MiB = 1u << 20;
constexpr size_t WS_CTL = 0, CTL_ZERO_BYTES = 1 * MiB;
constexpr size_t WS_H0 = 1 * MiB;
constexpr size_t WS_Q = 33 * MiB;
constexpr size_t WS_K = 49 * MiB;
constexpr size_t WS_V = 65 * MiB;
constexpr size_t WS_U = 81 * MiB;
constexpr size_t WS_GA = 97 * MiB;
constexpr size_t WS_GS = 129 * MiB;
constexpr size_t WS_AO = 161 * MiB;
constexpr size_t WS_GY = 177 * MiB;
constexpr size_t WS_SG = 193 * MiB;
constexpr size_t WS_Y = 209 * MiB;
constexpr size_t WS_R1 = 241 * MiB;
constexpr size_t WS_H1 = 305 * MiB;
constexpr size_t WS_TOPI = 338 * MiB;
constexpr size_t WS_TOPG = 339 * MiB;
constexpr size_t WS_DEST = 340 * MiB;
constexpr size_t WS_TOK = 341 * MiB;
constexpr size_t WS_ACT = 342 * MiB;
constexpr size_t WS_OUTS = 486 * MiB;
constexpr size_t WS_END = 630 * MiB;
constexpr int CW_COUNTS = 64, CW_CURSOR = 128;
constexpr int CW_BAR = 4096;

__device__ __forceinline__ unsigned f2bf(float f) { unsigned u = __float_as_uint(f); return (u + 0x7fffu + ((u >> 16) & 1u)) >> 16; }
__device__ __forceinline__ float bf2f(unsigned h) { return __uint_as_float(h << 16); }
__device__ __forceinline__ unsigned pk2(float lo, float hi) { return f2bf(lo) | (f2bf(hi) << 16); }
__device__ __forceinline__ float wave_sum(float v) {
#pragma unroll
    for (int o = 1; o < 64; o <<= 1) v += __shfl_xor(v, o);
    return v;
}
__device__ __forceinline__ float sigmoid_f(float x) { return 1.f / (1.f + __expf(-x)); }
__device__ __forceinline__ float gelu_tanh(float x) { const float z = 0.7978845608028654f * (x + 0.044715f * x * x * x); return x * sigmoid_f(2.f * z); }

__device__ __forceinline__ void sincos_d(double x, double& s, double& c) {
    const double kd = rint(x * 0.63661977236758134308);
    const int k = (int)kd;
    double r = fma(-kd, 1.57079632679489655800e+00, x);
    r = fma(-kd, 6.12323399573676603587e-17, r);
    const double r2 = r * r;
    double sp = -1.0 / 1307674368000.0;
    sp = sp * r2 + 1.0 / 6227020800.0; sp = sp * r2 - 1.0 / 39916800.0; sp = sp * r2 + 1.0 / 362880.0; sp = sp * r2 - 1.0 / 5040.0; sp = sp * r2 + 1.0 / 120.0; sp = sp * r2 - 1.0 / 6.0;
    sp = r + r * r2 * sp;
    double cp = -1.0 / 87178291200.0;
    cp = cp * r2 + 1.0 / 479001600.0; cp = cp * r2 - 1.0 / 3628800.0; cp = cp * r2 + 1.0 / 40320.0; cp = cp * r2 - 1.0 / 720.0; cp = cp * r2 + 1.0 / 24.0; cp = cp * r2 - 0.5;
    cp = 1.0 + r2 * cp;
    const int q = k & 3;
    s = (q == 0) ? sp : (q == 1) ? cp : (q == 2) ? -sp : -cp;
    c = (q == 0) ? cp : (q == 1) ? -sp : (q == 2) ? -cp : sp;
}

#define XB_TMO      128
#define XB_XCNT(j)  (256  + 64 * (j))
#define XB_XSUB(j)  (1280 + 64 * (j))
#define XB_XGEN(j)  (2304 + 64 * (j))
#define XB_TOP      3328
#define XB_TOPGEN   3392
#define XCD_BAR_WORDS 3456
#define XB_SPIN_CAP (1u << 22)
__device__ __forceinline__ unsigned xb_ld(unsigned* p)              { return __hip_atomic_load(p, __ATOMIC_RELAXED, __HIP_MEMORY_SCOPE_AGENT); }
__device__ __forceinline__ unsigned xb_add(unsigned* p, unsigned v) { return __hip_atomic_fetch_add(p, v, __ATOMIC_RELAXED, __HIP_MEMORY_SCOPE_AGENT); }
__device__ __forceinline__ unsigned xb_xcc_id() { return (unsigned)__builtin_amdgcn_s_getreg((3 << 11) | 20) & 0xFu; }
#define XB_SPIN(cond, bar) do { unsigned _sp = 0; while (cond) { __builtin_amdgcn_s_sleep(1); \
    if ((++_sp & 255u) == 0u) { if (xb_ld(&(bar)[XB_TMO])) break; if (_sp > XB_SPIN_CAP) { atomicAdd(&(bar)[XB_TMO], 1u); break; } } } } while (0)
struct XcdBarrier { unsigned* bar; unsigned x; volatile LAS unsigned* st; };
__device__ __forceinline__ XcdBarrier xcd_barrier_post(unsigned* bar, volatile LAS unsigned* st) {
    XcdBarrier b; b.bar = bar; b.x = xb_xcc_id(); b.st = st;
    if (threadIdx.x == 0) (void)xb_add(&bar[XB_XCNT(b.x)], 1u);
    return b;
}
__device__ __forceinline__ void xcd_barrier_complete(unsigned* bar, unsigned x, unsigned& nloc, unsigned& nx) {
    const unsigned G = gridDim.x * gridDim.y * gridDim.z;
    unsigned sum, cnt, mine, sp = 0u;
    for (;;) {
        sum = 0u; cnt = 0u; mine = 0u;
#pragma unroll
        for (unsigned j = 0; j < 16; ++j) { const unsigned c = xb_ld(&bar[XB_XCNT(j)]); sum += c; cnt += (c > 0u) ? 1u : 0u; mine = (j == x) ? c : mine; }
        if (sum == G) break;
        __builtin_amdgcn_s_sleep(1);
        if ((++sp & 255u) == 0u) { if (xb_ld(&bar[XB_TMO])) break; if (sp > XB_SPIN_CAP) { atomicAdd(&bar[XB_TMO], 1u); break; } }
    }
    nloc = mine > 0u ? mine : 1u; nx = cnt > 0u ? cnt : 1u;
}
__device__ __forceinline__ void xcd_barrier(const XcdBarrier& b) {
    asm volatile("s_waitcnt vmcnt(0)" ::: "memory");
    __syncthreads();
    if (threadIdx.x == 0) {
        unsigned* bar = b.bar;
        __builtin_amdgcn_s_waitcnt(0);
        unsigned nloc = b.st[0], nx = b.st[1];
        if (nloc == 0u) { xcd_barrier_complete(bar, b.x, nloc, nx); b.st[0] = nloc; b.st[1] = nx; }
        const unsigned old = xb_add(&bar[XB_XSUB(b.x)], 1u);
        const unsigned gen = old / nloc;
        if (old + 1u == (gen + 1u) * nloc) {
            __builtin_amdgcn_fence(__ATOMIC_RELEASE, "agent");
            asm volatile("s_waitcnt vmcnt(0)" ::: "memory");
            const unsigned og = xb_add(&bar[XB_TOP], 1u);
            const unsigned tg = og / nx;
            if (og + 1u == (tg + 1u) * nx) xb_add(&bar[XB_TOPGEN], 1u);
            else XB_SPIN(xb_ld(&bar[XB_TOPGEN]) == tg, bar);
            __builtin_amdgcn_fence(__ATOMIC_ACQUIRE, "agent");
            xb_add(&bar[XB_XGEN(b.x)], 1u);
            asm volatile("s_waitcnt vmcnt(0)" ::: "memory");
        } else {
            XB_SPIN(xb_ld(&bar[XB_XGEN(b.x)]) == gen, bar);
            __builtin_amdgcn_fence(__ATOMIC_ACQUIRE, "agent");
            asm volatile("s_waitcnt vmcnt(0)" ::: "memory");
        }
    }
    __syncthreads();
}

struct Args {
    const float* in[28];
    float* out; unsigned char* ws;
    int ph_lo, ph_hi;
};
enum { I_X = 0, I_LNIG, I_LNIB, I_WIN, I_BGATE, I_RELB, I_LAMRE, I_LAMIM, I_LOGDT, I_BRE, I_BIM, I_CRE, I_CIM, I_SSMD, I_WGLU, I_WUA, I_WUS, I_WO,
       I_LN1G, I_LN1B, I_RW, I_RB, I_WGU, I_BGU, I_WD, I_BD, I_LN2G, I_LN2B };

struct Frame {
    LAS unsigned char* lds;
    int tid, lane, wave, G, gw, NGW;
    const float* const* in;
    float* out; unsigned char* ws;
    unsigned* ctl;
};

template <int PS> __device__ __forceinline__ int colbase(int tn, int wc) { return PS == 16 ? tn * 128 + wc * 32 : tn * 64 + wc * 16; }

template <int PS, class Cfg>
__device__ __forceinline__ void gemm_simple_tile(const Frame& F, const Cfg& c, int tm, int tn) {
    LAS bf16_t* As = (LAS bf16_t*)F.lds;
    LAS bf16_t* Bs = As + 128 * 40;
    const int tid = F.tid, lane = F.lane, w = F.wave, wr = w >> 2, wc = w & 3;
    f32x4 acc[4][2];
#pragma unroll
    for (int m = 0; m < 4; ++m)
#pragma unroll
        for (int n = 0; n < 2; ++n) acc[m][n] = (f32x4){0.f, 0.f, 0.f, 0.f};
    const int ar = tid >> 2, ak = (tid & 3) * 8;
    const bf16_t* ap = c.arow(tm * 128 + ar) + ak;
    const int bk = tid >> 4, bc = (tid & 15) * 8;
    const int pc = colbase<PS>(tn, bc >> 5) + ((bc >> 4) & 1) * PS + (bc & 15);
    const int ldb = c.ldb();
    const float* bp = c.bptr(tm) + (size_t)bk * ldb + pc;
    const int K = c.K();
    for (int k0 = 0; k0 < K; k0 += 32) {
        const u32x4 av = *(const u32x4*)(ap + k0);
        const f32x4 b0 = *(const f32x4*)(bp + (size_t)k0 * ldb), b1 = *(const f32x4*)(bp + (size_t)k0 * ldb + 4);
        __syncthreads();
        *(LAS u32x4*)(As + ar * 40 + ak) = av;
        Bs[(bc + 0) * 40 + bk] = (bf16_t)f2bf(b0[0]); Bs[(bc + 1) * 40 + bk] = (bf16_t)f2bf(b0[1]);
        Bs[(bc + 2) * 40 + bk] = (bf16_t)f2bf(b0[2]); Bs[(bc + 3) * 40 + bk] = (bf16_t)f2bf(b0[3]);
        Bs[(bc + 4) * 40 + bk] = (bf16_t)f2bf(b1[0]); Bs[(bc + 5) * 40 + bk] = (bf16_t)f2bf(b1[1]);
        Bs[(bc + 6) * 40 + bk] = (bf16_t)f2bf(b1[2]); Bs[(bc + 7) * 40 + bk] = (bf16_t)f2bf(b1[3]);
        __syncthreads();
        bf16x8 a[4], b[2];
#pragma unroll
        for (int m = 0; m < 4; ++m) a[m] = *(const LAS bf16x8*)(As + (wr * 64 + m * 16 + (lane & 15)) * 40 + (lane >> 4) * 8);
#pragma unroll
        for (int n = 0; n < 2; ++n) b[n] = *(const LAS bf16x8*)(Bs + (wc * 32 + n * 16 + (lane & 15)) * 40 + (lane >> 4) * 8);
#pragma unroll
        for (int m = 0; m < 4; ++m)
#pragma unroll
            for (int n = 0; n < 2; ++n) acc[m][n] = __builtin_amdgcn_mfma_f32_16x16x32_bf16(a[m], b[n], acc[m][n], 0, 0, 0);
    }
    const int col0 = colbase<PS>(tn, wc) + (lane & 15);
#pragma unroll
    for (int m = 0; m < 4; ++m)
#pragma unroll
        for (int r = 0; r < 4; ++r) {
            const int row = tm * 128 + wr * 64 + m * 16 + (lane >> 4) * 4 + r;
            c.epi(tm, row, col0, acc[m][0][r], acc[m][1][r]);
        }
    __syncthreads();
}

__device__ __forceinline__ void ph_ln_in(const Frame& F) {
    const float* x = F.in[I_X]; const f32x4* g4 = (const f32x4*)F.in[I_LNIG]; const f32x4* b4 = (const f32x4*)F.in[I_LNIB];
    bf16_t* H0 = (bf16_t*)(F.ws + WS_H0);
    for (int m = F.gw; m < T; m += F.NGW) {
        const f32x4* xr = (const f32x4*)(x + (size_t)m * DM) + F.lane;
        f32x4 v[4]; float s = 0.f;
#pragma unroll
        for (int j = 0; j < 4; ++j) { v[j] = xr[64 * j]; s += (v[j][0] + v[j][1]) + (v[j][2] + v[j][3]); }
        const float mean = wave_sum(s) * (1.f / DM); float s2 = 0.f;
#pragma unroll
        for (int j = 0; j < 4; ++j) { v[j] = v[j] - mean; s2 += (v[j][0] * v[j][0] + v[j][1] * v[j][1]) + (v[j][2] * v[j][2] + v[j][3] * v[j][3]); }
        const float rstd = 1.f / sqrtf(wave_sum(s2) * (1.f / DM) + LN_EPS);
        u32x2* o = (u32x2*)(H0 + (size_t)m * DM) + F.lane;
#pragma unroll
        for (int j = 0; j < 4; ++j) { const f32x4 y = v[j] * rstd * g4[F.lane + 64 * j] + b4[F.lane + 64 * j]; u32x2 w; w.x = pk2(y[0], y[1]); w.y = pk2(y[2], y[3]); o[64 * j] = w; }
    }
}

struct CfgInProj {
    const bf16_t* H0; const float* W; const float* bgate; bf16_t *Q, *Kb, *V, *U, *GA, *GS;
    __device__ __forceinline__ const bf16_t* arow(int row) const { return H0 + (size_t)row * DM; }
    __device__ __forceinline__ const float* bptr(int) const { return W; }
    __device__ __forceinline__ int ldb() const { return INW; }
    __device__ __forceinline__ int K() const { return DM; }
    __device__ __forceinline__ void one(int row, int col, float v) const {
        if (col < 512) Q[(size_t)row * AW + col] = (bf16_t)f2bf(v * 0.125f);
        else if (col < 1024) Kb[(size_t)row * AW + col - 512] = (bf16_t)f2bf(v);
        else if (col < 1536) V[(size_t)row * AW + col - 1024] = (bf16_t)f2bf(v);
        else if (col < 2048) U[(size_t)row * SW + col - 1536] = (bf16_t)f2bf(v);
        else if (col < 3072) GA[(size_t)row * DM + col - 2048] = (bf16_t)f2bf(sigmoid_f(v + bgate[col - 2048]));
        else GS[(size_t)row * DM + col - 3072] = (bf16_t)f2bf(sigmoid_f(v + bgate[col - 2048]));
    }
    __device__ __forceinline__ void epi(int, int row, int col0, float v0, float v1) const { one(row, col0, v0); one(row, col0 + 16, v1); }
};
__device__ __forceinline__ void ph_inproj(const Frame& F) {
    CfgInProj c{(const bf16_t*)(F.ws + WS_H0), F.in[I_WIN], F.in[I_BGATE], (bf16_t*)(F.ws + WS_Q), (bf16_t*)(F.ws + WS_K), (bf16_t*)(F.ws + WS_V), (bf16_t*)(F.ws + WS_U),
                (bf16_t*)(F.ws + WS_GA), (bf16_t*)(F.ws + WS_GS)};
    constexpr int NTM = T / 128, NTN = INW / 128;
    for (int t = blockIdx.x; t < NTM * NTN; t += F.G) gemm_simple_tile<16>(F, c, t / NTN, t % NTN);
}

__device__ __forceinline__ void ph_attn_simple(const Frame& F) {
    const bf16_t* Q = (const bf16_t*)(F.ws + WS_Q); const bf16_t* Kb = (const bf16_t*)(F.ws + WS_K); const bf16_t* V = (const bf16_t*)(F.ws + WS_V);
    bf16_t* AO = (bf16_t*)(F.ws + WS_AO); const float* relb = F.in[I_RELB];
    const int lane = F.lane;
    for (int it = F.gw; it < T * NH; it += F.NGW) {
        const int m = it / NH, h = it % NH, b = m / SEQ, t = m % SEQ, n = t / CHUNK;
        const float q = bf2f(Q[(size_t)m * AW + h * HD + lane]);
        const int k0 = (n - LEFT) * CHUNK < 0 ? 0 : (n - LEFT) * CHUNK, k1 = n * CHUNK + CHUNK;
        float mx = -1e30f, l = 0.f, o = 0.f;
        for (int kp = k0; kp < k1; ++kp) {
            const size_t kr = (size_t)(b * SEQ + kp) * AW + h * HD + lane;
            float s = wave_sum(q * bf2f(Kb[kr]));
            int dist = t - kp; dist = dist < -(CHUNK - 1) ? -(CHUNK - 1) : (dist > RELMAX ? RELMAX : dist);
            s += relb[h * RELSIZE + dist + (CHUNK - 1)];
            const float mn = fmaxf(mx, s), a = __expf(mx - mn), pp = __expf(s - mn);
            l = l * a + pp; o = o * a + pp * bf2f(V[kr]); mx = mn;
        }
        AO[(size_t)m * AW + h * HD + lane] = (bf16_t)f2bf(o / l);
    }
}

__device__ __forceinline__ void ph_ssm_simple(const Frame& F) {
    const bf16_t* U = (const bf16_t*)(F.ws + WS_U); bf16_t* GY = (bf16_t*)(F.ws + WS_GY);
    const int lane = F.lane;
    for (int it = F.gw; it < BATCH * NG; it += F.NGW) {
        const int b = it / NG, g = it % NG;
        const double lre = (double)F.in[I_LAMRE][g * NP + lane], lim = (double)F.in[I_LAMIM][g * NP + lane];
        const double dt = (double)expf(F.in[I_LOGDT][g]);
        const double er = (double)expf((float)(lre * dt));
        double sn, cs; sincos_d(lim * dt, sn, cs);
        const double lbr_d = er * cs, lbi_d = er * sn;
        const double nr = lbr_d - 1.0, ni = lbi_d, den = lre * lre + lim * lim;
        const double cr = (nr * lre + ni * lim) / den, ci = (ni * lre - nr * lim) / den;
        const float lbr = (float)lbr_d, lbi = (float)lbi_d;
        float Bre[GSZ], Bim[GSZ], Cre[GSZ], Cim[GSZ];
#pragma unroll
        for (int c = 0; c < GSZ; ++c) {
            const double br = (double)F.in[I_BRE][(g * NP + lane) * GSZ + c], bi = (double)F.in[I_BIM][(g * NP + lane) * GSZ + c];
            Bre[c] = (float)(cr * br - ci * bi); Bim[c] = (float)(cr * bi + ci * br);
            Cre[c] = F.in[I_CRE][(g * GSZ + c) * NP + lane]; Cim[c] = F.in[I_CIM][(g * GSZ + c) * NP + lane];
        }
        const float dsk = F.in[I_SSMD][g * GSZ + (lane & 15)];
        float xr = 0.f, xi = 0.f;
        for (int t = 0; t < SEQ; ++t) {
            const bf16_t* up = U + (size_t)(b * SEQ + t) * SW + g * GSZ;
            const u32x4 u0 = *(const u32x4*)up, u1 = *(const u32x4*)(up + 8);
            float u[GSZ];
#pragma unroll
            for (int i = 0; i < 4; ++i) { u[2 * i] = bf2f(u0[i] & 0xffffu); u[2 * i + 1] = bf2f(u0[i] >> 16); u[8 + 2 * i] = bf2f(u1[i] & 0xffffu); u[8 + 2 * i + 1] = bf2f(u1[i] >> 16); }
            float br = 0.f, bi = 0.f;
#pragma unroll
            for (int c = 0; c < GSZ; ++c) { br += Bre[c] * u[c]; bi += Bim[c] * u[c]; }
            const float nxr = lbr * xr - lbi * xi + br, nxi = lbr * xi + lbi * xr + bi; xr = nxr; xi = nxi;
            float yv = 0.f, uv = 0.f;
#pragma unroll
            for (int c = 0; c < GSZ; ++c) { const float part = wave_sum(Cre[c] * xr - Cim[c] * xi); if ((lane & 15) == c) { yv = part; uv = u[c]; } }
            yv += dsk * uv;
            if (lane < GSZ) GY[(size_t)(b * SEQ + t) * SW + g * GSZ + lane] = (bf16_t)f2bf(gelu_tanh(yv));
        }
    }
}

struct CfgGlu {
    const bf16_t* GY; const float* W; bf16_t* SGo;
    __device__ __forceinline__ const bf16_t* arow(int row) const { return GY + (size_t)row * SW; }
    __device__ __forceinline__ const float* bptr(int) const { return W; }
    __device__ __forceinline__ int ldb() const { return 2 * SW; }
    __device__ __forceinline__ int K() const { return SW; }
    __device__ __forceinline__ void epi(int, int row, int col0, float v0, float v1) const { SGo[(size_t)row * SW + col0] = (bf16_t)f2bf(v0 * sigmoid_f(v1)); }
};
__device__ __forceinline__ void ph_glu(const Frame& F) {
    CfgGlu c{(const bf16_t*)(F.ws + WS_GY), F.in[I_WGLU], (bf16_t*)(F.ws + WS_SG)};
    constexpr int NTM = T / 128, NTN = SW / 64;
    for (int t = blockIdx.x; t < NTM * NTN; t += F.G) gemm_simple_tile<SW>(F, c, t / NTN, t % NTN);
}

struct CfgUp {
    const bf16_t* A; const float* W; const bf16_t* gate; float* tmp; bf16_t* Y; bool second;
    __device__ __forceinline__ const bf16_t* arow(int row) const { return A + (size_t)row * 512; }
    __device__ __forceinline__ const float* bptr(int) const { return W; }
    __device__ __forceinline__ int ldb() const { return DM; }
    __device__ __forceinline__ int K() const { return 512; }
    __device__ __forceinline__ void one(int row, int col, float v) const {
        const size_t i = (size_t)row * DM + col; const float gv = bf2f(gate[i]) * v;
        if (!second) tmp[i] = gv; else Y[i] = (bf16_t)f2bf(tmp[i] + gv);
    }
    __device__ __forceinline__ void epi(int, int row, int col0, float v0, float v1) const { one(row, col0, v0); one(row, col0 + 16, v1); }
};
__device__ __forceinline__ void ph_up(const Frame& F, bool second) {
    CfgUp c{(const bf16_t*)(F.ws + (second ? WS_SG : WS_AO)), F.in[second ? I_WUS : I_WUA], (const bf16_t*)(F.ws + (second ? WS_GS : WS_GA)), (float*)(F.ws + WS_R1), (bf16_t*)(F.ws + WS_Y), second};
    constexpr int NTM = T / 128, NTN = DM / 128;
    for (int t = blockIdx.x; t < NTM * NTN; t += F.G) gemm_simple_tile<16>(F, c, t / NTN, t % NTN);
}

struct CfgWo {
    const bf16_t* Y; const float* W; const bf16_t* H0; float* R1;
    __device__ __forceinline__ const bf16_t* arow(int row) const { return Y + (size_t)row * DM; }
    __device__ __forceinline__ const float* bptr(int) const { return W; }
    __device__ __forceinline__ int ldb() const { return DM; }
    __device__ __forceinline__ int K() const { return DM; }
    __device__ __forceinline__ void one(int row, int col, float v) const { const size_t i = (size_t)row * DM + col; R1[i] = ALPHA * bf2f(H0[i]) + v; }
    __device__ __forceinline__ void epi(int, int row, int col0, float v0, float v1) const { one(row, col0, v0); one(row, col0 + 16, v1); }
};
__device__ __forceinline__ void ph_wo(const Frame& F) {
    CfgWo c{(const bf16_t*)(F.ws + WS_Y), F.in[I_WO], (const bf16_t*)(F.ws + WS_H0), (float*)(F.ws + WS_R1)};
    constexpr int NTM = T / 128, NTN = DM / 128;
    for (int t = blockIdx.x; t < NTM * NTN; t += F.G) gemm_simple_tile<16>(F, c, t / NTN, t % NTN);
}

__device__ __forceinline__ void ph_ln1_router(const Frame& F) {
    const float* R1 = (const float*)(F.ws + WS_R1); bf16_t* H1 = (bf16_t*)(F.ws + WS_H1);
    const f32x4* g4 = (const f32x4*)F.in[I_LN1G]; const f32x4* b4 = (const f32x4*)F.in[I_LN1B];
    const float* rw = F.in[I_RW]; const float* rb = F.in[I_RB];
    int* TOPI = (int*)(F.ws + WS_TOPI); float* TOPG = (float*)(F.ws + WS_TOPG); int* TOK = (int*)(F.ws + WS_TOK);
    const int lane = F.lane;
    for (int i = blockIdx.x * 512 + F.tid; i < NROWS; i += F.G * 512) TOK[i] = T;
    if (blockIdx.x == 0) { for (int i = F.tid; i < DM / 2; i += 512) ((unsigned*)(H1 + (size_t)T * DM))[i] = 0u; }
    for (int m = F.gw; m < T; m += F.NGW) {
        const f32x4* xr = (const f32x4*)(R1 + (size_t)m * DM) + lane;
        f32x4 v[4]; float s = 0.f;
#pragma unroll
        for (int j = 0; j < 4; ++j) { v[j] = xr[64 * j]; s += (v[j][0] + v[j][1]) + (v[j][2] + v[j][3]); }
        const float mean = wave_sum(s) * (1.f / DM); float s2 = 0.f;
#pragma unroll
        for (int j = 0; j < 4; ++j) { v[j] = v[j] - mean; s2 += (v[j][0] * v[j][0] + v[j][1] * v[j][1]) + (v[j][2] * v[j][2] + v[j][3] * v[j][3]); }
        const float rstd = 1.f / sqrtf(wave_sum(s2) * (1.f / DM) + LN_EPS);
        u32x2* o = (u32x2*)(H1 + (size_t)m * DM) + lane;
        float lg[NE];
#pragma unroll
        for (int e = 0; e < NE; ++e) lg[e] = 0.f;
#pragma unroll
        for (int j = 0; j < 4; ++j) {
            const f32x4 y = v[j] * rstd * g4[lane + 64 * j] + b4[lane + 64 * j];
            u32x2 w; w.x = pk2(y[0], y[1]); w.y = pk2(y[2], y[3]); o[64 * j] = w;
#pragma unroll
            for (int i = 0; i < 4; ++i) {
                const f32x4* wr4 = (const f32x4*)(rw + (size_t)(256 * j + 4 * lane + i) * NE);
#pragma unroll
                for (int q = 0; q < 8; ++q) { const f32x4 ww = wr4[q]; lg[4 * q] += y[i] * ww[0]; lg[4 * q + 1] += y[i] * ww[1]; lg[4 * q + 2] += y[i] * ww[2]; lg[4 * q + 3] += y[i] * ww[3]; }
                asm volatile("" ::: "memory");
            }
        }
        float r16[16], r8[8], r4[4], r2[2], r1;
        { const bool hb = (lane & 32) != 0;
#pragma unroll
          for (int i = 0; i < 16; ++i) { const float keep = hb ? lg[i + 16] : lg[i], send = hb ? lg[i] : lg[i + 16]; r16[i] = keep + __shfl_xor(send, 32); } }
        { const bool hb = (lane & 16) != 0;
#pragma unroll
          for (int i = 0; i < 8; ++i) { const float keep = hb ? r16[i + 8] : r16[i], send = hb ? r16[i] : r16[i + 8]; r8[i] = keep + __shfl_xor(send, 16); } }
        { const bool hb = (lane & 8) != 0;
#pragma unroll
          for (int i = 0; i < 4; ++i) { const float keep = hb ? r8[i + 4] : r8[i], send = hb ? r8[i] : r8[i + 4]; r4[i] = keep + __shfl_xor(send, 8); } }
        { const bool hb = (lane & 4) != 0;
#pragma unroll
          for (int i = 0; i < 2; ++i) { const float keep = hb ? r4[i + 2] : r4[i], send = hb ? r4[i] : r4[i + 2]; r2[i] = keep + __shfl_xor(send, 4); } }
        { const bool hb = (lane & 2) != 0; const float keep = hb ? r2[1] : r2[0], send = hb ? r2[0] : r2[1]; r1 = keep + __shfl_xor(send, 2); }
        r1 += __shfl_xor(r1, 1);
        const int mye = (lane >> 1) & 31;
        float myv = r1 + rb[mye];
        float tv[TOPK]; int ti[TOPK];
#pragma unroll
        for (int k = 0; k < TOPK; ++k) {
            float bv = myv; int bi = mye;
#pragma unroll
            for (int o = 1; o < 64; o <<= 1) { const float ov = __shfl_xor(bv, o); const int oi = __shfl_xor(bi, o); if (ov > bv || (ov == bv && oi < bi)) { bv = ov; bi = oi; } }
            tv[k] = bv; ti[k] = bi; if (mye == bi) myv = -3.0e38f;
        }
        const float e1 = __expf(tv[1] - tv[0]), e2 = __expf(tv[2] - tv[0]), e3 = __expf(tv[3] - tv[0]);
        const float inv = 1.f / (1.f + e1 + e2 + e3);
        if (lane == 0) {
            TOPI[m * 4 + 0] = ti[0]; TOPI[m * 4 + 1] = ti[1]; TOPI[m * 4 + 2] = ti[2]; TOPI[m * 4 + 3] = ti[3];
            TOPG[m * 4 + 0] = inv; TOPG[m * 4 + 1] = e1 * inv; TOPG[m * 4 + 2] = e2 * inv; TOPG[m * 4 + 3] = e3 * inv;
#pragma unroll
            for (int k = 0; k < TOPK; ++k) atomicAdd(F.ctl + CW_COUNTS + ti[k], 1u);
        }
    }
}

__device__ __forceinline__ void load_pstart(const Frame& F) {
    LAS int* ps = (LAS int*)(F.lds + 65536);
    __syncthreads();
    if (F.tid == 0) { int acc = 0; for (int e = 0; e < NE; ++e) { ps[e] = acc; const int c = (int)__hip_atomic_load(F.ctl + CW_COUNTS + e, __ATOMIC_RELAXED, __HIP_MEMORY_SCOPE_AGENT); acc += ((c + EB - 1) / EB) * EB; } ps[NE] = acc; }
    __syncthreads();
}
__device__ __forceinline__ void ph_dest(const Frame& F) {
    load_pstart(F);
    const LAS int* ps = (const LAS int*)(F.lds + 65536);
    const int* TOPI = (const int*)(F.ws + WS_TOPI); int* DEST = (int*)(F.ws + WS_DEST); int* TOK = (int*)(F.ws + WS_TOK);
    for (int a = blockIdx.x * 512 + F.tid; a < NASSIGN; a += F.G * 512) {
        const int e = TOPI[a]; const int pos = (int)atomicAdd(F.ctl + CW_CURSOR + e, 1u); const int d = ps[e] + pos;
        TOK[d] = a >> 2; DEST[a] = d;
    }
}

struct CfgMoe1 {
    const bf16_t* H1; const int* TOK; const float* W; const float* bgu; bf16_t* ACT; const LAS int* ps;
    __device__ __forceinline__ int expert(int tm) const { const int r0 = tm * 128; int e = 0;
#pragma unroll 1
        for (int i = 1; i < NE; ++i) e += (ps[i] <= r0) ? 1 : 0; return e; }
    __device__ __forceinline__ const bf16_t* arow(int row) const { return H1 + (size_t)TOK[row] * DM; }
    __device__ __forceinline__ const float* bptr(int tm) const { return W + (size_t)expert(tm) * DM * 2 * DE; }
    __device__ __forceinline__ int ldb() const { return 2 * DE; }
    __device__ __forceinline__ int K() const { return DM; }
    __device__ __forceinline__ void epi(int tm, int row, int col0, float v0, float v1) const {
        const int e = expert(tm);
        float g = v0 + bgu[e * 2 * DE + col0], l = v1 + bgu[e * 2 * DE + DE + col0];
        g = fminf(g, SWIGLU_LIMIT); l = fminf(fmaxf(l, -SWIGLU_LIMIT), SWIGLU_LIMIT);
        ACT[(size_t)row * DE + col0] = (bf16_t)f2bf(g * sigmoid_f(SWIGLU_ALPHA * g) * (l + 1.f));
    }
};
__device__ __forceinline__ void ph_moe1(const Frame& F) {
    load_pstart(F);
    const LAS int* ps = (const LAS int*)(F.lds + 65536);
    CfgMoe1 c{(const bf16_t*)(F.ws + WS_H1), (const int*)(F.ws + WS_TOK), F.in[I_WGU], F.in[I_BGU], (bf16_t*)(F.ws + WS_ACT), ps};
    const int ntm = ps[NE] / 128; constexpr int NTN = DE / 64;
    for (int t = blockIdx.x; t < ntm * NTN; t += F.G) gemm_simple_tile<DE>(F, c, t / NTN, t % NTN);
}
struct CfgMoe2 {
    const bf16_t* ACT; const float* W; const float* bd; bf16_t* OUTS; const LAS int* ps;
    __device__ __forceinline__ int expert(int tm) const { const int r0 = tm * 128; int e = 0;
#pragma unroll 1
        for (int i = 1; i < NE; ++i) e += (ps[i] <= r0) ? 1 : 0; return e; }
    __device__ __forceinline__ const bf16_t* arow(int row) const { return ACT + (size_t)row * DE; }
    __device__ __forceinline__ const float* bptr(int tm) const { return W + (size_t)expert(tm) * DE * DM; }
    __device__ __forceinline__ int ldb() const { return DM; }
    __device__ __forceinline__ int K() const { return DE; }
    __device__ __forceinline__ void epi(int tm, int row, int col0, float v0, float v1) const {
        const int e = expert(tm);
        OUTS[(size_t)row * DM + col0] = (bf16_t)f2bf(v0 + bd[e * DM + col0]);
        OUTS[(size_t)row * DM + col0 + 16] = (bf16_t)f2bf(v1 + bd[e * DM + col0 + 16]);
    }
};
__device__ __forceinline__ void ph_moe2(const Frame& F) {
    load_pstart(F);
    const LAS int* ps = (const LAS int*)(F.lds + 65536);
    CfgMoe2 c{(const bf16_t*)(F.ws + WS_ACT), F.in[I_WD], F.in[I_BD], (bf16_t*)(F.ws + WS_OUTS), ps};
    const int ntm = ps[NE] / 128; constexpr int NTN = DM / 128;
    for (int t = blockIdx.x; t < ntm * NTN; t += F.G) gemm_simple_tile<16>(F, c, t / NTN, t % NTN);
}

__device__ __forceinline__ void ph_combine(const Frame& F) {
    const bf16_t* H1 = (const bf16_t*)(F.ws + WS_H1); const bf16_t* OUTS = (const bf16_t*)(F.ws + WS_OUTS);
    const int* DEST = (const int*)(F.ws + WS_DEST); const float* TOPG = (const float*)(F.ws + WS_TOPG);
    const f32x4* g4 = (const f32x4*)F.in[I_LN2G]; const f32x4* b4 = (const f32x4*)F.in[I_LN2B];
    const int lane = F.lane;
    for (int m = F.gw; m < T; m += F.NGW) {
        f32x4 v[4];
        const u32x2* hr = (const u32x2*)(H1 + (size_t)m * DM) + lane;
#pragma unroll
        for (int j = 0; j < 4; ++j) { const u32x2 w = hr[64 * j]; v[j] = (f32x4){bf2f(w.x & 0xffffu), bf2f(w.x >> 16), bf2f(w.y & 0xffffu), bf2f(w.y >> 16)} * ALPHA; }
#pragma unroll
        for (int k = 0; k < TOPK; ++k) {
            const int d = DEST[m * 4 + k]; const float gk = TOPG[m * 4 + k];
            const u32x2* orow = (const u32x2*)(OUTS + (size_t)d * DM) + lane;
#pragma unroll
            for (int j = 0; j < 4; ++j) { const u32x2 w = orow[64 * j]; v[j] += (f32x4){bf2f(w.x & 0xffffu), bf2f(w.x >> 16), bf2f(w.y & 0xffffu), bf2f(w.y >> 16)} * gk; }
        }
        float s = 0.f;
#pragma unroll
        for (int j = 0; j < 4; ++j) s += (v[j][0] + v[j][1]) + (v[j][2] + v[j][3]);
        const float mean = wave_sum(s) * (1.f / DM); float s2 = 0.f;
#pragma unroll
        for (int j = 0; j < 4; ++j) { v[j] = v[j] - mean; s2 += (v[j][0] * v[j][0] + v[j][1] * v[j][1]) + (v[j][2] * v[j][2] + v[j][3] * v[j][3]); }
        const float rstd = 1.f / sqrtf(wave_sum(s2) * (1.f / DM) + LN_EPS);
        f32x4* o = (f32x4*)(F.out + (size_t)m * DM) + lane;
#pragma unroll
        for (int j = 0; j < 4; ++j) o[64 * j] = v[j] * rstd * g4[lane + 64 * j] + b4[lane + 64 * j];
    }
}

constexpr int LDS_BYTES = 147456;
constexpr int MISC_OFF = 131072 + 320;
constexpr int N_PHASES = 12;

__global__ void __launch_bounds__(NWAVES * 64, 2) mega_fwd(Args args) {
    extern __shared__ __attribute__((aligned(16))) unsigned char lds[];
    Frame F;
    F.lds = (LAS unsigned char*)lds;
    F.tid = threadIdx.x; F.lane = F.tid & 63; F.wave = __builtin_amdgcn_readfirstlane(F.tid >> 6);
    F.G = gridDim.x; F.gw = blockIdx.x * NWAVES + F.wave; F.NGW = F.G * NWAVES;
    F.in = args.in; F.out = args.out; F.ws = args.ws; F.ctl = (unsigned*)(args.ws + WS_CTL);
    volatile LAS unsigned* MISC = (volatile LAS unsigned*)(F.lds + MISC_OFF);
    for (int u = F.tid; u < 64; u += NWAVES * 64) MISC[u] = 0u;
    __syncthreads();
    const int lo = args.ph_lo, hi = args.ph_hi;
    XcdBarrier bar; bar.bar = F.ctl + CW_BAR; bar.x = 0; bar.st = nullptr;
    if (hi - lo > 1) bar = xcd_barrier_post(F.ctl + CW_BAR, MISC + 8);
#define IN(k) (lo <= (k) && (k) < hi)
#define SEAM(k) do { if (IN(k) && IN((k) + 1)) xcd_barrier(bar); } while (0)
    if (IN(0)) { ph_ln_in(F); } SEAM(0);
    if (IN(1)) { ph_inproj(F); } SEAM(1);
    if (IN(2)) { if (blockIdx.x < 8) ph_ssm_simple(F); else { Frame F2 = F; F2.gw = (blockIdx.x - 8) * NWAVES + F.wave; F2.NGW = (F.G - 8) * NWAVES; ph_attn_simple(F2); } } SEAM(2);
    if (IN(3)) { ph_glu(F); } SEAM(3);
    if (IN(4)) { ph_up(F, false); } SEAM(4);
    if (IN(5)) { ph_up(F, true); } SEAM(5);
    if (IN(6)) { ph_wo(F); } SEAM(6);
    if (IN(7)) { ph_ln1_router(F); } SEAM(7);
    if (IN(8)) { ph_dest(F); } SEAM(8);
    if (IN(9)) { ph_moe1(F); } SEAM(9);
    if (IN(10)) { ph_moe2(F); } SEAM(10);
    if (IN(11)) { ph_combine(F); }
#undef IN
#undef SEAM
}

extern "C" void kernel_launch(void* const* d_in, const int* in_sizes, int n_in, void* d_out, int out_size, void* d_ws, size_t ws_size, hipStream_t stream) {
    static int grid = 0;
    if (grid == 0) {
        if (n_in != 28 || out_size != T * DM || ws_size < WS_END) { fprintf(stderr, "kernel_launch: unexpected shapes (n_in %d out %d ws %zu)\n", n_in, out_size, ws_size); grid = -1; return; }
        int dev = 0, cus = 0;
        if (hipGetDevice(&dev) != hipSuccess || hipDeviceGetAttribute(&cus, hipDeviceAttributeMultiprocessorCount, dev) != hipSuccess) { grid = -1; return; }
        if (hipFuncSetAttribute((const void*)mega_fwd, hipFuncAttributeMaxDynamicSharedMemorySize, LDS_BYTES) != hipSuccess) { fprintf(stderr, "kernel_launch: hipFuncSetAttribute failed\n"); grid = -1; return; }
        grid = cus;
    }
    if (grid < 0) return;
    (void)hipMemsetAsync((char*)d_ws + WS_CTL, 0, CTL_ZERO_BYTES, stream);
    Args a{};
    for (int i = 0; i < 28; ++i) a.in[i] = (const float*)d_in[i];
    a.out = (float*)d_out; a.ws = (unsigned char*)d_ws;
#if MK_ONE_LAUNCH
    a.ph_lo = 0; a.ph_hi = N_PHASES;
    hipLaunchKernelGGL(mega_fwd, dim3(grid), dim3(NWAVES * 64), LDS_BYTES, stream, a);
#else
    for (int p = 0; p < N_PHASES; ++p) { a.ph_lo = p; a.ph_hi = p + 1; hipLaunchKernelGGL(mega_fwd, dim3(grid), dim3(NWAVES * 64), LDS_BYTES, stream, a); }
#endif
}
```

```cpp
#include <hip/hip_runtime.h>
#include <cstdio>
#include <cstdint>

#ifndef MK_ONE_LAUNCH
#define MK_ONE_LAUNCH 1
#endif

#define GAS __attribute__((address_space(1)))
#define LAS __attribute__((address_space(3)))
typedef unsigned short bf16_t;
typedef short bf16x8 __attribute__((ext_vector_type(8)));
typedef float f32x4 __attribute__((ext_vector_type(4)));
typedef unsigned u32x4 __attribute__((ext_vector_type(4)));
typedef unsigned u32x2 __attribute__((ext_vector_type(2)));

constexpr int BATCH = 2, SEQ = 8192, T = BATCH * SEQ, DM = 1024;
constexpr int CHUNK = 64, LEFT = 8, NCH = SEQ / CHUNK;
constexpr int NH = 8, HD = 64, AW = 512, RELMAX = 256, RELSIZE = 320;
constexpr int SW = 512, GSZ = 16, NG = 32, NP = 64;
constexpr int INW = 4096;
constexpr int NE = 32, TOPK = 4, DE = 1024, EB = 256;
constexpr int NASSIGN = T * TOPK;
constexpr int NROWS = NASSIGN + NE * EB;
constexpr float LN_EPS = 1e-5f;
constexpr float ALPHA = 1.189207115002721f;
constexpr float SWIGLU_LIMIT = 7.0f, SWIGLU_ALPHA = 1.702f;
constexpr int NWAVES = 8;

constexpr size_t MiB = 1u << 20;
constexpr size_t WS_CTL = 0, CTL_ZERO_BYTES = 1 * MiB;
constexpr size_t WS_H0 = 1 * MiB;
constexpr size_t WS_Q = 33 * MiB;
constexpr size_t WS_K = 49 * MiB;
constexpr size_t WS_V = 65 * MiB;
constexpr size_t WS_U = 81 * MiB;
constexpr size_t WS_GA = 97 * MiB;
constexpr size_t WS_GS = 129 * MiB;
constexpr size_t WS_AO = 161 * MiB;
constexpr size_t WS_GY = 177 * MiB;
constexpr size_t WS_SG = 193 * MiB;
constexpr size_t WS_Y = 209 * MiB;
constexpr size_t WS_R1 = 241 * MiB;
constexpr size_t WS_H1 = 305 * MiB;
constexpr size_t WS_TOPI = 338 * MiB;
constexpr size_t WS_TOPG = 339 * MiB;
constexpr size_t WS_DEST = 340 * MiB;
constexpr size_t WS_TOK = 341 * MiB;
constexpr size_t WS_ACT = 342 * MiB;
constexpr size_t WS_OUTS = 486 * MiB;
constexpr size_t WS_END = 630 * MiB;
constexpr int CW_COUNTS = 64, CW_CURSOR = 128;
constexpr int CW_BAR = 4096;

__device__ __forceinline__ unsigned f2bf(float f) { unsigned u = __float_as_uint(f); return (u + 0x7fffu + ((u >> 16) & 1u)) >> 16; }
__device__ __forceinline__ float bf2f(unsigned h) { return __uint_as_float(h << 16); }
__device__ __forceinline__ unsigned pk2(float lo, float hi) { return f2bf(lo) | (f2bf(hi) << 16); }
__device__ __forceinline__ float wave_sum(float v) {
#pragma unroll
    for (int o = 1; o < 64; o <<= 1) v += __shfl_xor(v, o);
    return v;
}
__device__ __forceinline__ float sigmoid_f(float x) { return 1.f / (1.f + __expf(-x)); }
__device__ __forceinline__ float gelu_tanh(float x) { const float z = 0.7978845608028654f * (x + 0.044715f * x * x * x); return x * sigmoid_f(2.f * z); }

__device__ __forceinline__ void sincos_d(double x, double& s, double& c) {
    const double kd = rint(x * 0.63661977236758134308);
    const int k = (int)kd;
    double r = fma(-kd, 1.57079632679489655800e+00, x);
    r = fma(-kd, 6.12323399573676603587e-17, r);
    const double r2 = r * r;
    double sp = -1.0 / 1307674368000.0;
    sp = sp * r2 + 1.0 / 6227020800.0; sp = sp * r2 - 1.0 / 39916800.0; sp = sp * r2 + 1.0 / 362880.0; sp = sp * r2 - 1.0 / 5040.0; sp = sp * r2 + 1.0 / 120.0; sp = sp * r2 - 1.0 / 6.0;
    sp = r + r * r2 * sp;
    double cp = -1.0 / 87178291200.0;
    cp = cp * r2 + 1.0 / 479001600.0; cp = cp * r2 - 1.0 / 3628800.0; cp = cp * r2 + 1.0 / 40320.0; cp = cp * r2 - 1.0 / 720.0; cp = cp * r2 + 1.0 / 24.0; cp = cp * r2 - 0.5;
    cp = 1.0 + r2 * cp;
    const int q = k & 3;
    s = (q == 0) ? sp : (q == 1) ? cp : (q == 2) ? -sp : -cp;
    c = (q == 0) ? cp : (q == 1) ? -sp : (q == 2) ? -cp : sp;
}

#define XB_TMO      128
#define XB_XCNT(j)  (256  + 64 * (j))
#define XB_XSUB(j)  (1280 + 64 * (j))
#define XB_XGEN(j)  (2304 + 64 * (j))
#define XB_TOP      3328
#define XB_TOPGEN   3392
#define XCD_BAR_WORDS 3456
#define XB_SPIN_CAP (1u << 22)
__device__ __forceinline__ unsigned xb_ld(unsigned* p)              { return __hip_atomic_load(p, __ATOMIC_RELAXED, __HIP_MEMORY_SCOPE_AGENT); }
__device__ __forceinline__ unsigned xb_add(unsigned* p, unsigned v) { return __hip_atomic_fetch_add(p, v, __ATOMIC_RELAXED, __HIP_MEMORY_SCOPE_AGENT); }
__device__ __forceinline__ unsigned xb_xcc_id() { return (unsigned)__builtin_amdgcn_s_getreg((3 << 11) | 20) & 0xFu; }
#define XB_SPIN(cond, bar) do { unsigned _sp = 0; while (cond) { __builtin_amdgcn_s_sleep(1); \
    if ((++_sp & 255u) == 0u) { if (xb_ld(&(bar)[XB_TMO])) break; if (_sp > XB_SPIN_CAP) { atomicAdd(&(bar)[XB_TMO], 1u); break; } } } } while (0)
struct XcdBarrier { unsigned* bar; unsigned x; volatile LAS unsigned* st; };
__device__ __forceinline__ XcdBarrier xcd_barrier_post(unsigned* bar, volatile LAS unsigned* st) {
    XcdBarrier b; b.bar = bar; b.x = xb_xcc_id(); b.st = st;
    if (threadIdx.x == 0) (void)xb_add(&bar[XB_XCNT(b.x)], 1u);
    return b;
}
__device__ __forceinline__ void xcd_barrier_complete(unsigned* bar, unsigned x, unsigned& nloc, unsigned& nx) {
    const unsigned G = gridDim.x * gridDim.y * gridDim.z;
    unsigned sum, cnt, mine, sp = 0u;
    for (;;) {
        sum = 0u; cnt = 0u; mine = 0u;
#pragma unroll
        for (unsigned j = 0; j < 16; ++j) { const unsigned c = xb_ld(&bar[XB_XCNT(j)]); sum += c; cnt += (c > 0u) ? 1u : 0u; mine = (j == x) ? c : mine; }
        if (sum == G) break;
        __builtin_amdgcn_s_sleep(1);
        if ((++sp & 255u) == 0u) { if (xb_ld(&bar[XB_TMO])) break; if (sp > XB_SPIN_CAP) { atomicAdd(&bar[XB_TMO], 1u); break; } }
    }
    nloc = mine > 0u ? mine : 1u; nx = cnt > 0u ? cnt : 1u;
}
__device__ __forceinline__ void xcd_barrier(const XcdBarrier& b) {
    asm volatile("s_waitcnt vmcnt(0)" ::: "memory");
    __syncthreads();
    if (threadIdx.x == 0) {
        unsigned* bar = b.bar;
        __builtin_amdgcn_s_waitcnt(0);
        unsigned nloc = b.st[0], nx = b.st[1];
        if (nloc == 0u) { xcd_barrier_complete(bar, b.x, nloc, nx); b.st[0] = nloc; b.st[1] = nx; }
        const unsigned old = xb_add(&bar[XB_XSUB(b.x)], 1u);
        const unsigned gen = old / nloc;
        if (old + 1u == (gen + 1u) * nloc) {
            __builtin_amdgcn_fence(__ATOMIC_RELEASE, "agent");
            asm volatile("s_waitcnt vmcnt(0)" ::: "memory");
            const unsigned og = xb_add(&bar[XB_TOP], 1u);
            const unsigned tg = og / nx;
            if (og + 1u == (tg + 1u) * nx) xb_add(&bar[XB_TOPGEN], 1u);
            else XB_SPIN(xb_ld(&bar[XB_TOPGEN]) == tg, bar);
            __builtin_amdgcn_fence(__ATOMIC_ACQUIRE, "agent");
            xb_add(&bar[XB_XGEN(b.x)], 1u);
            asm volatile("s_waitcnt vmcnt(0)" ::: "memory");
        } else {
            XB_SPIN(xb_ld(&bar[XB_XGEN(b.x)]) == gen, bar);
            __builtin_amdgcn_fence(__ATOMIC_ACQUIRE, "agent");
            asm volatile("s_waitcnt vmcnt(0)" ::: "memory");
        }
    }
    __syncthreads();
}

struct Args {
    const float* in[28];
    float* out; unsigned char* ws;
    int ph_lo, ph_hi;
};
enum { I_X = 0, I_LNIG, I_LNIB, I_WIN, I_BGATE, I_RELB, I_LAMRE, I_LAMIM, I_LOGDT, I_BRE, I_BIM, I_CRE, I_CIM, I_SSMD, I_WGLU, I_WUA, I_WUS, I_WO,
       I_LN1G, I_LN1B, I_RW, I_RB, I_WGU, I_BGU, I_WD, I_BD, I_LN2G, I_LN2B };

struct Frame {
    LAS unsigned char* lds;
    int tid, lane, wave, G, gw, NGW;
    const float* const* in;
    float* out; unsigned char* ws;
    unsigned* ctl;
};

template <int PS> __device__ __forceinline__ int colbase(int tn, int wc) { return PS == 16 ? tn * 128 + wc * 32 : tn * 64 + wc * 16; }

template <int PS, class Cfg>
__device__ __forceinline__ void gemm_simple_tile(const Frame& F, const Cfg& c, int tm, int tn) {
    LAS bf16_t* As = (LAS bf16_t*)F.lds;
    LAS bf16_t* Bs = As + 128 * 40;
    const int tid = F.tid, lane = F.lane, w = F.wave, wr = w >> 2, wc = w & 3;
    f32x4 acc[4][2];
#pragma unroll
    for (int m = 0; m < 4; ++m)
#pragma unroll
        for (int n = 0; n < 2; ++n) acc[m][n] = (f32x4){0.f, 0.f, 0.f, 0.f};
    const int ar = tid >> 2, ak = (tid & 3) * 8;
    const bf16_t* ap = c.arow(tm * 128 + ar) + ak;
    const int bk = tid >> 4, bc = (tid & 15) * 8;
    const int pc = colbase<PS>(tn, bc >> 5) + ((bc >> 4) & 1) * PS + (bc & 15);
    const int ldb = c.ldb();
    const float* bp = c.bptr(tm) + (size_t)bk * ldb + pc;
    const int K = c.K();
    for (int k0 = 0; k0 < K; k0 += 32) {
        const u32x4 av = *(const u32x4*)(ap + k0);
        const f32x4 b0 = *(const f32x4*)(bp + (size_t)k0 * ldb), b1 = *(const f32x4*)(bp + (size_t)k0 * ldb + 4);
        __syncthreads();
        *(LAS u32x4*)(As + ar * 40 + ak) = av;
        Bs[(bc + 0) * 40 + bk] = (bf16_t)f2bf(b0[0]); Bs[(bc + 1) * 40 + bk] = (bf16_t)f2bf(b0[1]);
        Bs[(bc + 2) * 40 + bk] = (bf16_t)f2bf(b0[2]); Bs[(bc + 3) * 40 + bk] = (bf16_t)f2bf(b0[3]);
        Bs[(bc + 4) * 40 + bk] = (bf16_t)f2bf(b1[0]); Bs[(bc + 5) * 40 + bk] = (bf16_t)f2bf(b1[1]);
        Bs[(bc + 6) * 40 + bk] = (bf16_t)f2bf(b1[2]); Bs[(bc + 7) * 40 + bk] = (bf16_t)f2bf(b1[3]);
        __syncthreads();
        bf16x8 a[4], b[2];
#pragma unroll
        for (int m = 0; m < 4; ++m) a[m] = *(const LAS bf16x8*)(As + (wr * 64 + m * 16 + (lane & 15)) * 40 + (lane >> 4) * 8);
#pragma unroll
        for (int n = 0; n < 2; ++n) b[n] = *(const LAS bf16x8*)(Bs + (wc * 32 + n * 16 + (lane & 15)) * 40 + (lane >> 4) * 8);
#pragma unroll
        for (int m = 0; m < 4; ++m)
#pragma unroll
            for (int n = 0; n < 2; ++n) acc[m][n] = __builtin_amdgcn_mfma_f32_16x16x32_bf16(a[m], b[n], acc[m][n], 0, 0, 0);
    }
    const int col0 = colbase<PS>(tn, wc) + (lane & 15);
#pragma unroll
    for (int m = 0; m < 4; ++m)
#pragma unroll
        for (int r = 0; r < 4; ++r) {
            const int row = tm * 128 + wr * 64 + m * 16 + (lane >> 4) * 4 + r;
            c.epi(tm, row, col0, acc[m][0][r], acc[m][1][r]);
        }
    __syncthreads();
}

__device__ __forceinline__ void ph_ln_in(const Frame& F) {
    const float* x = F.in[I_X]; const f32x4* g4 = (const f32x4*)F.in[I_LNIG]; const f32x4* b4 = (const f32x4*)F.in[I_LNIB];
    bf16_t* H0 = (bf16_t*)(F.ws + WS_H0);
    for (int m = F.gw; m < T; m += F.NGW) {
        const f32x4* xr = (const f32x4*)(x + (size_t)m * DM) + F.lane;
        f32x4 v[4]; float s = 0.f;
#pragma unroll
        for (int j = 0; j < 4; ++j) { v[j] = xr[64 * j]; s += (v[j][0] + v[j][1]) + (v[j][2] + v[j][3]); }
        const float mean = wave_sum(s) * (1.f / DM); float s2 = 0.f;
#pragma unroll
        for (int j = 0; j < 4; ++j) { v[j] = v[j] - mean; s2 += (v[j][0] * v[j][0] + v[j][1] * v[j][1]) + (v[j][2] * v[j][2] + v[j][3] * v[j][3]); }
        const float rstd = 1.f / sqrtf(wave_sum(s2) * (1.f / DM) + LN_EPS);
        u32x2* o = (u32x2*)(H0 + (size_t)m * DM) + F.lane;
#pragma unroll
        for (int j = 0; j < 4; ++j) { const f32x4 y = v[j] * rstd * g4[F.lane + 64 * j] + b4[F.lane + 64 * j]; u32x2 w; w.x = pk2(y[0], y[1]); w.y = pk2(y[2], y[3]); o[64 * j] = w; }
    }
}

struct CfgInProj {
    const bf16_t* H0; const float* W; const float* bgate; bf16_t *Q, *Kb, *V, *U, *GA, *GS;
    __device__ __forceinline__ const bf16_t* arow(int row) const { return H0 + (size_t)row * DM; }
    __device__ __forceinline__ const float* bptr(int) const { return W; }
    __device__ __forceinline__ int ldb() const { return INW; }
    __device__ __forceinline__ int K() const { return DM; }
    __device__ __forceinline__ void one(int row, int col, float v) const {
        if (col < 512) Q[(size_t)row * AW + col] = (bf16_t)f2bf(v * 0.125f);
        else if (col < 1024) Kb[(size_t)row * AW + col - 512] = (bf16_t)f2bf(v);
        else if (col < 1536) V[(size_t)row * AW + col - 1024] = (bf16_t)f2bf(v);
        else if (col < 2048) U[(size_t)row * SW + col - 1536] = (bf16_t)f2bf(v);
        else if (col < 3072) GA[(size_t)row * DM + col - 2048] = (bf16_t)f2bf(sigmoid_f(v + bgate[col - 2048]));
        else GS[(size_t)row * DM + col - 3072] = (bf16_t)f2bf(sigmoid_f(v + bgate[col - 2048]));
    }
    __device__ __forceinline__ void epi(int, int row, int col0, float v0, float v1) const { one(row, col0, v0); one(row, col0 + 16, v1); }
};
__device__ __forceinline__ void ph_inproj(const Frame& F) {
    CfgInProj c{(const bf16_t*)(F.ws + WS_H0), F.in[I_WIN], F.in[I_BGATE], (bf16_t*)(F.ws + WS_Q), (bf16_t*)(F.ws + WS_K), (bf16_t*)(F.ws + WS_V), (bf16_t*)(F.ws + WS_U),
                (bf16_t*)(F.ws + WS_GA), (bf16_t*)(F.ws + WS_GS)};
    constexpr int NTM = T / 128, NTN = INW / 128;
    for (int t = blockIdx.x; t < NTM * NTN; t += F.G) gemm_simple_tile<16>(F, c, t / NTN, t % NTN);
}

__device__ __forceinline__ void ph_attn_simple(const Frame& F) {
    const bf16_t* Q = (const bf16_t*)(F.ws + WS_Q); const bf16_t* Kb = (const bf16_t*)(F.ws + WS_K); const bf16_t* V = (const bf16_t*)(F.ws + WS_V);
    bf16_t* AO = (bf16_t*)(F.ws + WS_AO); const float* relb = F.in[I_RELB];
    const int lane = F.lane;
    for (int it = F.gw; it < T * NH; it += F.NGW) {
        const int m = it / NH, h = it % NH, b = m / SEQ, t = m % SEQ, n = t / CHUNK;
        const float q = bf2f(Q[(size_t)m * AW + h * HD + lane]);
        const int k0 = (n - LEFT) * CHUNK < 0 ? 0 : (n - LEFT) * CHUNK, k1 = n * CHUNK + CHUNK;
        float mx = -1e30f, l = 0.f, o = 0.f;
        for (int kp = k0; kp < k1; ++kp) {
            const size_t kr = (size_t)(b * SEQ + kp) * AW + h * HD + lane;
            float s = wave_sum(q * bf2f(Kb[kr]));
            int dist = t - kp; dist = dist < -(CHUNK - 1) ? -(CHUNK - 1) : (dist > RELMAX ? RELMAX : dist);
            s += relb[h * RELSIZE + dist + (CHUNK - 1)];
            const float mn = fmaxf(mx, s), a = __expf(mx - mn), pp = __expf(s - mn);
            l = l * a + pp; o = o * a + pp * bf2f(V[kr]); mx = mn;
        }
        AO[(size_t)m * AW + h * HD + lane] = (bf16_t)f2bf(o / l);
    }
}

__device__ __forceinline__ void ph_ssm_simple(const Frame& F) {
    const bf16_t* U = (const bf16_t*)(F.ws + WS_U); bf16_t* GY = (bf16_t*)(F.ws + WS_GY);
    const int lane = F.lane;
    for (int it = F.gw; it < BATCH * NG; it += F.NGW) {
        const int b = it / NG, g = it % NG;
        const double lre = (double)F.in[I_LAMRE][g * NP + lane], lim = (double)F.in[I_LAMIM][g * NP + lane];
        const double dt = (double)expf(F.in[I_LOGDT][g]);
        const double er = (double)expf((float)(lre * dt));
        double sn, cs; sincos_d(lim * dt, sn, cs);
        const double lbr_d = er * cs, lbi_d = er * sn;
        const double nr = lbr_d - 1.0, ni = lbi_d, den = lre * lre + lim * lim;
        const double cr = (nr * lre + ni * lim) / den, ci = (ni * lre - nr * lim) / den;
        const float lbr = (float)lbr_d, lbi = (float)lbi_d;
        float Bre[GSZ], Bim[GSZ], Cre[GSZ], Cim[GSZ];
#pragma unroll
        for (int c = 0; c < GSZ; ++c) {
            const double br = (double)F.in[I_BRE][(g * NP + lane) * GSZ + c], bi = (double)F.in[I_BIM][(g * NP + lane) * GSZ + c];
            Bre[c] = (float)(cr * br - ci * bi); Bim[c] = (float)(cr * bi + ci * br);
            Cre[c] = F.in[I_CRE][(g * GSZ + c) * NP + lane]; Cim[c] = F.in[I_CIM][(g * GSZ + c) * NP + lane];
        }
        const float dsk = F.in[I_SSMD][g * GSZ + (lane & 15)];
        float xr = 0.f, xi = 0.f;
        for (int t = 0; t < SEQ; ++t) {
            const bf16_t* up = U + (size_t)(b * SEQ + t) * SW + g * GSZ;
            const u32x4 u0 = *(const u32x4*)up, u1 = *(const u32x4*)(up + 8);
            float u[GSZ];
#pragma unroll
            for (int i = 0; i < 4; ++i) { u[2 * i] = bf2f(u0[i] & 0xffffu); u[2 * i + 1] = bf2f(u0[i] >> 16); u[8 + 2 * i] = bf2f(u1[i] & 0xffffu); u[8 + 2 * i + 1] = bf2f(u1[i] >> 16); }
            float br = 0.f, bi = 0.f;
#pragma unroll
            for (int c = 0; c < GSZ; ++c) { br += Bre[c] * u[c]; bi += Bim[c] * u[c]; }
            const float nxr = lbr * xr - lbi * xi + br, nxi = lbr * xi + lbi * xr + bi; xr = nxr; xi = nxi;
            float yv = 0.f, uv = 0.f;
#pragma unroll
            for (int c = 0; c < GSZ; ++c) { const float part = wave_sum(Cre[c] * xr - Cim[c] * xi); if ((lane & 15) == c) { yv = part; uv = u[c]; } }
            yv += dsk * uv;
            if (lane < GSZ) GY[(size_t)(b * SEQ + t) * SW + g * GSZ + lane] = (bf16_t)f2bf(gelu_tanh(yv));
        }
    }
}

struct CfgGlu {
    const bf16_t* GY; const float* W; bf16_t* SGo;
    __device__ __forceinline__ const bf16_t* arow(int row) const { return GY + (size_t)row * SW; }
    __device__ __forceinline__ const float* bptr(int) const { return W; }
    __device__ __forceinline__ int ldb() const { return 2 * SW; }
    __device__ __forceinline__ int K() const { return SW; }
    __device__ __forceinline__ void epi(int, int row, int col0, float v0, float v1) const { SGo[(size_t)row * SW + col0] = (bf16_t)f2bf(v0 * sigmoid_f(v1)); }
};
__device__ __forceinline__ void ph_glu(const Frame& F) {
    CfgGlu c{(const bf16_t*)(F.ws + WS_GY), F.in[I_WGLU], (bf16_t*)(F.ws + WS_SG)};
    constexpr int NTM = T / 128, NTN = SW / 64;
    for (int t = blockIdx.x; t < NTM * NTN; t += F.G) gemm_simple_tile<SW>(F, c, t / NTN, t % NTN);
}

struct CfgUp {
    const bf16_t* A; const float* W; const bf16_t* gate; float* tmp; bf16_t* Y; bool second;
    __device__ __forceinline__ const bf16_t* arow(int row) const { return A + (size_t)row * 512; }
    __device__ __forceinline__ const float* bptr(int) const { return W; }
    __device__ __forceinline__ int ldb() const { return DM; }
    __device__ __forceinline__ int K() const { return 512; }
    __device__ __forceinline__ void one(int row, int col, float v) const {
        const size_t i = (size_t)row * DM + col; const float gv = bf2f(gate[i]) * v;
        if (!second) tmp[i] = gv; else Y[i] = (bf16_t)f2bf(tmp[i] + gv);
    }
    __device__ __forceinline__ void epi(int, int row, int col0, float v0, float v1) const { one(row, col0, v0); one(row, col0 + 16, v1); }
};
__device__ __forceinline__ void ph_up(const Frame& F, bool second) {
    CfgUp c{(const bf16_t*)(F.ws + (second ? WS_SG : WS_AO)), F.in[second ? I_WUS : I_WUA], (const bf16_t*)(F.ws + (second ? WS_GS : WS_GA)), (float*)(F.ws + WS_R1), (bf16_t*)(F.ws + WS_Y), second};
    constexpr int NTM = T / 128, NTN = DM / 128;
    for (int t = blockIdx.x; t < NTM * NTN; t += F.G) gemm_simple_tile<16>(F, c, t / NTN, t % NTN);
}

struct CfgWo {
    const bf16_t* Y; const float* W; const bf16_t* H0; float* R1;
    __device__ __forceinline__ const bf16_t* arow(int row) const { return Y + (size_t)row * DM; }
    __device__ __forceinline__ const float* bptr(int) const { return W; }
    __device__ __forceinline__ int ldb() const { return DM; }
    __device__ __forceinline__ int K() const { return DM; }
    __device__ __forceinline__ void one(int row, int col, float v) const { const size_t i = (size_t)row * DM + col; R1[i] = ALPHA * bf2f(H0[i]) + v; }
    __device__ __forceinline__ void epi(int, int row, int col0, float v0, float v1) const { one(row, col0, v0); one(row, col0 + 16, v1); }
};
__device__ __forceinline__ void ph_wo(const Frame& F) {
    CfgWo c{(const bf16_t*)(F.ws + WS_Y), F.in[I_WO], (const bf16_t*)(F.ws + WS_H0), (float*)(F.ws + WS_R1)};
    constexpr int NTM = T / 128, NTN = DM / 128;
    for (int t = blockIdx.x; t < NTM * NTN; t += F.G) gemm_simple_tile<16>(F, c, t / NTN, t % NTN);
}

__device__ __forceinline__ void ph_ln1_router(const Frame& F) {
    const float* R1 = (const float*)(F.ws + WS_R1); bf16_t* H1 = (bf16_t*)(F.ws + WS_H1);
    const f32x4* g4 = (const f32x4*)F.in[I_LN1G]; const f32x4* b4 = (const f32x4*)F.in[I_LN1B];
    const float* rw = F.in[I_RW]; const float* rb = F.in[I_RB];
    int* TOPI = (int*)(F.ws + WS_TOPI); float* TOPG = (float*)(F.ws + WS_TOPG); int* TOK = (int*)(F.ws + WS_TOK);
    const int lane = F.lane;
    for (int i = blockIdx.x * 512 + F.tid; i < NROWS; i += F.G * 512) TOK[i] = T;
    if (blockIdx.x == 0) { for (int i = F.tid; i < DM / 2; i += 512) ((unsigned*)(H1 + (size_t)T * DM))[i] = 0u; }
    for (int m = F.gw; m < T; m += F.NGW) {
        const f32x4* xr = (const f32x4*)(R1 + (size_t)m * DM) + lane;
        f32x4 v[4]; float s = 0.f;
#pragma unroll
        for (int j = 0; j < 4; ++j) { v[j] = xr[64 * j]; s += (v[j][0] + v[j][1]) + (v[j][2] + v[j][3]); }
        const float mean = wave_sum(s) * (1.f / DM); float s2 = 0.f;
#pragma unroll
        for (int j = 0; j < 4; ++j) { v[j] = v[j] - mean; s2 += (v[j][0] * v[j][0] + v[j][1] * v[j][1]) + (v[j][2] * v[j][2] + v[j][3] * v[j][3]); }
        const float rstd = 1.f / sqrtf(wave_sum(s2) * (1.f / DM) + LN_EPS);
        u32x2* o = (u32x2*)(H1 + (size_t)m * DM) + lane;
        float lg[NE];
#pragma unroll
        for (int e = 0; e < NE; ++e) lg[e] = 0.f;
#pragma unroll
        for (int j = 0; j < 4; ++j) {
            const f32x4 y = v[j] * rstd * g4[lane + 64 * j] + b4[lane + 64 * j];
            u32x2 w; w.x = pk2(y[0], y[1]); w.y = pk2(y[2], y[3]); o[64 * j] = w;
#pragma unroll
            for (int i = 0; i < 4; ++i) {
                const f32x4* wr4 = (const f32x4*)(rw + (size_t)(256 * j + 4 * lane + i) * NE);
#pragma unroll
                for (int q = 0; q < 8; ++q) { const f32x4 ww = wr4[q]; lg[4 * q] += y[i] * ww[0]; lg[4 * q + 1] += y[i] * ww[1]; lg[4 * q + 2] += y[i] * ww[2]; lg[4 * q + 3] += y[i] * ww[3]; }
                asm volatile("" ::: "memory");
            }
        }
        float r16[16], r8[8], r4[4], r2[2], r1;
        { const bool hb = (lane & 32) != 0;
#pragma unroll
          for (int i = 0; i < 16; ++i) { const float keep = hb ? lg[i + 16] : lg[i], send = hb ? lg[i] : lg[i + 16]; r16[i] = keep + __shfl_xor(send, 32); } }
        { const bool hb = (lane & 16) != 0;
#pragma unroll
          for (int i = 0; i < 8; ++i) { const float keep = hb ? r16[i + 8] : r16[i], send = hb ? r16[i] : r16[i + 8]; r8[i] = keep + __shfl_xor(send, 16); } }
        { const bool hb = (lane & 8) != 0;
#pragma unroll
          for (int i = 0; i < 4; ++i) { const float keep = hb ? r8[i + 4] : r8[i], send = hb ? r8[i] : r8[i + 4]; r4[i] = keep + __shfl_xor(send, 8); } }
        { const bool hb = (lane & 4) != 0;
#pragma unroll
          for (int i = 0; i < 2; ++i) { const float keep = hb ? r4[i + 2] : r4[i], send = hb ? r4[i] : r4[i + 2]; r2[i] = keep + __shfl_xor(send, 4); } }
        { const bool hb = (lane & 2) != 0; const float keep = hb ? r2[1] : r2[0], send = hb ? r2[0] : r2[1]; r1 = keep + __shfl_xor(send, 2); }
        r1 += __shfl_xor(r1, 1);
        const int mye = (lane >> 1) & 31;
        float myv = r1 + rb[mye];
        float tv[TOPK]; int ti[TOPK];
#pragma unroll
        for (int k = 0; k < TOPK; ++k) {
            float bv = myv; int bi = mye;
#pragma unroll
            for (int o = 1; o < 64; o <<= 1) { const float ov = __shfl_xor(bv, o); const int oi = __shfl_xor(bi, o); if (ov > bv || (ov == bv && oi < bi)) { bv = ov; bi = oi; } }
            tv[k] = bv; ti[k] = bi; if (mye == bi) myv = -3.0e38f;
        }
        const float e1 = __expf(tv[1] - tv[0]), e2 = __expf(tv[2] - tv[0]), e3 = __expf(tv[3] - tv[0]);
        const float inv = 1.f / (1.f + e1 + e2 + e3);
        if (lane == 0) {
            TOPI[m * 4 + 0] = ti[0]; TOPI[m * 4 + 1] = ti[1]; TOPI[m * 4 + 2] = ti[2]; TOPI[m * 4 + 3] = ti[3];
            TOPG[m * 4 + 0] = inv; TOPG[m * 4 + 1] = e1 * inv; TOPG[m * 4 + 2] = e2 * inv; TOPG[m * 4 + 3] = e3 * inv;
#pragma unroll
            for (int k = 0; k < TOPK; ++k) atomicAdd(F.ctl + CW_COUNTS + ti[k], 1u);
        }
    }
}

__device__ __forceinline__ void load_pstart(const Frame& F) {
    LAS int* ps = (LAS int*)(F.lds + 65536);
    __syncthreads();
    if (F.tid == 0) { int acc = 0; for (int e = 0; e < NE; ++e) { ps[e] = acc; const int c = (int)__hip_atomic_load(F.ctl + CW_COUNTS + e, __ATOMIC_RELAXED, __HIP_MEMORY_SCOPE_AGENT); acc += ((c + EB - 1) / EB) * EB; } ps[NE] = acc; }
    __syncthreads();
}
__device__ __forceinline__ void ph_dest(const Frame& F) {
    load_pstart(F);
    const LAS int* ps = (const LAS int*)(F.lds + 65536);
    const int* TOPI = (const int*)(F.ws + WS_TOPI); int* DEST = (int*)(F.ws + WS_DEST); int* TOK = (int*)(F.ws + WS_TOK);
    for (int a = blockIdx.x * 512 + F.tid; a < NASSIGN; a += F.G * 512) {
        const int e = TOPI[a]; const int pos = (int)atomicAdd(F.ctl + CW_CURSOR + e, 1u); const int d = ps[e] + pos;
        TOK[d] = a >> 2; DEST[a] = d;
    }
}

struct CfgMoe1 {
    const bf16_t* H1; const int* TOK; const float* W; const float* bgu; bf16_t* ACT; const LAS int* ps;
    __device__ __forceinline__ int expert(int tm) const { const int r0 = tm * 128; int e = 0;
#pragma unroll 1
        for (int i = 1; i < NE; ++i) e += (ps[i] <= r0) ? 1 : 0; return e; }
    __device__ __forceinline__ const bf16_t* arow(int row) const { return H1 + (size_t)TOK[row] * DM; }
    __device__ __forceinline__ const float* bptr(int tm) const { return W + (size_t)expert(tm) * DM * 2 * DE; }
    __device__ __forceinline__ int ldb() const { return 2 * DE; }
    __device__ __forceinline__ int K() const { return DM; }
    __device__ __forceinline__ void epi(int tm, int row, int col0, float v0, float v1) const {
        const int e = expert(tm);
        float g = v0 + bgu[e * 2 * DE + col0], l = v1 + bgu[e * 2 * DE + DE + col0];
        g = fminf(g, SWIGLU_LIMIT); l = fminf(fmaxf(l, -SWIGLU_LIMIT), SWIGLU_LIMIT);
        ACT[(size_t)row * DE + col0] = (bf16_t)f2bf(g * sigmoid_f(SWIGLU_ALPHA * g) * (l + 1.f));
    }
};
__device__ __forceinline__ void ph_moe1(const Frame& F) {
    load_pstart(F);
    const LAS int* ps = (const LAS int*)(F.lds + 65536);
    CfgMoe1 c{(const bf16_t*)(F.ws + WS_H1), (const int*)(F.ws + WS_TOK), F.in[I_WGU], F.in[I_BGU], (bf16_t*)(F.ws + WS_ACT), ps};
    const int ntm = ps[NE] / 128; constexpr int NTN = DE / 64;
    for (int t = blockIdx.x; t < ntm * NTN; t += F.G) gemm_simple_tile<DE>(F, c, t / NTN, t % NTN);
}
struct CfgMoe2 {
    const bf16_t* ACT; const float* W; const float* bd; bf16_t* OUTS; const LAS int* ps;
    __device__ __forceinline__ int expert(int tm) const { const int r0 = tm * 128; int e = 0;
#pragma unroll 1
        for (int i = 1; i < NE; ++i) e += (ps[i] <= r0) ? 1 : 0; return e; }
    __device__ __forceinline__ const bf16_t* arow(int row) const { return ACT + (size_t)row * DE; }
    __device__ __forceinline__ const float* bptr(int tm) const { return W + (size_t)expert(tm) * DE * DM; }
    __device__ __forceinline__ int ldb() const { return DM; }
    __device__ __forceinline__ int K() const { return DE; }
    __device__ __forceinline__ void epi(int tm, int row, int col0, float v0, float v1) const {
        const int e = expert(tm);
        OUTS[(size_t)row * DM + col0] = (bf16_t)f2bf(v0 + bd[e * DM + col0]);
        OUTS[(size_t)row * DM + col0 + 16] = (bf16_t)f2bf(v1 + bd[e * DM + col0 + 16]);
    }
};
__device__ __forceinline__ void ph_moe2(const Frame& F) {
    load_pstart(F);
    const LAS int* ps = (const LAS int*)(F.lds + 65536);
    CfgMoe2 c{(const bf16_t*)(F.ws + WS_ACT), F.in[I_WD], F.in[I_BD], (bf16_t*)(F.ws + WS_OUTS), ps};
    const int ntm = ps[NE] / 128; constexpr int NTN = DM / 128;
    for (int t = blockIdx.x; t < ntm * NTN; t += F.G) gemm_simple_tile<16>(F, c, t / NTN, t % NTN);
}

__device__ __forceinline__ void ph_combine(const Frame& F) {
    const bf16_t* H1 = (const bf16_t*)(F.ws + WS_H1); const bf16_t* OUTS = (const bf16_t*)(F.ws + WS_OUTS);
    const int* DEST = (const int*)(F.ws + WS_DEST); const float* TOPG = (const float*)(F.ws + WS_TOPG);
    const f32x4* g4 = (const f32x4*)F.in[I_LN2G]; const f32x4* b4 = (const f32x4*)F.in[I_LN2B];
    const int lane = F.lane;
    for (int m = F.gw; m < T; m += F.NGW) {
        f32x4 v[4];
        const u32x2* hr = (const u32x2*)(H1 + (size_t)m * DM) + lane;
#pragma unroll
        for (int j = 0; j < 4; ++j) { const u32x2 w = hr[64 * j]; v[j] = (f32x4){bf2f(w.x & 0xffffu), bf2f(w.x >> 16), bf2f(w.y & 0xffffu), bf2f(w.y >> 16)} * ALPHA; }
#pragma unroll
        for (int k = 0; k < TOPK; ++k) {
            const int d = DEST[m * 4 + k]; const float gk = TOPG[m * 4 + k];
            const u32x2* orow = (const u32x2*)(OUTS + (size_t)d * DM) + lane;
#pragma unroll
            for (int j = 0; j < 4; ++j) { const u32x2 w = orow[64 * j]; v[j] += (f32x4){bf2f(w.x & 0xffffu), bf2f(w.x >> 16), bf2f(w.y & 0xffffu), bf2f(w.y >> 16)} * gk; }
        }
        float s = 0.f;
#pragma unroll
        for (int j = 0; j < 4; ++j) s += (v[j][0] + v[j][1]) + (v[j][2] + v[j][3]);
        const float mean = wave_sum(s) * (1.f / DM); float s2 = 0.f;
#pragma unroll
        for (int j = 0; j < 4; ++j) { v[j] = v[j] - mean; s2 += (v[j][0] * v[j][0] + v[j][1] * v[j][1]) + (v[j][2] * v[j][2] + v[j][3] * v[j][3]); }
        const float rstd = 1.f / sqrtf(wave_sum(s2) * (1.f / DM) + LN_EPS);
        f32x4* o = (f32x4*)(F.out + (size_t)m * DM) + lane;
#pragma unroll
        for (int j = 0; j < 4; ++j) o[64 * j] = v[j] * rstd * g4[lane + 64 * j] + b4[lane + 64 * j];
    }
}

constexpr int LDS_BYTES = 147456;
constexpr int MISC_OFF = 131072 + 320;
constexpr int N_PHASES = 12;

__global__ void __launch_bounds__(NWAVES * 64, 2) mega_fwd(Args args) {
    extern __shared__ __attribute__((aligned(16))) unsigned char lds[];
    Frame F;
    F.lds = (LAS unsigned char*)lds;
    F.tid = threadIdx.x; F.lane = F.tid & 63; F.wave = __builtin_amdgcn_readfirstlane(F.tid >> 6);
    F.G = gridDim.x; F.gw = blockIdx.x * NWAVES + F.wave; F.NGW = F.G * NWAVES;
    F.in = args.in; F.out = args.out; F.ws = args.ws; F.ctl = (unsigned*)(args.ws + WS_CTL);
    volatile LAS unsigned* MISC = (volatile LAS unsigned*)(F.lds + MISC_OFF);
    for (int u = F.tid; u < 64; u += NWAVES * 64) MISC[u] = 0u;
    __syncthreads();
    const int lo = args.ph_lo, hi = args.ph_hi;
    XcdBarrier bar; bar.bar = F.ctl + CW_BAR; bar.x = 0; bar.st = nullptr;
    if (hi - lo > 1) bar = xcd_barrier_post(F.ctl + CW_BAR, MISC + 8);
#define IN(k) (lo <= (k) && (k) < hi)
#define SEAM(k) do { if (IN(k) && IN((k) + 1)) xcd_barrier(bar); } while (0)
    if (IN(0)) { ph_ln_in(F); } SEAM(0);
    if (IN(1)) { ph_inproj(F); } SEAM(1);
    if (IN(2)) { if (blockIdx.x < 8) ph_ssm_simple(F); else { Frame F2 = F; F2.gw = (blockIdx.x - 8) * NWAVES + F.wave; F2.NGW = (F.G - 8) * NWAVES; ph_attn_simple(F2); } } SEAM(2);
    if (IN(3)) { ph_glu(F); } SEAM(3);
    if (IN(4)) { ph_up(F, false); } SEAM(4);
    if (IN(5)) { ph_up(F, true); } SEAM(5);
    if (IN(6)) { ph_wo(F); } SEAM(6);
    if (IN(7)) { ph_ln1_router(F); } SEAM(7);
    if (IN(8)) { ph_dest(F); } SEAM(8);
    if (IN(9)) { ph_moe1(F); } SEAM(9);
    if (IN(10)) { ph_moe2(F); } SEAM(10);
    if (IN(11)) { ph_combine(F); }
#undef IN
#undef SEAM
}

extern "C" void kernel_launch(void* const* d_in, const int* in_sizes, int n_in, void* d_out, int out_size, void* d_ws, size_t ws_size, hipStream_t stream) {
    static int grid = 0;
    if (grid == 0) {
        if (n_in != 28 || out_size != T * DM || ws_size < WS_END) { fprintf(stderr, "kernel_launch: unexpected shapes (n_in %d out %d ws %zu)\n", n_in, out_size, ws_size); grid = -1; return; }
        int dev = 0, cus = 0;
        if (hipGetDevice(&dev) != hipSuccess || hipDeviceGetAttribute(&cus, hipDeviceAttributeMultiprocessorCount, dev) != hipSuccess) { grid = -1; return; }
        if (hipFuncSetAttribute((const void*)mega_fwd, hipFuncAttributeMaxDynamicSharedMemorySize, LDS_BYTES) != hipSuccess) { fprintf(stderr, "kernel_launch: hipFuncSetAttribute failed\n"); grid = -1; return; }
        grid = cus;
    }
    if (grid < 0) return;
    (void)hipMemsetAsync((char*)d_ws + WS_CTL, 0, CTL_ZERO_BYTES, stream);
    Args a{};
    for (int i = 0; i < 28; ++i) a.in[i] = (const float*)d_in[i];
    a.out = (float*)d_out; a.ws = (unsigned char*)d_ws;
#if MK_ONE_LAUNCH
    a.ph_lo = 0; a.ph_hi = N_PHASES;
    hipLaunchKernelGGL(mega_fwd, dim3(grid), dim3(NWAVES * 64), LDS_BYTES, stream, a);
#else
    for (int p = 0; p < N_PHASES; ++p) { a.ph_lo = p; a.ph_hi = p + 1; hipLaunchKernelGGL(mega_fwd, dim3(grid), dim3(NWAVES * 64), LDS_BYTES, stream, a); }
#endif
}
```

```cpp
#include <hip/hip_runtime.h>
#include <cstdio>
#include <cstdint>

#ifndef FAST_INPROJ
#define FAST_INPROJ 1
#endif
#ifndef FAST_MID
#define FAST_MID 1
#endif
#ifndef FAST_MOE1
#define FAST_MOE1 1
#endif
#ifndef FAST_MOE2
#define FAST_MOE2 1
#endif
#define FAST_ANY (FAST_INPROJ || FAST_MID || FAST_MOE1 || FAST_MOE2)
#ifndef MK_ONE_LAUNCH
#define MK_ONE_LAUNCH 1
#endif

#define GAS __attribute__((address_space(1)))
#define LAS __attribute__((address_space(3)))
typedef unsigned short bf16_t;
typedef short bf16x8 __attribute__((ext_vector_type(8)));
typedef float f32x4 __attribute__((ext_vector_type(4)));
typedef unsigned u32x4 __attribute__((ext_vector_type(4)));
typedef unsigned u32x2 __attribute__((ext_vector_type(2)));

constexpr int BATCH = 2, SEQ = 8192, T = BATCH * SEQ, DM = 1024;
constexpr int CHUNK = 64, LEFT = 8, NCH = SEQ / CHUNK;
constexpr int NH = 8, HD = 64, AW = 512, RELMAX = 256, RELSIZE = 320;
constexpr int SW = 512, GSZ = 16, NG = 32, NP = 64;
constexpr int INW = 4096;
constexpr int NE = 32, TOPK = 4, DE = 1024, EB = 256;
constexpr int NASSIGN = T * TOPK;
constexpr int NROWS = NASSIGN + NE * EB;
constexpr float LN_EPS = 1e-5f;
constexpr float ALPHA = 1.189207115002721f;
constexpr float SWIGLU_LIMIT = 7.0f, SWIGLU_ALPHA = 1.702f;
constexpr int NWAVES = 8;
constexpr int LDS_BYTES = 147456;
constexpr int MISC_OFF = 131072 + 320, PS_OFF = 131072 + 1024, TOKL_OFF = 131072 + 2048, TOKL_UNITS = 10;

constexpr size_t MiB = 1u << 20;
constexpr size_t WS_CTL = 0, CTL_ZERO_BYTES = 1 * MiB;
constexpr size_t WS_H0 = 1 * MiB;
constexpr size_t WS_Q = 33 * MiB;
constexpr size_t WS_K = 49 * MiB;
constexpr size_t WS_V = 65 * MiB;
constexpr size_t WS_U = 81 * MiB;
constexpr size_t WS_GA = 97 * MiB;
constexpr size_t WS_GS = 129 * MiB;
constexpr size_t WS_AO = 161 * MiB;
constexpr size_t WS_GY = 177 * MiB;
constexpr size_t WS_SG = 193 * MiB;
constexpr size_t WS_Y = 209 * MiB;
constexpr size_t WS_R1 = 241 * MiB;
constexpr size_t WS_H1 = 305 * MiB;
constexpr size_t WS_TOPI = 338 * MiB;
constexpr size_t WS_TOPG = 339 * MiB;
constexpr size_t WS_DEST = 340 * MiB;
constexpr size_t WS_TOK = 341 * MiB;
constexpr size_t WS_ACT = 342 * MiB;
constexpr size_t WS_OUTS = 486 * MiB;
constexpr size_t WS_WIN = 630 * MiB;
constexpr size_t WS_WGLU = 638 * MiB;
constexpr size_t WS_WUA = 639 * MiB;
constexpr size_t WS_WUS = 640 * MiB;
constexpr size_t WS_WO = 641 * MiB;
constexpr size_t WS_WGU = 643 * MiB;
constexpr size_t WS_WD = 771 * MiB;
constexpr size_t WS_TMPB = WS_R1;
constexpr size_t WS_END = 835 * MiB;
constexpr int CW_COUNTS = 64, CW_CURSOR = 128;
constexpr int CW_BAR = 4096;

__device__ __forceinline__ unsigned f2bf(float f) { unsigned u = __float_as_uint(f); return (u + 0x7fffu + ((u >> 16) & 1u)) >> 16; }
__device__ __forceinline__ float bf2f(unsigned h) { return __uint_as_float(h << 16); }
__device__ __forceinline__ unsigned pk2(float lo, float hi) { return f2bf(lo) | (f2bf(hi) << 16); }
__device__ __forceinline__ float wave_sum(float v) {
#pragma unroll
    for (int o = 1; o < 64; o <<= 1) v += __shfl_xor(v, o);
    return v;
}
__device__ __forceinline__ float sigmoid_f(float x) { return 1.f / (1.f + __expf(-x)); }
__device__ __forceinline__ float gelu_tanh(float x) { const float z = 0.7978845608028654f * (x + 0.044715f * x * x * x); return x * sigmoid_f(2.f * z); }

__device__ __forceinline__ void sincos_d(double x, double& s, double& c) {
    const double kd = rint(x * 0.63661977236758134308);
    const int k = (int)kd;
    double r = fma(-kd, 1.57079632679489655800e+00, x);
    r = fma(-kd, 6.12323399573676603587e-17, r);
    const double r2 = r * r;
    double sp = -1.0 / 1307674368000.0;
    sp = sp * r2 + 1.0 / 6227020800.0; sp = sp * r2 - 1.0 / 39916800.0; sp = sp * r2 + 1.0 / 362880.0; sp = sp * r2 - 1.0 / 5040.0; sp = sp * r2 + 1.0 / 120.0; sp = sp * r2 - 1.0 / 6.0;
    sp = r + r * r2 * sp;
    double cp = -1.0 / 87178291200.0;
    cp = cp * r2 + 1.0 / 479001600.0; cp = cp * r2 - 1.0 / 3628800.0; cp = cp * r2 + 1.0 / 40320.0; cp = cp * r2 - 1.0 / 720.0; cp = cp * r2 + 1.0 / 24.0; cp = cp * r2 - 0.5;
    cp = 1.0 + r2 * cp;
    const int q = k & 3;
    s = (q == 0) ? sp : (q == 1) ? cp : (q == 2) ? -sp : -cp;
    c = (q == 0) ? cp : (q == 1) ? -sp : (q == 2) ? -cp : sp;
}

#define XB_TMO      128
#define XB_XCNT(j)  (256  + 64 * (j))
#define XB_XSUB(j)  (1280 + 64 * (j))
#define XB_XGEN(j)  (2304 + 64 * (j))
#define XB_TOP      3328
#define XB_TOPGEN   3392
#define XCD_BAR_WORDS 3456
#define XB_SPIN_CAP (1u << 22)
__device__ __forceinline__ unsigned xb_ld(unsigned* p)              { return __hip_atomic_load(p, __ATOMIC_RELAXED, __HIP_MEMORY_SCOPE_AGENT); }
__device__ __forceinline__ unsigned xb_add(unsigned* p, unsigned v) { return __hip_atomic_fetch_add(p, v, __ATOMIC_RELAXED, __HIP_MEMORY_SCOPE_AGENT); }
__device__ __forceinline__ unsigned xb_xcc_id() { return (unsigned)__builtin_amdgcn_s_getreg((3 << 11) | 20) & 0xFu; }
#define XB_SPIN(cond, bar) do { unsigned _sp = 0; while (cond) { __builtin_amdgcn_s_sleep(1); \
    if ((++_sp & 255u) == 0u) { if (xb_ld(&(bar)[XB_TMO])) break; if (_sp > XB_SPIN_CAP) { atomicAdd(&(bar)[XB_TMO], 1u); break; } } } } while (0)
struct XcdBarrier { unsigned* bar; unsigned x; volatile LAS unsigned* st; };
__device__ __forceinline__ XcdBarrier xcd_barrier_post(unsigned* bar, volatile LAS unsigned* st) {
    XcdBarrier b; b.bar = bar; b.x = xb_xcc_id(); b.st = st;
    if (threadIdx.x == 0) (void)xb_add(&bar[XB_XCNT(b.x)], 1u);
    return b;
}
__device__ __forceinline__ void xcd_barrier_complete(unsigned* bar, unsigned x, unsigned& nloc, unsigned& nx) {
    const unsigned G = gridDim.x * gridDim.y * gridDim.z;
    unsigned sum, cnt, mine, sp = 0u;
    for (;;) {
        sum = 0u; cnt = 0u; mine = 0u;
#pragma unroll
        for (unsigned j = 0; j < 16; ++j) { const unsigned c = xb_ld(&bar[XB_XCNT(j)]); sum += c; cnt += (c > 0u) ? 1u : 0u; mine = (j == x) ? c : mine; }
        if (sum == G) break;
        __builtin_amdgcn_s_sleep(1);
        if ((++sp & 255u) == 0u) { if (xb_ld(&bar[XB_TMO])) break; if (sp > XB_SPIN_CAP) { atomicAdd(&bar[XB_TMO], 1u); break; } }
    }
    nloc = mine > 0u ? mine : 1u; nx = cnt > 0u ? cnt : 1u;
}
__device__ __forceinline__ void xcd_barrier(const XcdBarrier& b) {
    asm volatile("s_waitcnt vmcnt(0)" ::: "memory");
    __syncthreads();
    if (threadIdx.x == 0) {
        unsigned* bar = b.bar;
        __builtin_amdgcn_s_waitcnt(0);
        unsigned nloc = b.st[0], nx = b.st[1];
        if (nloc == 0u) { xcd_barrier_complete(bar, b.x, nloc, nx); b.st[0] = nloc; b.st[1] = nx; }
        const unsigned old = xb_add(&bar[XB_XSUB(b.x)], 1u);
        const unsigned gen = old / nloc;
        if (old + 1u == (gen + 1u) * nloc) {
            __builtin_amdgcn_fence(__ATOMIC_RELEASE, "agent");
            asm volatile("s_waitcnt vmcnt(0)" ::: "memory");
            const unsigned og = xb_add(&bar[XB_TOP], 1u);
            const unsigned tg = og / nx;
            if (og + 1u == (tg + 1u) * nx) xb_add(&bar[XB_TOPGEN], 1u);
            else XB_SPIN(xb_ld(&bar[XB_TOPGEN]) == tg, bar);
            __builtin_amdgcn_fence(__ATOMIC_ACQUIRE, "agent");
            xb_add(&bar[XB_XGEN(b.x)], 1u);
            asm volatile("s_waitcnt vmcnt(0)" ::: "memory");
        } else {
            XB_SPIN(xb_ld(&bar[XB_XGEN(b.x)]) == gen, bar);
            __builtin_amdgcn_fence(__ATOMIC_ACQUIRE, "agent");
            asm volatile("s_waitcnt vmcnt(0)" ::: "memory");
        }
    }
    __syncthreads();
}


namespace pg8 {
#define PG8_LAS __attribute__((address_space(3)))
constexpr int BM = 256, BK = 64, HALF = 128, HTB = HALF * BK * 2, STAGE_BYTES = 8 * HTB, NXCD = 8, WGM = 8;
__host__ __device__ __forceinline__ int lds_byte(int r, int c) { const int st = (r >> 4) * 2 + (c >> 5), rr = r & 15, cc = c & 31, ob = rr * 64 + cc * 2; return st * 1024 + (ob ^ (((ob >> 9) & 1) << 5)); }
__host__ __device__ __forceinline__ void stage_rc(int b, int& R, int& C) { const int st = b / 1024, sb = b % 1024, swz = sb ^ (((sb >> 9) & 1) << 5); R = (st >> 1) * 16 + swz / 64; C = (st & 1) * 32 + (swz % 64) / 2; }
__host__ __device__ __forceinline__ int perm32(int rho) { const int n = rho >> 4, i = rho & 15; return 8 * (i >> 2) + 4 * n + (i & 3); }
struct Unit { int pm, pn, bn, ex; };
struct Gemm { const bf16_t* A; const bf16_t* Bt; int K; };
struct StaticOrder {
    int nM, nN, nwg, G, c;
    __device__ void init(int nM_, int nN_, int G_, int c_) { nM = nM_; nN = nN_; nwg = nM * nN; G = G_; c = c_; }
    __device__ bool next(int i, Unit& u) const {
        const long L = (long)i * G + c; if (L >= nwg) return false;
        int wgid = (int)L; { const int q = nwg / NXCD, r = nwg % NXCD, xcd = wgid % NXCD, off = wgid / NXCD; wgid = (xcd < r ? xcd * (q + 1) : r * (q + 1) + (xcd - r) * q) + off; }
        const int nig = WGM * nN, gid = wgid / nig, fm = gid * WGM, gsz = (nM - fm) < WGM ? (nM - fm) : WGM;
        u.pm = fm + ((wgid % nig) % gsz); u.pn = (wgid % nig) / gsz; u.bn = u.pn; u.ex = 0; return true;
    }
    __device__ __forceinline__ unsigned rowoff(int, int) const { return 0u; }
};
__device__ __forceinline__ unsigned cvt_pk_bf16(float lo, float hi) { unsigned r; asm volatile("v_cvt_pk_bf16_f32 %0, %1, %2" : "=v"(r) : "v"(lo), "v"(hi)); return r; }

template <class Epi, class Sched, bool GATHER>
__device__ __forceinline__ void gemm_phase(PG8_LAS unsigned char* lds, const Gemm g, const Sched& S, const Epi& E) {
    const int tid = threadIdx.x, wid = __builtin_amdgcn_readfirstlane(tid >> 6), lane = tid & 63, wr = wid >> 2, wc = wid & 3, fr = lane & 15, fq = lane >> 4;
    const int K = g.K, nt = K / BK;
    unsigned voffA0[2], voffA1[2], voffB[2];
#pragma unroll
    for (int i = 0; i < 2; ++i) { int R, C; stage_rc(tid * 16 + i * 8192, R, C); const int Rb = Epi::PERM ? ((R & ~31) + perm32(R & 31)) : R;
        voffA0[i] = (unsigned)(R * K + C) * 2u; voffA1[i] = voffA0[i] + (unsigned)(HALF * K * 2); voffB[i] = (unsigned)(Rb * K + C) * 2u; }
    const size_t kstep = (size_t)(BK * 2);
    const size_t hstep = (size_t)HALF * K * 2;
    const size_t tstep = 2 * hstep;
    const unsigned ldsw = (unsigned)wid * 1024u;
    const int aoff = lds_byte(wr * 64 + fr, fq * 8), boff = lds_byte(wc * 32 + fr, fq * 8);
#define PG8_SA(b, h) (((b) * 2 + (h)) * HTB)
#define PG8_SB(b, h) ((4 + (b) * 2 + (h)) * HTB)
#define PG8_STAGE(bufoff, gbase, voff) do { _Pragma("unroll") for (int _i = 0; _i < 2; ++_i) \
        __builtin_amdgcn_global_load_lds((const unsigned*)((const char*)(gbase) + (voff)[_i]), (PG8_LAS unsigned*)(lds + (bufoff) + ldsw + _i * 8192), 16, 0, 0); } while (0)
#define PG8_LDA(dst, b, h) do { _Pragma("unroll") for (int m = 0; m < 4; ++m) _Pragma("unroll") for (int k = 0; k < 2; ++k) dst[m][k] = *(const PG8_LAS bf16x8*)(lds + PG8_SA(b, h) + aoff + m * 2048 + k * 1024); } while (0)
#define PG8_LDB(dst, b, h) do { _Pragma("unroll") for (int n = 0; n < 2; ++n) _Pragma("unroll") for (int k = 0; k < 2; ++k) dst[n][k] = *(const PG8_LAS bf16x8*)(lds + PG8_SB(b, h) + boff + n * 2048 + k * 1024); } while (0)
#define PG8_MMA(ai, bj, At, Bt) do { __builtin_amdgcn_s_setprio(1); _Pragma("unroll") for (int m = 0; m < 4; ++m) _Pragma("unroll") for (int n = 0; n < 2; ++n) _Pragma("unroll") for (int k = 0; k < 2; ++k) \
        acc[ai][bj][m][n] = __builtin_amdgcn_mfma_f32_16x16x32_bf16(Bt[n][k], At[m][k], acc[ai][bj][m][n], 0, 0, 0); __builtin_amdgcn_s_setprio(0); } while (0)
#define PG8_WAIT_V(n) asm volatile("s_waitcnt vmcnt(" #n ")" ::: "memory")
#define PG8_WAIT_L(n) asm volatile("s_waitcnt lgkmcnt(" #n ")" ::: "memory")
#define PG8_BAR __builtin_amdgcn_s_barrier()
#define PG8_SCHED __builtin_amdgcn_sched_barrier(0)
#define PG8_GOFF(ui_) do { if constexpr (GATHER) { _Pragma("unroll") for (int _i = 0; _i < 2; ++_i) { int R_, C_; stage_rc(tid * 16 + _i * 8192, R_, C_); \
        voffA0[_i] = S.rowoff((ui_), R_) + (unsigned)(C_ * 2); voffA1[_i] = S.rowoff((ui_), HALF + R_) + (unsigned)(C_ * 2); } } } while (0)
    Unit cur, nxt; int ui = 0;
    if (!S.next(0, cur)) return;
    f32x4 acc[2][2][4][2];
#pragma unroll
    for (int a = 0; a < 2; ++a)
#pragma unroll
        for (int b = 0; b < 2; ++b)
#pragma unroll
            for (int m = 0; m < 4; ++m)
#pragma unroll
                for (int n = 0; n < 2; ++n) acc[a][b][m][n] = (f32x4){0.f, 0.f, 0.f, 0.f};
    bf16x8 At[4][2], B0[2][2], B1[2][2];
    PG8_GOFF(0);
    const char* cA = GATHER ? (const char*)g.A : (const char*)g.A + (size_t)cur.pm * tstep; const char* cB = (const char*)g.Bt + (size_t)cur.bn * tstep;
    PG8_STAGE(PG8_SB(0, 0), cB, voffB); PG8_STAGE(PG8_SB(0, 1), cB + hstep, voffB); PG8_STAGE(PG8_SA(0, 0), cA, voffA0); PG8_STAGE(PG8_SA(0, 1), cA, voffA1);
    if (wr == 1) PG8_BAR;
    PG8_WAIT_V(2); PG8_BAR;
    PG8_STAGE(PG8_SB(1, 0), cB + kstep, voffB); PG8_STAGE(PG8_SA(1, 0), cA + kstep, voffA0); PG8_STAGE(PG8_SB(1, 1), cB + hstep + kstep, voffB);
    PG8_WAIT_V(6); PG8_BAR;
    for (;;) {
        const bool has_next = S.next(ui + 1, nxt);
        const char* nA = GATHER ? (const char*)g.A : (has_next ? (const char*)g.A + (size_t)nxt.pm * tstep : cA);
        const char* nB = has_next ? (const char*)g.Bt + (size_t)nxt.bn * tstep : cB;
        for (int t = 0; t < nt; t += 2) {
            const bool last = (t == nt - 2);
            const char* a1 = cA + (size_t)(t + 1) * kstep;
            const char* a2 = last ? nA : cA + (size_t)(t + 2) * kstep; const char* b2 = last ? nB : cB + (size_t)(t + 2) * kstep;
            const char* a3 = a2 + kstep; const char* b3 = b2 + kstep;
            PG8_LDB(B0, 0, 0); PG8_LDB(B1, 0, 1); PG8_SCHED; PG8_LDA(At, 0, 0); PG8_STAGE(PG8_SA(1, 1), a1, voffA1);
            if (GATHER && last && has_next) { PG8_GOFF(ui + 1); }
            PG8_WAIT_V(8); PG8_WAIT_L(0); PG8_BAR; PG8_MMA(0, 0, At, B0); PG8_MMA(0, 1, At, B1); PG8_BAR; PG8_SCHED;
            PG8_LDA(At, 0, 1); PG8_STAGE(PG8_SB(0, 0), b2, voffB); PG8_STAGE(PG8_SB(0, 1), b2 + hstep, voffB); PG8_STAGE(PG8_SA(0, 0), a2, voffA0);
            PG8_WAIT_V(8); PG8_WAIT_L(0); PG8_BAR; PG8_MMA(1, 0, At, B0); PG8_MMA(1, 1, At, B1); PG8_BAR; PG8_SCHED;
            PG8_LDB(B0, 1, 0); PG8_LDB(B1, 1, 1); PG8_SCHED; PG8_LDA(At, 1, 0); PG8_STAGE(PG8_SA(0, 1), a2, voffA1);
            PG8_WAIT_V(8); PG8_WAIT_L(0); PG8_BAR; PG8_MMA(0, 0, At, B0); PG8_MMA(0, 1, At, B1); PG8_BAR; PG8_SCHED;
            PG8_LDA(At, 1, 1); PG8_STAGE(PG8_SB(1, 0), b3, voffB); PG8_STAGE(PG8_SB(1, 1), b3 + hstep, voffB); PG8_STAGE(PG8_SA(1, 0), a3, voffA0);
            PG8_WAIT_V(8); PG8_WAIT_L(0); PG8_BAR; PG8_MMA(1, 0, At, B0); PG8_MMA(1, 1, At, B1); PG8_BAR; PG8_SCHED;
        }
        if (wr == 0) PG8_BAR;
        E(acc, cur, wr, wc, fr, fq);
        if (!has_next) break;
#pragma unroll
        for (int a = 0; a < 2; ++a)
#pragma unroll
            for (int b = 0; b < 2; ++b)
#pragma unroll
                for (int m = 0; m < 4; ++m)
#pragma unroll
                    for (int n = 0; n < 2; ++n) acc[a][b][m][n] = (f32x4){0.f, 0.f, 0.f, 0.f};
        cur = nxt; cA = nA; cB = nB; ++ui;
        if (wr == 1) PG8_BAR;
    }
    PG8_WAIT_V(0);
    PG8_BAR;
#undef PG8_SA
#undef PG8_SB
#undef PG8_STAGE
#undef PG8_LDA
#undef PG8_LDB
#undef PG8_MMA
#undef PG8_WAIT_V
#undef PG8_WAIT_L
#undef PG8_BAR
#undef PG8_SCHED
#undef PG8_GOFF
}
}

struct Args {
    const float* in[28];
    float* out; unsigned char* ws;
    int ph_lo, ph_hi;
};
enum { I_X = 0, I_LNIG, I_LNIB, I_WIN, I_BGATE, I_RELB, I_LAMRE, I_LAMIM, I_LOGDT, I_BRE, I_BIM, I_CRE, I_CIM, I_SSMD, I_WGLU, I_WUA, I_WUS, I_WO,
       I_LN1G, I_LN1B, I_RW, I_RB, I_WGU, I_BGU, I_WD, I_BD, I_LN2G, I_LN2B };

struct Frame {
    LAS unsigned char* lds;
    int tid, lane, wave, G, gw, NGW;
    const float* const* in;
    float* out; unsigned char* ws;
    unsigned* ctl;
};

template <int PS> __device__ __forceinline__ int colbase(int tn, int wc) { return PS == 16 ? tn * 128 + wc * 32 : tn * 64 + wc * 16; }

template <int PS, class Cfg>
__device__ __forceinline__ void gemm_simple_tile(const Frame& F, const Cfg& c, int tm, int tn) {
    LAS bf16_t* As = (LAS bf16_t*)F.lds;
    LAS bf16_t* Bs = As + 128 * 40;
    const int tid = F.tid, lane = F.lane, w = F.wave, wr = w >> 2, wc = w & 3;
    f32x4 acc[4][2];
#pragma unroll
    for (int m = 0; m < 4; ++m)
#pragma unroll
        for (int n = 0; n < 2; ++n) acc[m][n] = (f32x4){0.f, 0.f, 0.f, 0.f};
    const int ar = tid >> 2, ak = (tid & 3) * 8;
    const bf16_t* ap = c.arow(tm * 128 + ar) + ak;
    const int bk = tid >> 4, bc = (tid & 15) * 8;
    const int pc = colbase<PS>(tn, bc >> 5) + ((bc >> 4) & 1) * PS + (bc & 15);
    const int ldb = c.ldb();
    const float* bp = c.bptr(tm) + (size_t)bk * ldb + pc;
    const int K = c.K();
    for (int k0 = 0; k0 < K; k0 += 32) {
        const u32x4 av = *(const u32x4*)(ap + k0);
        const f32x4 b0 = *(const f32x4*)(bp + (size_t)k0 * ldb), b1 = *(const f32x4*)(bp + (size_t)k0 * ldb + 4);
        __syncthreads();
        *(LAS u32x4*)(As + ar * 40 + ak) = av;
        Bs[(bc + 0) * 40 + bk] = (bf16_t)f2bf(b0[0]); Bs[(bc + 1) * 40 + bk] = (bf16_t)f2bf(b0[1]);
        Bs[(bc + 2) * 40 + bk] = (bf16_t)f2bf(b0[2]); Bs[(bc + 3) * 40 + bk] = (bf16_t)f2bf(b0[3]);
        Bs[(bc + 4) * 40 + bk] = (bf16_t)f2bf(b1[0]); Bs[(bc + 5) * 40 + bk] = (bf16_t)f2bf(b1[1]);
        Bs[(bc + 6) * 40 + bk] = (bf16_t)f2bf(b1[2]); Bs[(bc + 7) * 40 + bk] = (bf16_t)f2bf(b1[3]);
        __syncthreads();
        bf16x8 a[4], b[2];
#pragma unroll
        for (int m = 0; m < 4; ++m) a[m] = *(const LAS bf16x8*)(As + (wr * 64 + m * 16 + (lane & 15)) * 40 + (lane >> 4) * 8);
#pragma unroll
        for (int n = 0; n < 2; ++n) b[n] = *(const LAS bf16x8*)(Bs + (wc * 32 + n * 16 + (lane & 15)) * 40 + (lane >> 4) * 8);
#pragma unroll
        for (int m = 0; m < 4; ++m)
#pragma unroll
            for (int n = 0; n < 2; ++n) acc[m][n] = __builtin_amdgcn_mfma_f32_16x16x32_bf16(a[m], b[n], acc[m][n], 0, 0, 0);
    }
    const int col0 = colbase<PS>(tn, wc) + (lane & 15);
#pragma unroll
    for (int m = 0; m < 4; ++m)
#pragma unroll
        for (int r = 0; r < 4; ++r) {
            const int row = tm * 128 + wr * 64 + m * 16 + (lane >> 4) * 4 + r;
            c.epi(tm, row, col0, acc[m][0][r], acc[m][1][r]);
        }
    __syncthreads();
}


__device__ __forceinline__ void store8(bf16_t* p, const f32x4 v0, const f32x4 v1) {
    u32x4 w; w.x = pg8::cvt_pk_bf16(v0[0], v0[1]); w.y = pg8::cvt_pk_bf16(v0[2], v0[3]); w.z = pg8::cvt_pk_bf16(v1[0], v1[1]); w.w = pg8::cvt_pk_bf16(v1[2], v1[3]);
    *(u32x4*)p = w;
}
__device__ __forceinline__ void load8(const bf16_t* p, f32x4& v0, f32x4& v1) {
    const u32x4 w = *(const u32x4*)p;
    v0 = (f32x4){bf2f(w.x & 0xffffu), bf2f(w.x >> 16), bf2f(w.y & 0xffffu), bf2f(w.y >> 16)};
    v1 = (f32x4){bf2f(w.z & 0xffffu), bf2f(w.z >> 16), bf2f(w.w & 0xffffu), bf2f(w.w >> 16)};
}
__device__ __forceinline__ f32x4 sigmoid4(const f32x4 v) { return (f32x4){sigmoid_f(v[0]), sigmoid_f(v[1]), sigmoid_f(v[2]), sigmoid_f(v[3])}; }

struct EpiInProj {
    static constexpr bool PERM = true;
    bf16_t *Q, *Kb, *V, *U, *GA, *GS; const float* bgate;
    __device__ __forceinline__ void operator()(const f32x4 (&acc)[2][2][4][2], const pg8::Unit& u, int wr, int wc, int fr, int fq) const {
        const int pn = u.pn, row0 = u.pm * 256 + wr * 64 + fr, colin = wc * 32 + 8 * fq;
        bf16_t* base; int ld, cb; float sc = 1.f; const bool gate = pn >= 8;
        if (pn < 8) { base = pn < 2 ? Q : (pn < 4 ? Kb : (pn < 6 ? V : U)); ld = 512; cb = (pn & 1) * 256; if (pn < 2) sc = 0.125f; }
        else { base = pn < 12 ? GA : GS; ld = 1024; cb = (pn & 3) * 256; }
#pragma unroll
        for (int bj = 0; bj < 2; ++bj) {
            f32x4 b0 = (f32x4){0.f, 0.f, 0.f, 0.f}, b1 = b0;
            if (gate) { const float* bp = bgate + (pn - 8) * 256 + bj * 128 + colin; b0 = *(const f32x4*)bp; b1 = *(const f32x4*)(bp + 4); }
#pragma unroll
            for (int ai = 0; ai < 2; ++ai)
#pragma unroll
                for (int m = 0; m < 4; ++m) {
                    f32x4 v0 = acc[ai][bj][m][0], v1 = acc[ai][bj][m][1];
                    if (gate) { v0 = sigmoid4(v0 + b0); v1 = sigmoid4(v1 + b1); } else { v0 = v0 * sc; v1 = v1 * sc; }
                    store8(base + (size_t)(row0 + ai * 128 + m * 16) * ld + cb + bj * 128 + colin, v0, v1);
                }
        }
    }
};
struct EpiGlu {
    static constexpr bool PERM = true;
    bf16_t* SGo;
    __device__ __forceinline__ void operator()(const f32x4 (&acc)[2][2][4][2], const pg8::Unit& u, int wr, int wc, int fr, int fq) const {
        const int row0 = u.pm * 256 + wr * 64 + fr, col = u.pn * 128 + wc * 32 + 8 * fq;
#pragma unroll
        for (int ai = 0; ai < 2; ++ai)
#pragma unroll
            for (int m = 0; m < 4; ++m)
                store8(SGo + (size_t)(row0 + ai * 128 + m * 16) * SW + col, acc[ai][0][m][0] * sigmoid4(acc[ai][1][m][0]), acc[ai][0][m][1] * sigmoid4(acc[ai][1][m][1]));
    }
};
struct EpiUp {
    static constexpr bool PERM = true;
    const bf16_t* gate; bf16_t* tmp; bf16_t* Y; bool second;
    __device__ __forceinline__ void operator()(const f32x4 (&acc)[2][2][4][2], const pg8::Unit& u, int wr, int wc, int fr, int fq) const {
        const int row0 = u.pm * 256 + wr * 64 + fr, col0 = u.pn * 256 + wc * 32 + 8 * fq;
#pragma unroll
        for (int ai = 0; ai < 2; ++ai)
#pragma unroll
            for (int m = 0; m < 4; ++m)
#pragma unroll
                for (int bj = 0; bj < 2; ++bj) {
                    const size_t off = (size_t)(row0 + ai * 128 + m * 16) * DM + col0 + bj * 128;
                    f32x4 g0, g1; load8(gate + off, g0, g1);
                    f32x4 v0 = g0 * acc[ai][bj][m][0], v1 = g1 * acc[ai][bj][m][1];
                    if (second) { f32x4 t0, t1; load8(tmp + off, t0, t1); store8(Y + off, v0 + t0, v1 + t1); }
                    else store8(tmp + off, v0, v1);
                }
    }
};
struct EpiWo {
    static constexpr bool PERM = false;
    const bf16_t* H0; float* R1;
    __device__ __forceinline__ void operator()(const f32x4 (&acc)[2][2][4][2], const pg8::Unit& u, int wr, int wc, int fr, int fq) const {
        const int row0 = u.pm * 256 + wr * 64 + fr, col0 = u.pn * 256 + wc * 32 + 4 * fq;
#pragma unroll
        for (int ai = 0; ai < 2; ++ai)
#pragma unroll
            for (int m = 0; m < 4; ++m)
#pragma unroll
                for (int bj = 0; bj < 2; ++bj)
#pragma unroll
                    for (int n = 0; n < 2; ++n) {
                        const size_t off = (size_t)(row0 + ai * 128 + m * 16) * DM + col0 + bj * 128 + n * 16;
                        const u32x2 w = *(const u32x2*)(H0 + off);
                        const f32x4 h = (f32x4){bf2f(w.x & 0xffffu), bf2f(w.x >> 16), bf2f(w.y & 0xffffu), bf2f(w.y >> 16)};
                        *(f32x4*)(R1 + off) = h * ALPHA + acc[ai][bj][m][n];
                    }
    }
};
struct EpiMoe1 {
    static constexpr bool PERM = true;
    const float* bgu; bf16_t* ACT;
    __device__ __forceinline__ void operator()(const f32x4 (&acc)[2][2][4][2], const pg8::Unit& u, int wr, int wc, int fr, int fq) const {
        const int row0 = u.pm * 256 + wr * 64 + fr, col = u.pn * 128 + wc * 32 + 8 * fq;
        const float* bp = bgu + (size_t)u.ex * 2 * DE + col;
        const f32x4 bg0 = *(const f32x4*)bp, bg1 = *(const f32x4*)(bp + 4), bl0 = *(const f32x4*)(bp + DE), bl1 = *(const f32x4*)(bp + DE + 4);
#pragma unroll
        for (int ai = 0; ai < 2; ++ai)
#pragma unroll
            for (int m = 0; m < 4; ++m) {
                f32x4 o[2];
#pragma unroll
                for (int n = 0; n < 2; ++n) {
                    const f32x4 gv = acc[ai][0][m][n] + (n ? bg1 : bg0), lv = acc[ai][1][m][n] + (n ? bl1 : bl0);
#pragma unroll
                    for (int j = 0; j < 4; ++j) { const float gg = fminf(gv[j], SWIGLU_LIMIT), ll = fminf(fmaxf(lv[j], -SWIGLU_LIMIT), SWIGLU_LIMIT); o[n][j] = gg * sigmoid_f(SWIGLU_ALPHA * gg) * (ll + 1.f); }
                }
                store8(ACT + (size_t)(row0 + ai * 128 + m * 16) * DE + col, o[0], o[1]);
            }
    }
};
struct EpiMoe2 {
    static constexpr bool PERM = true;
    const float* bd; bf16_t* OUTS;
    __device__ __forceinline__ void operator()(const f32x4 (&acc)[2][2][4][2], const pg8::Unit& u, int wr, int wc, int fr, int fq) const {
        const int row0 = u.pm * 256 + wr * 64 + fr, col0 = u.pn * 256 + wc * 32 + 8 * fq;
#pragma unroll
        for (int bj = 0; bj < 2; ++bj) {
            const float* bp = bd + (size_t)u.ex * DM + col0 + bj * 128;
            const f32x4 b0 = *(const f32x4*)bp, b1 = *(const f32x4*)(bp + 4);
#pragma unroll
            for (int ai = 0; ai < 2; ++ai)
#pragma unroll
                for (int m = 0; m < 4; ++m)
                    store8(OUTS + (size_t)(row0 + ai * 128 + m * 16) * DM + col0 + bj * 128, acc[ai][bj][m][0] + b0, acc[ai][bj][m][1] + b1);
        }
    }
};
struct MoeOrder {
    pg8::StaticOrder so; const LAS int* ps; const LAS unsigned* tokl; int bt_per_e;
    __device__ __forceinline__ bool next(int i, pg8::Unit& u) const {
        if (!so.next(i, u)) return false;
        int e = 0; const int r0 = u.pm * 256;
#pragma unroll 1
        for (int k = 1; k < NE; ++k) e += (ps[k] <= r0) ? 1 : 0;
        e = __builtin_amdgcn_readfirstlane(e);
        u.ex = e; u.bn = e * bt_per_e + u.pn; return true;
    }
    __device__ __forceinline__ unsigned rowoff(int ui, int r) const { return tokl[ui * 256 + r]; }
};
__device__ __forceinline__ void ph_ln_in(const Frame& F) {
    const float* x = F.in[I_X]; const f32x4* g4 = (const f32x4*)F.in[I_LNIG]; const f32x4* b4 = (const f32x4*)F.in[I_LNIB];
    bf16_t* H0 = (bf16_t*)(F.ws + WS_H0);
    for (int m = F.gw; m < T; m += F.NGW) {
        const f32x4* xr = (const f32x4*)(x + (size_t)m * DM) + F.lane;
        f32x4 v[4]; float s = 0.f;
#pragma unroll
        for (int j = 0; j < 4; ++j) { v[j] = xr[64 * j]; s += (v[j][0] + v[j][1]) + (v[j][2] + v[j][3]); }
        const float mean = wave_sum(s) * (1.f / DM); float s2 = 0.f;
#pragma unroll
        for (int j = 0; j < 4; ++j) { v[j] = v[j] - mean; s2 += (v[j][0] * v[j][0] + v[j][1] * v[j][1]) + (v[j][2] * v[j][2] + v[j][3] * v[j][3]); }
        const float rstd = 1.f / sqrtf(wave_sum(s2) * (1.f / DM) + LN_EPS);
        u32x2* o = (u32x2*)(H0 + (size_t)m * DM) + F.lane;
#pragma unroll
        for (int j = 0; j < 4; ++j) { const f32x4 y = v[j] * rstd * g4[F.lane + 64 * j] + b4[F.lane + 64 * j]; u32x2 w; w.x = pk2(y[0], y[1]); w.y = pk2(y[2], y[3]); o[64 * j] = w; }
    }
}

struct CfgInProj {
    const bf16_t* H0; const float* W; const float* bgate; bf16_t *Q, *Kb, *V, *U, *GA, *GS;
    __device__ __forceinline__ const bf16_t* arow(int row) const { return H0 + (size_t)row * DM; }
    __device__ __forceinline__ const float* bptr(int) const { return W; }
    __device__ __forceinline__ int ldb() const { return INW; }
    __device__ __forceinline__ int K() const { return DM; }
    __device__ __forceinline__ void one(int row, int col, float v) const {
        if (col < 512) Q[(size_t)row * AW + col] = (bf16_t)f2bf(v * 0.125f);
        else if (col < 1024) Kb[(size_t)row * AW + col - 512] = (bf16_t)f2bf(v);
        else if (col < 1536) V[(size_t)row * AW + col - 1024] = (bf16_t)f2bf(v);
        else if (col < 2048) U[(size_t)row * SW + col - 1536] = (bf16_t)f2bf(v);
        else if (col < 3072) GA[(size_t)row * DM + col - 2048] = (bf16_t)f2bf(sigmoid_f(v + bgate[col - 2048]));
        else GS[(size_t)row * DM + col - 3072] = (bf16_t)f2bf(sigmoid_f(v + bgate[col - 2048]));
    }
    __device__ __forceinline__ void epi(int, int row, int col0, float v0, float v1) const { one(row, col0, v0); one(row, col0 + 16, v1); }
};
__device__ __forceinline__ void ph_inproj(const Frame& F) {
    CfgInProj c{(const bf16_t*)(F.ws + WS_H0), F.in[I_WIN], F.in[I_BGATE], (bf16_t*)(F.ws + WS_Q), (bf16_t*)(F.ws + WS_K), (bf16_t*)(F.ws + WS_V), (bf16_t*)(F.ws + WS_U),
                (bf16_t*)(F.ws + WS_GA), (bf16_t*)(F.ws + WS_GS)};
    constexpr int NTM = T / 128, NTN = INW / 128;
    for (int t = blockIdx.x; t < NTM * NTN; t += F.G) gemm_simple_tile<16>(F, c, t / NTN, t % NTN);
}

__device__ __forceinline__ void ph_attn_simple(const Frame& F) {
    const bf16_t* Q = (const bf16_t*)(F.ws + WS_Q); const bf16_t* Kb = (const bf16_t*)(F.ws + WS_K); const bf16_t* V = (const bf16_t*)(F.ws + WS_V);
    bf16_t* AO = (bf16_t*)(F.ws + WS_AO); const float* relb = F.in[I_RELB];
    const int lane = F.lane;
    for (int it = F.gw; it < T * NH; it += F.NGW) {
        const int m = it / NH, h = it % NH, b = m / SEQ, t = m % SEQ, n = t / CHUNK;
        const float q = bf2f(Q[(size_t)m * AW + h * HD + lane]);
        const int k0 = (n - LEFT) * CHUNK < 0 ? 0 : (n - LEFT) * CHUNK, k1 = n * CHUNK + CHUNK;
        float mx = -1e30f, l = 0.f, o = 0.f;
        for (int kp = k0; kp < k1; ++kp) {
            const size_t kr = (size_t)(b * SEQ + kp) * AW + h * HD + lane;
            float s = wave_sum(q * bf2f(Kb[kr]));
            int dist = t - kp; dist = dist < -(CHUNK - 1) ? -(CHUNK - 1) : (dist > RELMAX ? RELMAX : dist);
            s += relb[h * RELSIZE + dist + (CHUNK - 1)];
            const float mn = fmaxf(mx, s), a = __expf(mx - mn), pp = __expf(s - mn);
            l = l * a + pp; o = o * a + pp * bf2f(V[kr]); mx = mn;
        }
        AO[(size_t)m * AW + h * HD + lane] = (bf16_t)f2bf(o / l);
    }
}

__device__ __forceinline__ void ph_ssm_simple(const Frame& F) {
    const bf16_t* U = (const bf16_t*)(F.ws + WS_U); bf16_t* GY = (bf16_t*)(F.ws + WS_GY);
    const int lane = F.lane;
    for (int it = F.gw; it < BATCH * NG; it += F.NGW) {
        const int b = it / NG, g = it % NG;
        const double lre = (double)F.in[I_LAMRE][g * NP + lane], lim = (double)F.in[I_LAMIM][g * NP + lane];
        const double dt = (double)expf(F.in[I_LOGDT][g]);
        const double er = (double)expf((float)(lre * dt));
        double sn, cs; sincos_d(lim * dt, sn, cs);
        const double lbr_d = er * cs, lbi_d = er * sn;
        const double nr = lbr_d - 1.0, ni = lbi_d, den = lre * lre + lim * lim;
        const double cr = (nr * lre + ni * lim) / den, ci = (ni * lre - nr * lim) / den;
        const float lbr = (float)lbr_d, lbi = (float)lbi_d;
        float Bre[GSZ], Bim[GSZ], Cre[GSZ], Cim[GSZ];
#pragma unroll
        for (int c = 0; c < GSZ; ++c) {
            const double br = (double)F.in[I_BRE][(g * NP + lane) * GSZ + c], bi = (double)F.in[I_BIM][(g * NP + lane) * GSZ + c];
            Bre[c] = (float)(cr * br - ci * bi); Bim[c] = (float)(cr * bi + ci * br);
            Cre[c] = F.in[I_CRE][(g * GSZ + c) * NP + lane]; Cim[c] = F.in[I_CIM][(g * GSZ + c) * NP + lane];
        }
        const float dsk = F.in[I_SSMD][g * GSZ + (lane & 15)];
        float xr = 0.f, xi = 0.f;
        for (int t = 0; t < SEQ; ++t) {
            const bf16_t* up = U + (size_t)(b * SEQ + t) * SW + g * GSZ;
            const u32x4 u0 = *(const u32x4*)up, u1 = *(const u32x4*)(up + 8);
            float u[GSZ];
#pragma unroll
            for (int i = 0; i < 4; ++i) { u[2 * i] = bf2f(u0[i] & 0xffffu); u[2 * i + 1] = bf2f(u0[i] >> 16); u[8 + 2 * i] = bf2f(u1[i] & 0xffffu); u[8 + 2 * i + 1] = bf2f(u1[i] >> 16); }
            float br = 0.f, bi = 0.f;
#pragma unroll
            for (int c = 0; c < GSZ; ++c) { br += Bre[c] * u[c]; bi += Bim[c] * u[c]; }
            const float nxr = lbr * xr - lbi * xi + br, nxi = lbr * xi + lbi * xr + bi; xr = nxr; xi = nxi;
            float yv = 0.f, uv = 0.f;
#pragma unroll
            for (int c = 0; c < GSZ; ++c) { const float part = wave_sum(Cre[c] * xr - Cim[c] * xi); if ((lane & 15) == c) { yv = part; uv = u[c]; } }
            yv += dsk * uv;
            if (lane < GSZ) GY[(size_t)(b * SEQ + t) * SW + g * GSZ + lane] = (bf16_t)f2bf(gelu_tanh(yv));
        }
    }
}

struct CfgGlu {
    const bf16_t* GY; const float* W; bf16_t* SGo;
    __device__ __forceinline__ const bf16_t* arow(int row) const { return GY + (size_t)row * SW; }
    __device__ __forceinline__ const float* bptr(int) const { return W; }
    __device__ __forceinline__ int ldb() const { return 2 * SW; }
    __device__ __forceinline__ int K() const { return SW; }
    __device__ __forceinline__ void epi(int, int row, int col0, float v0, float v1) const { SGo[(size_t)row * SW + col0] = (bf16_t)f2bf(v0 * sigmoid_f(v1)); }
};
__device__ __forceinline__ void ph_glu(const Frame& F) {
    CfgGlu c{(const bf16_t*)(F.ws + WS_GY), F.in[I_WGLU], (bf16_t*)(F.ws + WS_SG)};
    constexpr int NTM = T / 128, NTN = SW / 64;
    for (int t = blockIdx.x; t < NTM * NTN; t += F.G) gemm_simple_tile<SW>(F, c, t / NTN, t % NTN);
}

struct CfgUp {
    const bf16_t* A; const float* W; const bf16_t* gate; float* tmp; bf16_t* Y; bool second;
    __device__ __forceinline__ const bf16_t* arow(int row) const { return A + (size_t)row * 512; }
    __device__ __forceinline__ const float* bptr(int) const { return W; }
    __device__ __forceinline__ int ldb() const { return DM; }
    __device__ __forceinline__ int K() const { return 512; }
    __device__ __forceinline__ void one(int row, int col, float v) const {
        const size_t i = (size_t)row * DM + col; const float gv = bf2f(gate[i]) * v;
        if (!second) tmp[i] = gv; else Y[i] = (bf16_t)f2bf(tmp[i] + gv);
    }
    __device__ __forceinline__ void epi(int, int row, int col0, float v0, float v1) const { one(row, col0, v0); one(row, col0 + 16, v1); }
};
__device__ __forceinline__ void ph_up(const Frame& F, bool second) {
    CfgUp c{(const bf16_t*)(F.ws + (second ? WS_SG : WS_AO)), F.in[second ? I_WUS : I_WUA], (const bf16_t*)(F.ws + (second ? WS_GS : WS_GA)), (float*)(F.ws + WS_R1), (bf16_t*)(F.ws + WS_Y), second};
    constexpr int NTM = T / 128, NTN = DM / 128;
    for (int t = blockIdx.x; t < NTM * NTN; t += F.G) gemm_simple_tile<16>(F, c, t / NTN, t % NTN);
}

struct CfgWo {
    const bf16_t* Y; const float* W; const bf16_t* H0; float* R1;
    __device__ __forceinline__ const bf16_t* arow(int row) const { return Y + (size_t)row * DM; }
    __device__ __forceinline__ const float* bptr(int) const { return W; }
    __device__ __forceinline__ int ldb() const { return DM; }
    __device__ __forceinline__ int K() const { return DM; }
    __device__ __forceinline__ void one(int row, int col, float v) const { const size_t i = (size_t)row * DM + col; R1[i] = ALPHA * bf2f(H0[i]) + v; }
    __device__ __forceinline__ void epi(int, int row, int col0, float v0, float v1) const { one(row, col0, v0); one(row, col0 + 16, v1); }
};
__device__ __forceinline__ void ph_wo(const Frame& F) {
    CfgWo c{(const bf16_t*)(F.ws + WS_Y), F.in[I_WO], (const bf16_t*)(F.ws + WS_H0), (float*)(F.ws + WS_R1)};
    constexpr int NTM = T / 128, NTN = DM / 128;
    for (int t = blockIdx.x; t < NTM * NTN; t += F.G) gemm_simple_tile<16>(F, c, t / NTN, t % NTN);
}

__device__ __forceinline__ void ph_ln1_router(const Frame& F) {
    const float* R1 = (const float*)(F.ws + WS_R1); bf16_t* H1 = (bf16_t*)(F.ws + WS_H1);
    const f32x4* g4 = (const f32x4*)F.in[I_LN1G]; const f32x4* b4 = (const f32x4*)F.in[I_LN1B];
    const float* rw = F.in[I_RW]; const float* rb = F.in[I_RB];
    int* TOPI = (int*)(F.ws + WS_TOPI); float* TOPG = (float*)(F.ws + WS_TOPG); int* TOK = (int*)(F.ws + WS_TOK);
    const int lane = F.lane;
    for (int i = blockIdx.x * 512 + F.tid; i < NROWS; i += F.G * 512) TOK[i] = T;
    if (blockIdx.x == 0) { for (int i = F.tid; i < DM / 2; i += 512) ((unsigned*)(H1 + (size_t)T * DM))[i] = 0u; }
    for (int m = F.gw; m < T; m += F.NGW) {
        const f32x4* xr = (const f32x4*)(R1 + (size_t)m * DM) + lane;
        f32x4 v[4]; float s = 0.f;
#pragma unroll
        for (int j = 0; j < 4; ++j) { v[j] = xr[64 * j]; s += (v[j][0] + v[j][1]) + (v[j][2] + v[j][3]); }
        const float mean = wave_sum(s) * (1.f / DM); float s2 = 0.f;
#pragma unroll
        for (int j = 0; j < 4; ++j) { v[j] = v[j] - mean; s2 += (v[j][0] * v[j][0] + v[j][1] * v[j][1]) + (v[j][2] * v[j][2] + v[j][3] * v[j][3]); }
        const float rstd = 1.f / sqrtf(wave_sum(s2) * (1.f / DM) + LN_EPS);
        u32x2* o = (u32x2*)(H1 + (size_t)m * DM) + lane;
        float lg[NE];
#pragma unroll
        for (int e = 0; e < NE; ++e) lg[e] = 0.f;
#pragma unroll
        for (int j = 0; j < 4; ++j) {
            const f32x4 y = v[j] * rstd * g4[lane + 64 * j] + b4[lane + 64 * j];
            u32x2 w; w.x = pk2(y[0], y[1]); w.y = pk2(y[2], y[3]); o[64 * j] = w;
            const float* wj = rw + (size_t)(256 * j + 4 * lane) * NE;
            asm volatile("" : "+v"(wj));
#pragma unroll
            for (int i = 0; i < 4; ++i) {
                const f32x4* wr4 = (const f32x4*)(wj + i * NE);
#pragma unroll
                for (int q = 0; q < 8; ++q) { const f32x4 ww = wr4[q]; lg[4 * q] += y[i] * ww[0]; lg[4 * q + 1] += y[i] * ww[1]; lg[4 * q + 2] += y[i] * ww[2]; lg[4 * q + 3] += y[i] * ww[3]; }
                asm volatile("" ::: "memory");
            }
        }
        float r16[16], r8[8], r4[4], r2[2], r1;
        { const bool hb = (lane & 32) != 0;
#pragma unroll
          for (int i = 0; i < 16; ++i) { const float keep = hb ? lg[i + 16] : lg[i], send = hb ? lg[i] : lg[i + 16]; r16[i] = keep + __shfl_xor(send, 32); } }
        { const bool hb = (lane & 16) != 0;
#pragma unroll
          for (int i = 0; i < 8; ++i) { const float keep = hb ? r16[i + 8] : r16[i], send = hb ? r16[i] : r16[i + 8]; r8[i] = keep + __shfl_xor(send, 16); } }
        { const bool hb = (lane & 8) != 0;
#pragma unroll
          for (int i = 0; i < 4; ++i) { const float keep = hb ? r8[i + 4] : r8[i], send = hb ? r8[i] : r8[i + 4]; r4[i] = keep + __shfl_xor(send, 8); } }
        { const bool hb = (lane & 4) != 0;
#pragma unroll
          for (int i = 0; i < 2; ++i) { const float keep = hb ? r4[i + 2] : r4[i], send = hb ? r4[i] : r4[i + 2]; r2[i] = keep + __shfl_xor(send, 4); } }
        { const bool hb = (lane & 2) != 0; const float keep = hb ? r2[1] : r2[0], send = hb ? r2[0] : r2[1]; r1 = keep + __shfl_xor(send, 2); }
        r1 += __shfl_xor(r1, 1);
        const int mye = (lane >> 1) & 31;
        float myv = r1 + rb[mye];
        float tv[TOPK]; int ti[TOPK];
#pragma unroll
        for (int k = 0; k < TOPK; ++k) {
            float bv = myv; int bi = mye;
#pragma unroll
            for (int o = 1; o < 64; o <<= 1) { const float ov = __shfl_xor(bv, o); const int oi = __shfl_xor(bi, o); if (ov > bv || (ov == bv && oi < bi)) { bv = ov; bi = oi; } }
            tv[k] = bv; ti[k] = bi; if (mye == bi) myv = -3.0e38f;
        }
        const float e1 = __expf(tv[1] - tv[0]), e2 = __expf(tv[2] - tv[0]), e3 = __expf(tv[3] - tv[0]);
        const float inv = 1.f / (1.f + e1 + e2 + e3);
        if (lane == 0) {
            TOPI[m * 4 + 0] = ti[0]; TOPI[m * 4 + 1] = ti[1]; TOPI[m * 4 + 2] = ti[2]; TOPI[m * 4 + 3] = ti[3];
            TOPG[m * 4 + 0] = inv; TOPG[m * 4 + 1] = e1 * inv; TOPG[m * 4 + 2] = e2 * inv; TOPG[m * 4 + 3] = e3 * inv;
#pragma unroll
            for (int k = 0; k < TOPK; ++k) atomicAdd(F.ctl + CW_COUNTS + ti[k], 1u);
        }
    }
}

__device__ __forceinline__ void load_pstart(const Frame& F) {
    LAS int* ps = (LAS int*)(F.lds + PS_OFF);
    __syncthreads();
    if (F.tid == 0) { int acc = 0; for (int e = 0; e < NE; ++e) { ps[e] = acc; const int c = (int)__hip_atomic_load(F.ctl + CW_COUNTS + e, __ATOMIC_RELAXED, __HIP_MEMORY_SCOPE_AGENT); acc += ((c + EB - 1) / EB) * EB; } ps[NE] = acc; }
    __syncthreads();
}
__device__ __forceinline__ void ph_dest(const Frame& F) {
    load_pstart(F);
    const LAS int* ps = (const LAS int*)(F.lds + PS_OFF);
    const int* TOPI = (const int*)(F.ws + WS_TOPI); int* DEST = (int*)(F.ws + WS_DEST); int* TOK = (int*)(F.ws + WS_TOK);
    for (int a = blockIdx.x * 512 + F.tid; a < NASSIGN; a += F.G * 512) {
        const int e = TOPI[a]; const int pos = (int)atomicAdd(F.ctl + CW_CURSOR + e, 1u); const int d = ps[e] + pos;
        TOK[d] = a >> 2; DEST[a] = d;
    }
}

struct CfgMoe1 {
    const bf16_t* H1; const int* TOK; const float* W; const float* bgu; bf16_t* ACT; const LAS int* ps;
    __device__ __forceinline__ int expert(int tm) const { const int r0 = tm * 128; int e = 0;
#pragma unroll 1
        for (int i = 1; i < NE; ++i) e += (ps[i] <= r0) ? 1 : 0; return e; }
    __device__ __forceinline__ const bf16_t* arow(int row) const { return H1 + (size_t)TOK[row] * DM; }
    __device__ __forceinline__ const float* bptr(int tm) const { return W + (size_t)expert(tm) * DM * 2 * DE; }
    __device__ __forceinline__ int ldb() const { return 2 * DE; }
    __device__ __forceinline__ int K() const { return DM; }
    __device__ __forceinline__ void epi(int tm, int row, int col0, float v0, float v1) const {
        const int e = expert(tm);
        float g = v0 + bgu[e * 2 * DE + col0], l = v1 + bgu[e * 2 * DE + DE + col0];
        g = fminf(g, SWIGLU_LIMIT); l = fminf(fmaxf(l, -SWIGLU_LIMIT), SWIGLU_LIMIT);
        ACT[(size_t)row * DE + col0] = (bf16_t)f2bf(g * sigmoid_f(SWIGLU_ALPHA * g) * (l + 1.f));
    }
};
__device__ __forceinline__ void ph_moe1(const Frame& F) {
    load_pstart(F);
    const LAS int* ps = (const LAS int*)(F.lds + PS_OFF);
    CfgMoe1 c{(const bf16_t*)(F.ws + WS_H1), (const int*)(F.ws + WS_TOK), F.in[I_WGU], F.in[I_BGU], (bf16_t*)(F.ws + WS_ACT), ps};
    const int ntm = ps[NE] / 128; constexpr int NTN = DE / 64;
    for (int t = blockIdx.x; t < ntm * NTN; t += F.G) gemm_simple_tile<DE>(F, c, t / NTN, t % NTN);
}
struct CfgMoe2 {
    const bf16_t* ACT; const float* W; const float* bd; bf16_t* OUTS; const LAS int* ps;
    __device__ __forceinline__ int expert(int tm) const { const int r0 = tm * 128; int e = 0;
#pragma unroll 1
        for (int i = 1; i < NE; ++i) e += (ps[i] <= r0) ? 1 : 0; return e; }
    __device__ __forceinline__ const bf16_t* arow(int row) const { return ACT + (size_t)row * DE; }
    __device__ __forceinline__ const float* bptr(int tm) const { return W + (size_t)expert(tm) * DE * DM; }
    __device__ __forceinline__ int ldb() const { return DM; }
    __device__ __forceinline__ int K() const { return DE; }
    __device__ __forceinline__ void epi(int tm, int row, int col0, float v0, float v1) const {
        const int e = expert(tm);
        OUTS[(size_t)row * DM + col0] = (bf16_t)f2bf(v0 + bd[e * DM + col0]);
        OUTS[(size_t)row * DM + col0 + 16] = (bf16_t)f2bf(v1 + bd[e * DM + col0 + 16]);
    }
};
__device__ __forceinline__ void ph_moe2(const Frame& F) {
    load_pstart(F);
    const LAS int* ps = (const LAS int*)(F.lds + PS_OFF);
    CfgMoe2 c{(const bf16_t*)(F.ws + WS_ACT), F.in[I_WD], F.in[I_BD], (bf16_t*)(F.ws + WS_OUTS), ps};
    const int ntm = ps[NE] / 128; constexpr int NTN = DM / 128;
    for (int t = blockIdx.x; t < ntm * NTN; t += F.G) gemm_simple_tile<16>(F, c, t / NTN, t % NTN);
}


__device__ __forceinline__ void p0_transpose_item(const float* W, int K, int N, bf16_t* WT, bool paired, LAS float* scr, int item, int lane) {
    const int nblk = N / 32, kb = item / nblk, nb = item % nblk, k0 = 64 * kb, n0 = 32 * nb;
    int drow = n0;
    if (paired) { const int half = N >> 1, j = n0 % half; drow = (j >> 7) * 256 + (n0 / half) * 128 + (j & 127); }
#pragma unroll 8
    for (int i = 0; i < 32; ++i) { const int kk = 2 * i + (lane >> 5); scr[kk * 33 + (lane & 31)] = W[(size_t)(k0 + kk) * N + n0 + (lane & 31)]; }
    asm volatile("s_waitcnt lgkmcnt(0)" ::: "memory");
    const int c = lane & 7;
#pragma unroll
    for (int j = 0; j < 4; ++j) { const int n = (lane >> 3) + 8 * j; const LAS float* s = scr + (8 * c) * 33 + n;
        u32x4 o; o.x = pk2(s[0 * 33], s[1 * 33]); o.y = pk2(s[2 * 33], s[3 * 33]); o.z = pk2(s[4 * 33], s[5 * 33]); o.w = pk2(s[6 * 33], s[7 * 33]);
        *(u32x4*)(WT + (size_t)(drow + n) * K + k0 + 8 * c) = o; }
    asm volatile("s_waitcnt lgkmcnt(0)" ::: "memory");
}
__device__ __forceinline__ void ph_convert(const Frame& F) {
    LAS float* scr = (LAS float*)(F.lds + F.wave * 16384);
    constexpr int I_IN = (DM / 64) * (INW / 32), I_GLU = (SW / 64) * (2 * SW / 32), I_UP = (512 / 64) * (DM / 32), I_O = (DM / 64) * (DM / 32);
    constexpr int I_GU1 = (DM / 64) * (2 * DE / 32), I_D1 = (DE / 64) * (DM / 32);
    constexpr int NITEMS = I_IN + I_GLU + 2 * I_UP + I_O + NE * I_GU1 + NE * I_D1;
    for (int it = F.gw; it < NITEMS; it += F.NGW) {
        int r = it;
        if (r < NE * I_GU1) { const int e = r / I_GU1; p0_transpose_item(F.in[I_WGU] + (size_t)e * DM * 2 * DE, DM, 2 * DE, (bf16_t*)(F.ws + WS_WGU) + (size_t)e * 2 * DE * DM, true, scr, r % I_GU1, F.lane); continue; } r -= NE * I_GU1;
        if (r < NE * I_D1) { const int e = r / I_D1; p0_transpose_item(F.in[I_WD] + (size_t)e * DE * DM, DE, DM, (bf16_t*)(F.ws + WS_WD) + (size_t)e * DM * DE, false, scr, r % I_D1, F.lane); continue; } r -= NE * I_D1;
        if (r < I_IN) { p0_transpose_item(F.in[I_WIN], DM, INW, (bf16_t*)(F.ws + WS_WIN), false, scr, r, F.lane); continue; } r -= I_IN;
        if (r < I_GLU) { p0_transpose_item(F.in[I_WGLU], SW, 2 * SW, (bf16_t*)(F.ws + WS_WGLU), true, scr, r, F.lane); continue; } r -= I_GLU;
        if (r < I_UP) { p0_transpose_item(F.in[I_WUA], 512, DM, (bf16_t*)(F.ws + WS_WUA), false, scr, r, F.lane); continue; } r -= I_UP;
        if (r < I_UP) { p0_transpose_item(F.in[I_WUS], 512, DM, (bf16_t*)(F.ws + WS_WUS), false, scr, r, F.lane); continue; } r -= I_UP;
        p0_transpose_item(F.in[I_WO], DM, DM, (bf16_t*)(F.ws + WS_WO), false, scr, r, F.lane);
    }
    __syncthreads();
}

__device__ __forceinline__ void ph_inproj_fast(const Frame& F) {
    pg8::Gemm g{(const bf16_t*)(F.ws + WS_H0), (const bf16_t*)(F.ws + WS_WIN), DM};
    pg8::StaticOrder S; S.init(T / 256, INW / 256, F.G, (int)blockIdx.x);
    EpiInProj E{(bf16_t*)(F.ws + WS_Q), (bf16_t*)(F.ws + WS_K), (bf16_t*)(F.ws + WS_V), (bf16_t*)(F.ws + WS_U), (bf16_t*)(F.ws + WS_GA), (bf16_t*)(F.ws + WS_GS), F.in[I_BGATE]};
    pg8::gemm_phase<EpiInProj, pg8::StaticOrder, false>(F.lds, g, S, E);
}
__device__ __forceinline__ void ph_glu_fast(const Frame& F) {
    pg8::Gemm g{(const bf16_t*)(F.ws + WS_GY), (const bf16_t*)(F.ws + WS_WGLU), SW};
    pg8::StaticOrder S; S.init(T / 256, 2 * SW / 256, F.G, (int)blockIdx.x);
    EpiGlu E{(bf16_t*)(F.ws + WS_SG)};
    pg8::gemm_phase<EpiGlu, pg8::StaticOrder, false>(F.lds, g, S, E);
}
__device__ __forceinline__ void ph_up_fast(const Frame& F, bool second) {
    pg8::Gemm g{(const bf16_t*)(F.ws + (second ? WS_SG : WS_AO)), (const bf16_t*)(F.ws + (second ? WS_WUS : WS_WUA)), 512};
    pg8::StaticOrder S; S.init(T / 256, DM / 256, F.G, (int)blockIdx.x);
    EpiUp E{(const bf16_t*)(F.ws + (second ? WS_GS : WS_GA)), (bf16_t*)(F.ws + WS_TMPB), (bf16_t*)(F.ws + WS_Y), second};
    pg8::gemm_phase<EpiUp, pg8::StaticOrder, false>(F.lds, g, S, E);
}
__device__ __forceinline__ void ph_wo_fast(const Frame& F) {
    pg8::Gemm g{(const bf16_t*)(F.ws + WS_Y), (const bf16_t*)(F.ws + WS_WO), DM};
    pg8::StaticOrder S; S.init(T / 256, DM / 256, F.G, (int)blockIdx.x);
    EpiWo E{(const bf16_t*)(F.ws + WS_H0), (float*)(F.ws + WS_R1)};
    pg8::gemm_phase<EpiWo, pg8::StaticOrder, false>(F.lds, g, S, E);
}
__device__ __forceinline__ void ph_moe1_fast(const Frame& F) {
    load_pstart(F);
    const LAS int* ps = (const LAS int*)(F.lds + PS_OFF); LAS unsigned* tokl = (LAS unsigned*)(F.lds + TOKL_OFF);
    MoeOrder S; S.so.init(__builtin_amdgcn_readfirstlane(ps[NE]) / 256, 2 * DE / 256, F.G, (int)blockIdx.x); S.ps = ps; S.tokl = tokl; S.bt_per_e = 2 * DE / 256;
    const int* TOK = (const int*)(F.ws + WS_TOK);
    pg8::Unit u;
    for (int i = 0; i < TOKL_UNITS; ++i) { if (!S.next(i, u)) break; if (F.tid < 256) tokl[i * 256 + F.tid] = (unsigned)TOK[u.pm * 256 + F.tid] * (unsigned)(DM * 2); }
    __syncthreads();
    pg8::Gemm g{(const bf16_t*)(F.ws + WS_H1), (const bf16_t*)(F.ws + WS_WGU), DM};
    EpiMoe1 E{F.in[I_BGU], (bf16_t*)(F.ws + WS_ACT)};
    pg8::gemm_phase<EpiMoe1, MoeOrder, true>(F.lds, g, S, E);
}
__device__ __forceinline__ void ph_moe2_fast(const Frame& F) {
    load_pstart(F);
    const LAS int* ps = (const LAS int*)(F.lds + PS_OFF);
    MoeOrder S; S.so.init(__builtin_amdgcn_readfirstlane(ps[NE]) / 256, DM / 256, F.G, (int)blockIdx.x); S.ps = ps; S.tokl = nullptr; S.bt_per_e = DM / 256;
    pg8::Gemm g{(const bf16_t*)(F.ws + WS_ACT), (const bf16_t*)(F.ws + WS_WD), DE};
    EpiMoe2 E{F.in[I_BD], (bf16_t*)(F.ws + WS_OUTS)};
    pg8::gemm_phase<EpiMoe2, MoeOrder, false>(F.lds, g, S, E);
}
__device__ __forceinline__ void ph_combine(const Frame& F) {
    const bf16_t* H1 = (const bf16_t*)(F.ws + WS_H1); const bf16_t* OUTS = (const bf16_t*)(F.ws + WS_OUTS);
    const int* DEST = (const int*)(F.ws + WS_DEST); const float* TOPG = (const float*)(F.ws + WS_TOPG);
    const f32x4* g4 = (const f32x4*)F.in[I_LN2G]; const f32x4* b4 = (const f32x4*)F.in[I_LN2B];
    const int lane = F.lane;
    for (int m = F.gw; m < T; m += F.NGW) {
        f32x4 v[4];
        const u32x2* hr = (const u32x2*)(H1 + (size_t)m * DM) + lane;
#pragma unroll
        for (int j = 0; j < 4; ++j) { const u32x2 w = hr[64 * j]; v[j] = (f32x4){bf2f(w.x & 0xffffu), bf2f(w.x >> 16), bf2f(w.y & 0xffffu), bf2f(w.y >> 16)} * ALPHA; }
#pragma unroll
        for (int k = 0; k < TOPK; ++k) {
            const int d = DEST[m * 4 + k]; const float gk = TOPG[m * 4 + k];
            const u32x2* orow = (const u32x2*)(OUTS + (size_t)d * DM) + lane;
#pragma unroll
            for (int j = 0; j < 4; ++j) { const u32x2 w = orow[64 * j]; v[j] += (f32x4){bf2f(w.x & 0xffffu), bf2f(w.x >> 16), bf2f(w.y & 0xffffu), bf2f(w.y >> 16)} * gk; }
        }
        float s = 0.f;
#pragma unroll
        for (int j = 0; j < 4; ++j) s += (v[j][0] + v[j][1]) + (v[j][2] + v[j][3]);
        const float mean = wave_sum(s) * (1.f / DM); float s2 = 0.f;
#pragma unroll
        for (int j = 0; j < 4; ++j) { v[j] = v[j] - mean; s2 += (v[j][0] * v[j][0] + v[j][1] * v[j][1]) + (v[j][2] * v[j][2] + v[j][3] * v[j][3]); }
        const float rstd = 1.f / sqrtf(wave_sum(s2) * (1.f / DM) + LN_EPS);
        f32x4* o = (f32x4*)(F.out + (size_t)m * DM) + lane;
#pragma unroll
        for (int j = 0; j < 4; ++j) o[64 * j] = v[j] * rstd * g4[lane + 64 * j] + b4[lane + 64 * j];
    }
}


constexpr int N_PHASES = 12;

__global__ void __launch_bounds__(NWAVES * 64, 2) mega_fwd(Args args) {
    extern __shared__ __attribute__((aligned(16))) unsigned char lds[];
    Frame F;
    F.lds = (LAS unsigned char*)lds;
    F.tid = threadIdx.x; F.lane = F.tid & 63; F.wave = __builtin_amdgcn_readfirstlane(F.tid >> 6);
    F.G = gridDim.x; F.gw = blockIdx.x * NWAVES + F.wave; F.NGW = F.G * NWAVES;
    F.in = args.in; F.out = args.out; F.ws = args.ws; F.ctl = (unsigned*)(args.ws + WS_CTL);
    volatile LAS unsigned* MISC = (volatile LAS unsigned*)(F.lds + MISC_OFF);
    for (int u = F.tid; u < 64; u += NWAVES * 64) MISC[u] = 0u;
    __syncthreads();
    const int lo = args.ph_lo, hi = args.ph_hi;
    XcdBarrier bar; bar.bar = F.ctl + CW_BAR; bar.x = 0; bar.st = nullptr;
    if (hi - lo > 1) bar = xcd_barrier_post(F.ctl + CW_BAR, MISC + 8);
#define IN(k) (lo <= (k) && (k) < hi)
#define SEAM(k) do { if (IN(k) && IN((k) + 1)) xcd_barrier(bar); } while (0)
    if (IN(0)) { ph_ln_in(F); if (FAST_ANY) ph_convert(F); } SEAM(0);
    if (IN(1)) { if (FAST_INPROJ) ph_inproj_fast(F); else ph_inproj(F); } SEAM(1);
    if (IN(2)) { if (blockIdx.x < 8) ph_ssm_simple(F); else { Frame F2 = F; F2.gw = (blockIdx.x - 8) * NWAVES + F.wave; F2.NGW = (F.G - 8) * NWAVES; ph_attn_simple(F2); } } SEAM(2);
    if (IN(3)) { if (FAST_MID) ph_glu_fast(F); else ph_glu(F); } SEAM(3);
    if (IN(4)) { if (FAST_MID) ph_up_fast(F, false); else ph_up(F, false); } SEAM(4);
    if (IN(5)) { if (FAST_MID) ph_up_fast(F, true); else ph_up(F, true); } SEAM(5);
    if (IN(6)) { if (FAST_MID) ph_wo_fast(F); else ph_wo(F); } SEAM(6);
    if (IN(7)) { ph_ln1_router(F); } SEAM(7);
    if (IN(8)) { ph_dest(F); } SEAM(8);
    if (IN(9)) { if (FAST_MOE1) ph_moe1_fast(F); else ph_moe1(F); } SEAM(9);
    if (IN(10)) { if (FAST_MOE2) ph_moe2_fast(F); else ph_moe2(F); } SEAM(10);
    if (IN(11)) { ph_combine(F); }
#undef IN
#undef SEAM
}

extern "C" void kernel_launch(void* const* d_in, const int* in_sizes, int n_in, void* d_out, int out_size, void* d_ws, size_t ws_size, hipStream_t stream) {
    static int grid = 0;
    if (grid == 0) {
        if (n_in != 28 || out_size != T * DM || ws_size < WS_END) { fprintf(stderr, "kernel_launch: unexpected shapes (n_in %d out %d ws %zu)\n", n_in, out_size, ws_size); grid = -1; return; }
        int dev = 0, cus = 0;
        if (hipGetDevice(&dev) != hipSuccess || hipDeviceGetAttribute(&cus, hipDeviceAttributeMultiprocessorCount, dev) != hipSuccess) { grid = -1; return; }
        if (hipFuncSetAttribute((const void*)mega_fwd, hipFuncAttributeMaxDynamicSharedMemorySize, LDS_BYTES) != hipSuccess) { fprintf(stderr, "kernel_launch: hipFuncSetAttribute failed\n"); grid = -1; return; }
        grid = cus;
    }
    if (grid < 0) return;
    (void)hipMemsetAsync((char*)d_ws + WS_CTL, 0, CTL_ZERO_BYTES, stream);
    Args a{};
    for (int i = 0; i < 28; ++i) a.in[i] = (const float*)d_in[i];
    a.out = (float*)d_out; a.ws = (unsigned char*)d_ws;
#if MK_ONE_LAUNCH
    a.ph_lo = 0; a.ph_hi = N_PHASES;
    hipLaunchKernelGGL(mega_fwd, dim3(grid), dim3(NWAVES * 64), LDS_BYTES, stream, a);
#else
    for (int p = 0; p < N_PHASES; ++p) { a.ph_lo = p; a.ph_hi = p + 1; hipLaunchKernelGGL(mega_fwd, dim3(grid), dim3(NWAVES * 64), LDS_BYTES, stream, a); }
#endif
}
```

```cpp
#include <hip/hip_runtime.h>
#include <cstdio>
#include <cstdint>

#ifndef FAST_INPROJ
#define FAST_INPROJ 1
#endif
#ifndef FAST_MID
#define FAST_MID 1
#endif
#ifndef FAST_MOE1
#define FAST_MOE1 1
#endif
#ifndef FAST_SSM
#define FAST_SSM 1
#endif
#ifndef FAST_ATTN
#define FAST_ATTN 1
#endif
#ifndef FAST_MOE2
#define FAST_MOE2 1
#endif
#define FAST_ANY (FAST_INPROJ || FAST_MID || FAST_MOE1 || FAST_MOE2)
#ifndef MK_ONE_LAUNCH
#define MK_ONE_LAUNCH 1
#endif

#define GAS __attribute__((address_space(1)))
#define LAS __attribute__((address_space(3)))
typedef unsigned short bf16_t;
typedef short bf16x8 __attribute__((ext_vector_type(8)));
typedef float f32x4 __attribute__((ext_vector_type(4)));
typedef unsigned u32x4 __attribute__((ext_vector_type(4)));
typedef unsigned u32x2 __attribute__((ext_vector_type(2)));

constexpr int BATCH = 2, SEQ = 8192, T = BATCH * SEQ, DM = 1024;
constexpr int CHUNK = 64, LEFT = 8, NCH = SEQ / CHUNK;
constexpr int NH = 8, HD = 64, AW = 512, RELMAX = 256, RELSIZE = 320;
constexpr int SW = 512, GSZ = 16, NG = 32, NP = 64;
constexpr int INW = 4096;
constexpr int NE = 32, TOPK = 4, DE = 1024, EB = 256;
constexpr int NASSIGN = T * TOPK;
constexpr int NROWS = NASSIGN + NE * EB;
constexpr float LN_EPS = 1e-5f;
constexpr float ALPHA = 1.189207115002721f;
constexpr float SWIGLU_LIMIT = 7.0f, SWIGLU_ALPHA = 1.702f;
constexpr int NWAVES = 8;
constexpr float LOG2E = 1.4426950408889634f, QSCALE = 0.125f * LOG2E;
constexpr int LDS_BYTES = 147456;
constexpr int MISC_OFF = 131072 + 320, PS_OFF = 131072 + 1024, TOKL_OFF = 131072 + 2048, TOKL_UNITS = 10;

constexpr size_t MiB = 1u << 20;
constexpr size_t WS_CTL = 0, CTL_ZERO_BYTES = 1 * MiB;
constexpr size_t WS_H0 = 1 * MiB;
constexpr size_t WS_Q = 33 * MiB;
constexpr size_t WS_K = 49 * MiB;
constexpr size_t WS_V = 65 * MiB;
constexpr size_t WS_U = 81 * MiB;
constexpr size_t WS_GA = 97 * MiB;
constexpr size_t WS_GS = 129 * MiB;
constexpr size_t WS_AO = 161 * MiB;
constexpr size_t WS_GY = 177 * MiB;
constexpr size_t WS_SG = 193 * MiB;
constexpr size_t WS_Y = 209 * MiB;
constexpr size_t WS_R1 = 241 * MiB;
constexpr size_t WS_H1 = 305 * MiB;
constexpr size_t WS_TOPI = 338 * MiB;
constexpr size_t WS_TOPG = 339 * MiB;
constexpr size_t WS_DEST = 340 * MiB;
constexpr size_t WS_TOK = 341 * MiB;
constexpr size_t WS_ACT = 342 * MiB;
constexpr size_t WS_OUTS = 486 * MiB;
constexpr size_t WS_WIN = 630 * MiB;
constexpr size_t WS_WGLU = 638 * MiB;
constexpr size_t WS_WUA = 639 * MiB;
constexpr size_t WS_WUS = 640 * MiB;
constexpr size_t WS_WO = 641 * MiB;
constexpr size_t WS_WGU = 643 * MiB;
constexpr size_t WS_WD = 771 * MiB;
constexpr size_t WS_TMPB = WS_R1;
constexpr size_t WS_VT = 835 * MiB;
constexpr size_t WS_LP = 851 * MiB;
constexpr size_t WS_LLP = 853 * MiB;
constexpr size_t WS_WST = 855 * MiB;
constexpr size_t WS_KDT = 863 * MiB;
constexpr size_t WS_CINT = 864 * MiB;
constexpr size_t WS_XSL = 865 * MiB;
constexpr size_t WS_UEND = 869 * MiB;
constexpr size_t WS_END = 870 * MiB;
constexpr int CW_COUNTS = 64, CW_CURSOR = 128;
constexpr int CW_BAR = 4096;

__device__ __forceinline__ unsigned f2bf(float f) { unsigned u = __float_as_uint(f); return (u + 0x7fffu + ((u >> 16) & 1u)) >> 16; }
__device__ __forceinline__ float bf2f(unsigned h) { return __uint_as_float(h << 16); }
__device__ __forceinline__ unsigned pk2(float lo, float hi) { return f2bf(lo) | (f2bf(hi) << 16); }
__device__ __forceinline__ float wave_sum(float v) {
#pragma unroll
    for (int o = 1; o < 64; o <<= 1) v += __shfl_xor(v, o);
    return v;
}
__device__ __forceinline__ float sigmoid_f(float x) { return 1.f / (1.f + __expf(-x)); }
__device__ __forceinline__ float gelu_tanh(float x) { const float z = 0.7978845608028654f * (x + 0.044715f * x * x * x); return x * sigmoid_f(2.f * z); }

__device__ __forceinline__ void sincos_d(double x, double& s, double& c) {
    const double kd = rint(x * 0.63661977236758134308);
    const int k = (int)kd;
    double r = fma(-kd, 1.57079632679489655800e+00, x);
    r = fma(-kd, 6.12323399573676603587e-17, r);
    const double r2 = r * r;
    double sp = -1.0 / 1307674368000.0;
    sp = sp * r2 + 1.0 / 6227020800.0; sp = sp * r2 - 1.0 / 39916800.0; sp = sp * r2 + 1.0 / 362880.0; sp = sp * r2 - 1.0 / 5040.0; sp = sp * r2 + 1.0 / 120.0; sp = sp * r2 - 1.0 / 6.0;
    sp = r + r * r2 * sp;
    double cp = -1.0 / 87178291200.0;
    cp = cp * r2 + 1.0 / 479001600.0; cp = cp * r2 - 1.0 / 3628800.0; cp = cp * r2 + 1.0 / 40320.0; cp = cp * r2 - 1.0 / 720.0; cp = cp * r2 + 1.0 / 24.0; cp = cp * r2 - 0.5;
    cp = 1.0 + r2 * cp;
    const int q = k & 3;
    s = (q == 0) ? sp : (q == 1) ? cp : (q == 2) ? -sp : -cp;
    c = (q == 0) ? cp : (q == 1) ? -sp : (q == 2) ? -cp : sp;
}

#define XB_TMO      128
#define XB_XCNT(j)  (256  + 64 * (j))
#define XB_XSUB(j)  (1280 + 64 * (j))
#define XB_XGEN(j)  (2304 + 64 * (j))
#define XB_TOP      3328
#define XB_TOPGEN   3392
#define XCD_BAR_WORDS 3456
#define XB_SPIN_CAP (1u << 22)
__device__ __forceinline__ unsigned xb_ld(unsigned* p)              { return __hip_atomic_load(p, __ATOMIC_RELAXED, __HIP_MEMORY_SCOPE_AGENT); }
__device__ __forceinline__ unsigned xb_add(unsigned* p, unsigned v) { return __hip_atomic_fetch_add(p, v, __ATOMIC_RELAXED, __HIP_MEMORY_SCOPE_AGENT); }
__device__ __forceinline__ unsigned xb_xcc_id() { return (unsigned)__builtin_amdgcn_s_getreg((3 << 11) | 20) & 0xFu; }
#define XB_SPIN(cond, bar) do { unsigned _sp = 0; while (cond) { __builtin_amdgcn_s_sleep(1); \
    if ((++_sp & 255u) == 0u) { if (xb_ld(&(bar)[XB_TMO])) break; if (_sp > XB_SPIN_CAP) { atomicAdd(&(bar)[XB_TMO], 1u); break; } } } } while (0)
struct XcdBarrier { unsigned* bar; unsigned x; volatile LAS unsigned* st; };
__device__ __forceinline__ XcdBarrier xcd_barrier_post(unsigned* bar, volatile LAS unsigned* st) {
    XcdBarrier b; b.bar = bar; b.x = xb_xcc_id(); b.st = st;
    if (threadIdx.x == 0) (void)xb_add(&bar[XB_XCNT(b.x)], 1u);
    return b;
}
__device__ __forceinline__ void xcd_barrier_complete(unsigned* bar, unsigned x, unsigned& nloc, unsigned& nx) {
    const unsigned G = gridDim.x * gridDim.y * gridDim.z;
    unsigned sum, cnt, mine, sp = 0u;
    for (;;) {
        sum = 0u; cnt = 0u; mine = 0u;
#pragma unroll
        for (unsigned j = 0; j < 16; ++j) { const unsigned c = xb_ld(&bar[XB_XCNT(j)]); sum += c; cnt += (c > 0u) ? 1u : 0u; mine = (j == x) ? c : mine; }
        if (sum == G) break;
        __builtin_amdgcn_s_sleep(1);
        if ((++sp & 255u) == 0u) { if (xb_ld(&bar[XB_TMO])) break; if (sp > XB_SPIN_CAP) { atomicAdd(&bar[XB_TMO], 1u); break; } }
    }
    nloc = mine > 0u ? mine : 1u; nx = cnt > 0u ? cnt : 1u;
}
__device__ __forceinline__ void xcd_barrier(const XcdBarrier& b) {
    asm volatile("s_waitcnt vmcnt(0)" ::: "memory");
    __syncthreads();
    if (threadIdx.x == 0) {
        unsigned* bar = b.bar;
        __builtin_amdgcn_s_waitcnt(0);
        unsigned nloc = b.st[0], nx = b.st[1];
        if (nloc == 0u) { xcd_barrier_complete(bar, b.x, nloc, nx); b.st[0] = nloc; b.st[1] = nx; }
        const unsigned old = xb_add(&bar[XB_XSUB(b.x)], 1u);
        const unsigned gen = old / nloc;
        if (old + 1u == (gen + 1u) * nloc) {
            __builtin_amdgcn_fence(__ATOMIC_RELEASE, "agent");
            asm volatile("s_waitcnt vmcnt(0)" ::: "memory");
            const unsigned og = xb_add(&bar[XB_TOP], 1u);
            const unsigned tg = og / nx;
            if (og + 1u == (tg + 1u) * nx) xb_add(&bar[XB_TOPGEN], 1u);
            else XB_SPIN(xb_ld(&bar[XB_TOPGEN]) == tg, bar);
            __builtin_amdgcn_fence(__ATOMIC_ACQUIRE, "agent");
            xb_add(&bar[XB_XGEN(b.x)], 1u);
            asm volatile("s_waitcnt vmcnt(0)" ::: "memory");
        } else {
            XB_SPIN(xb_ld(&bar[XB_XGEN(b.x)]) == gen, bar);
            __builtin_amdgcn_fence(__ATOMIC_ACQUIRE, "agent");
            asm volatile("s_waitcnt vmcnt(0)" ::: "memory");
        }
    }
    __syncthreads();
}


namespace pg8 {
#define PG8_LAS __attribute__((address_space(3)))
constexpr int BM = 256, BK = 64, HALF = 128, HTB = HALF * BK * 2, STAGE_BYTES = 8 * HTB, NXCD = 8, WGM = 8;
__host__ __device__ __forceinline__ int lds_byte(int r, int c) { const int st = (r >> 4) * 2 + (c >> 5), rr = r & 15, cc = c & 31, ob = rr * 64 + cc * 2; return st * 1024 + (ob ^ (((ob >> 9) & 1) << 5)); }
__host__ __device__ __forceinline__ void stage_rc(int b, int& R, int& C) { const int st = b / 1024, sb = b % 1024, swz = sb ^ (((sb >> 9) & 1) << 5); R = (st >> 1) * 16 + swz / 64; C = (st & 1) * 32 + (swz % 64) / 2; }
__host__ __device__ __forceinline__ int perm32(int rho) { const int n = rho >> 4, i = rho & 15; return 8 * (i >> 2) + 4 * n + (i & 3); }
struct Unit { int pm, pn, bn, ex; };
struct Gemm { const bf16_t* A; const bf16_t* Bt; int K; };
struct StaticOrder {
    int nM, nN, nwg, G, c;
    __device__ void init(int nM_, int nN_, int G_, int c_) { nM = nM_; nN = nN_; nwg = nM * nN; G = G_; c = c_; }
    __device__ bool next(int i, Unit& u) const {
        const long L = (long)i * G + c; if (L >= nwg) return false;
        int wgid = (int)L; { const int q = nwg / NXCD, r = nwg % NXCD, xcd = wgid % NXCD, off = wgid / NXCD; wgid = (xcd < r ? xcd * (q + 1) : r * (q + 1) + (xcd - r) * q) + off; }
        const int nig = WGM * nN, gid = wgid / nig, fm = gid * WGM, gsz = (nM - fm) < WGM ? (nM - fm) : WGM;
        u.pm = fm + ((wgid % nig) % gsz); u.pn = (wgid % nig) / gsz; u.bn = u.pn; u.ex = 0; return true;
    }
    __device__ __forceinline__ unsigned rowoff(int, int) const { return 0u; }
};
__device__ __forceinline__ unsigned cvt_pk_bf16(float lo, float hi) { unsigned r; asm volatile("v_cvt_pk_bf16_f32 %0, %1, %2" : "=v"(r) : "v"(lo), "v"(hi)); return r; }

template <class Epi, class Sched, bool GATHER>
__device__ __forceinline__ void gemm_phase(PG8_LAS unsigned char* lds, const Gemm g, const Sched& S, const Epi& E) {
    const int tid = threadIdx.x, wid = __builtin_amdgcn_readfirstlane(tid >> 6), lane = tid & 63, wr = wid >> 2, wc = wid & 3, fr = lane & 15, fq = lane >> 4;
    const int K = g.K, nt = K / BK;
    unsigned voffA0[2], voffA1[2], voffB[2];
#pragma unroll
    for (int i = 0; i < 2; ++i) { int R, C; stage_rc(tid * 16 + i * 8192, R, C); const int Rb = Epi::PERM ? ((R & ~31) + perm32(R & 31)) : R;
        voffA0[i] = (unsigned)(R * K + C) * 2u; voffA1[i] = voffA0[i] + (unsigned)(HALF * K * 2); voffB[i] = (unsigned)(Rb * K + C) * 2u; }
    const size_t kstep = (size_t)(BK * 2);
    const size_t hstep = (size_t)HALF * K * 2;
    const size_t tstep = 2 * hstep;
    const unsigned ldsw = (unsigned)wid * 1024u;
    const int aoff = lds_byte(wr * 64 + fr, fq * 8), boff = lds_byte(wc * 32 + fr, fq * 8);
#define PG8_SA(b, h) (((b) * 2 + (h)) * HTB)
#define PG8_SB(b, h) ((4 + (b) * 2 + (h)) * HTB)
#define PG8_STAGE(bufoff, gbase, voff) do { _Pragma("unroll") for (int _i = 0; _i < 2; ++_i) \
        __builtin_amdgcn_global_load_lds((const unsigned*)((const char*)(gbase) + (voff)[_i]), (PG8_LAS unsigned*)(lds + (bufoff) + ldsw + _i * 8192), 16, 0, 0); } while (0)
#define PG8_LDA(dst, b, h) do { _Pragma("unroll") for (int m = 0; m < 4; ++m) _Pragma("unroll") for (int k = 0; k < 2; ++k) dst[m][k] = *(const PG8_LAS bf16x8*)(lds + PG8_SA(b, h) + aoff + m * 2048 + k * 1024); } while (0)
#define PG8_LDB(dst, b, h) do { _Pragma("unroll") for (int n = 0; n < 2; ++n) _Pragma("unroll") for (int k = 0; k < 2; ++k) dst[n][k] = *(const PG8_LAS bf16x8*)(lds + PG8_SB(b, h) + boff + n * 2048 + k * 1024); } while (0)
#define PG8_MMA(ai, bj, At, Bt) do { __builtin_amdgcn_s_setprio(1); _Pragma("unroll") for (int m = 0; m < 4; ++m) _Pragma("unroll") for (int n = 0; n < 2; ++n) _Pragma("unroll") for (int k = 0; k < 2; ++k) \
        acc[ai][bj][m][n] = __builtin_amdgcn_mfma_f32_16x16x32_bf16(Bt[n][k], At[m][k], acc[ai][bj][m][n], 0, 0, 0); __builtin_amdgcn_s_setprio(0); } while (0)
#define PG8_WAIT_V(n) asm volatile("s_waitcnt vmcnt(" #n ")" ::: "memory")
#define PG8_WAIT_L(n) asm volatile("s_waitcnt lgkmcnt(" #n ")" ::: "memory")
#define PG8_BAR __builtin_amdgcn_s_barrier()
#define PG8_SCHED __builtin_amdgcn_sched_barrier(0)
#define PG8_GOFF(ui_) do { if constexpr (GATHER) { _Pragma("unroll") for (int _i = 0; _i < 2; ++_i) { int R_, C_; stage_rc(tid * 16 + _i * 8192, R_, C_); \
        voffA0[_i] = S.rowoff((ui_), R_) + (unsigned)(C_ * 2); voffA1[_i] = S.rowoff((ui_), HALF + R_) + (unsigned)(C_ * 2); } } } while (0)
    Unit cur, nxt; int ui = 0;
    if (!S.next(0, cur)) return;
    f32x4 acc[2][2][4][2];
#pragma unroll
    for (int a = 0; a < 2; ++a)
#pragma unroll
        for (int b = 0; b < 2; ++b)
#pragma unroll
            for (int m = 0; m < 4; ++m)
#pragma unroll
                for (int n = 0; n < 2; ++n) acc[a][b][m][n] = (f32x4){0.f, 0.f, 0.f, 0.f};
    bf16x8 At[4][2], B0[2][2], B1[2][2];
    PG8_GOFF(0);
    const char* cA = GATHER ? (const char*)g.A : (const char*)g.A + (size_t)cur.pm * tstep; const char* cB = (const char*)g.Bt + (size_t)cur.bn * tstep;
    PG8_STAGE(PG8_SB(0, 0), cB, voffB); PG8_STAGE(PG8_SB(0, 1), cB + hstep, voffB); PG8_STAGE(PG8_SA(0, 0), cA, voffA0); PG8_STAGE(PG8_SA(0, 1), cA, voffA1);
    if (wr == 1) PG8_BAR;
    PG8_WAIT_V(2); PG8_BAR;
    PG8_STAGE(PG8_SB(1, 0), cB + kstep, voffB); PG8_STAGE(PG8_SA(1, 0), cA + kstep, voffA0); PG8_STAGE(PG8_SB(1, 1), cB + hstep + kstep, voffB);
    PG8_WAIT_V(6); PG8_BAR;
    for (;;) {
        const bool has_next = S.next(ui + 1, nxt);
        const char* nA = GATHER ? (const char*)g.A : (has_next ? (const char*)g.A + (size_t)nxt.pm * tstep : cA);
        const char* nB = has_next ? (const char*)g.Bt + (size_t)nxt.bn * tstep : cB;
        for (int t = 0; t < nt; t += 2) {
            const bool last = (t == nt - 2);
            const char* a1 = cA + (size_t)(t + 1) * kstep;
            const char* a2 = last ? nA : cA + (size_t)(t + 2) * kstep; const char* b2 = last ? nB : cB + (size_t)(t + 2) * kstep;
            const char* a3 = a2 + kstep; const char* b3 = b2 + kstep;
            PG8_LDB(B0, 0, 0); PG8_LDB(B1, 0, 1); PG8_SCHED; PG8_LDA(At, 0, 0); PG8_STAGE(PG8_SA(1, 1), a1, voffA1);
            if (GATHER && last && has_next) { PG8_GOFF(ui + 1); }
            PG8_WAIT_V(8); PG8_WAIT_L(0); PG8_BAR; PG8_MMA(0, 0, At, B0); PG8_MMA(0, 1, At, B1); PG8_BAR; PG8_SCHED;
            PG8_LDA(At, 0, 1); PG8_STAGE(PG8_SB(0, 0), b2, voffB); PG8_STAGE(PG8_SB(0, 1), b2 + hstep, voffB); PG8_STAGE(PG8_SA(0, 0), a2, voffA0);
            PG8_WAIT_V(8); PG8_WAIT_L(0); PG8_BAR; PG8_MMA(1, 0, At, B0); PG8_MMA(1, 1, At, B1); PG8_BAR; PG8_SCHED;
            PG8_LDB(B0, 1, 0); PG8_LDB(B1, 1, 1); PG8_SCHED; PG8_LDA(At, 1, 0); PG8_STAGE(PG8_SA(0, 1), a2, voffA1);
            PG8_WAIT_V(8); PG8_WAIT_L(0); PG8_BAR; PG8_MMA(0, 0, At, B0); PG8_MMA(0, 1, At, B1); PG8_BAR; PG8_SCHED;
            PG8_LDA(At, 1, 1); PG8_STAGE(PG8_SB(1, 0), b3, voffB); PG8_STAGE(PG8_SB(1, 1), b3 + hstep, voffB); PG8_STAGE(PG8_SA(1, 0), a3, voffA0);
            PG8_WAIT_V(8); PG8_WAIT_L(0); PG8_BAR; PG8_MMA(1, 0, At, B0); PG8_MMA(1, 1, At, B1); PG8_BAR; PG8_SCHED;
        }
        if (wr == 0) PG8_BAR;
        E(acc, cur, wr, wc, fr, fq);
        if (!has_next) break;
#pragma unroll
        for (int a = 0; a < 2; ++a)
#pragma unroll
            for (int b = 0; b < 2; ++b)
#pragma unroll
                for (int m = 0; m < 4; ++m)
#pragma unroll
                    for (int n = 0; n < 2; ++n) acc[a][b][m][n] = (f32x4){0.f, 0.f, 0.f, 0.f};
        cur = nxt; cA = nA; cB = nB; ++ui;
        if (wr == 1) PG8_BAR;
    }
    PG8_WAIT_V(0);
    PG8_BAR;
#undef PG8_SA
#undef PG8_SB
#undef PG8_STAGE
#undef PG8_LDA
#undef PG8_LDB
#undef PG8_MMA
#undef PG8_WAIT_V
#undef PG8_WAIT_L
#undef PG8_BAR
#undef PG8_SCHED
#undef PG8_GOFF
}
}

struct Args {
    const float* in[28];
    float* out; unsigned char* ws;
    int ph_lo, ph_hi;
};
enum { I_X = 0, I_LNIG, I_LNIB, I_WIN, I_BGATE, I_RELB, I_LAMRE, I_LAMIM, I_LOGDT, I_BRE, I_BIM, I_CRE, I_CIM, I_SSMD, I_WGLU, I_WUA, I_WUS, I_WO,
       I_LN1G, I_LN1B, I_RW, I_RB, I_WGU, I_BGU, I_WD, I_BD, I_LN2G, I_LN2B };

struct Frame {
    LAS unsigned char* lds;
    int tid, lane, wave, G, gw, NGW;
    const float* const* in;
    float* out; unsigned char* ws;
    unsigned* ctl;
};

template <int PS> __device__ __forceinline__ int colbase(int tn, int wc) { return PS == 16 ? tn * 128 + wc * 32 : tn * 64 + wc * 16; }

template <int PS, class Cfg>
__device__ __forceinline__ void gemm_simple_tile(const Frame& F, const Cfg& c, int tm, int tn) {
    LAS bf16_t* As = (LAS bf16_t*)F.lds;
    LAS bf16_t* Bs = As + 128 * 40;
    const int tid = F.tid, lane = F.lane, w = F.wave, wr = w >> 2, wc = w & 3;
    f32x4 acc[4][2];
#pragma unroll
    for (int m = 0; m < 4; ++m)
#pragma unroll
        for (int n = 0; n < 2; ++n) acc[m][n] = (f32x4){0.f, 0.f, 0.f, 0.f};
    const int ar = tid >> 2, ak = (tid & 3) * 8;
    const bf16_t* ap = c.arow(tm * 128 + ar) + ak;
    const int bk = tid >> 4, bc = (tid & 15) * 8;
    const int pc = colbase<PS>(tn, bc >> 5) + ((bc >> 4) & 1) * PS + (bc & 15);
    const int ldb = c.ldb();
    const float* bp = c.bptr(tm) + (size_t)bk * ldb + pc;
    const int K = c.K();
    for (int k0 = 0; k0 < K; k0 += 32) {
        const u32x4 av = *(const u32x4*)(ap + k0);
        const f32x4 b0 = *(const f32x4*)(bp + (size_t)k0 * ldb), b1 = *(const f32x4*)(bp + (size_t)k0 * ldb + 4);
        __syncthreads();
        *(LAS u32x4*)(As + ar * 40 + ak) = av;
        Bs[(bc + 0) * 40 + bk] = (bf16_t)f2bf(b0[0]); Bs[(bc + 1) * 40 + bk] = (bf16_t)f2bf(b0[1]);
        Bs[(bc + 2) * 40 + bk] = (bf16_t)f2bf(b0[2]); Bs[(bc + 3) * 40 + bk] = (bf16_t)f2bf(b0[3]);
        Bs[(bc + 4) * 40 + bk] = (bf16_t)f2bf(b1[0]); Bs[(bc + 5) * 40 + bk] = (bf16_t)f2bf(b1[1]);
        Bs[(bc + 6) * 40 + bk] = (bf16_t)f2bf(b1[2]); Bs[(bc + 7) * 40 + bk] = (bf16_t)f2bf(b1[3]);
        __syncthreads();
        bf16x8 a[4], b[2];
#pragma unroll
        for (int m = 0; m < 4; ++m) a[m] = *(const LAS bf16x8*)(As + (wr * 64 + m * 16 + (lane & 15)) * 40 + (lane >> 4) * 8);
#pragma unroll
        for (int n = 0; n < 2; ++n) b[n] = *(const LAS bf16x8*)(Bs + (wc * 32 + n * 16 + (lane & 15)) * 40 + (lane >> 4) * 8);
#pragma unroll
        for (int m = 0; m < 4; ++m)
#pragma unroll
            for (int n = 0; n < 2; ++n) acc[m][n] = __builtin_amdgcn_mfma_f32_16x16x32_bf16(a[m], b[n], acc[m][n], 0, 0, 0);
    }
    const int col0 = colbase<PS>(tn, wc) + (lane & 15);
#pragma unroll
    for (int m = 0; m < 4; ++m)
#pragma unroll
        for (int r = 0; r < 4; ++r) {
            const int row = tm * 128 + wr * 64 + m * 16 + (lane >> 4) * 4 + r;
            c.epi(tm, row, col0, acc[m][0][r], acc[m][1][r]);
        }
    __syncthreads();
}


__device__ __forceinline__ void store8(bf16_t* p, const f32x4 v0, const f32x4 v1) {
    u32x4 w; w.x = pg8::cvt_pk_bf16(v0[0], v0[1]); w.y = pg8::cvt_pk_bf16(v0[2], v0[3]); w.z = pg8::cvt_pk_bf16(v1[0], v1[1]); w.w = pg8::cvt_pk_bf16(v1[2], v1[3]);
    *(u32x4*)p = w;
}
__device__ __forceinline__ void load8(const bf16_t* p, f32x4& v0, f32x4& v1) {
    const u32x4 w = *(const u32x4*)p;
    v0 = (f32x4){bf2f(w.x & 0xffffu), bf2f(w.x >> 16), bf2f(w.y & 0xffffu), bf2f(w.y >> 16)};
    v1 = (f32x4){bf2f(w.z & 0xffffu), bf2f(w.z >> 16), bf2f(w.w & 0xffffu), bf2f(w.w >> 16)};
}
__device__ __forceinline__ f32x4 sigmoid4(const f32x4 v) { return (f32x4){sigmoid_f(v[0]), sigmoid_f(v[1]), sigmoid_f(v[2]), sigmoid_f(v[3])}; }

struct EpiInProj {
    static constexpr bool PERM = true;
    bf16_t *Q, *Kb, *V, *U, *GA, *GS; const float* bgate; bf16_t* VT;
    __device__ __forceinline__ void operator()(const f32x4 (&acc)[2][2][4][2], const pg8::Unit& u, int wr, int wc, int fr, int fq) const {
        const int pn = u.pn, row0 = u.pm * 256 + wr * 64 + fr, colin = wc * 32 + 8 * fq;
        bf16_t* base; int ld, cb; float sc = 1.f; const bool gate = pn >= 8;
        if (pn < 8) { base = pn < 2 ? Q : (pn < 4 ? Kb : (pn < 6 ? V : U)); ld = 512; cb = (pn & 1) * 256; if (pn < 2) sc = QSCALE; }
        else { base = pn < 12 ? GA : GS; ld = 1024; cb = (pn & 3) * 256; }
#pragma unroll
        for (int bj = 0; bj < 2; ++bj) {
            f32x4 b0 = (f32x4){0.f, 0.f, 0.f, 0.f}, b1 = b0;
            if (gate) { const float* bp = bgate + (pn - 8) * 256 + bj * 128 + colin; b0 = *(const f32x4*)bp; b1 = *(const f32x4*)(bp + 4); }
#pragma unroll
            for (int ai = 0; ai < 2; ++ai)
#pragma unroll
                for (int m = 0; m < 4; ++m) {
                    f32x4 v0 = acc[ai][bj][m][0], v1 = acc[ai][bj][m][1];
                    if (gate) { v0 = sigmoid4(v0 + b0); v1 = sigmoid4(v1 + b1); } else { v0 = v0 * sc; v1 = v1 * sc; }
                    store8(base + (size_t)(row0 + ai * 128 + m * 16) * ld + cb + bj * 128 + colin, v0, v1);
                    if (pn == 4 || pn == 5) {
                        const int row = row0 + ai * 128 + m * 16, b = row / SEQ, tt = row % SEQ, i16 = tt & 15;
                        const int pos = (tt & ~15) | (i16 & 3) | ((i16 & 4) << 1) | ((i16 & 8) >> 1);
                        const int vcol = cb + bj * 128 + colin;
                        bf16_t* vp = VT + ((size_t)(b * NH) * HD + vcol) * SEQ + pos;
#pragma unroll
                        for (int j = 0; j < 4; ++j) { vp[(size_t)j * SEQ] = (bf16_t)f2bf(v0[j]); vp[(size_t)(4 + j) * SEQ] = (bf16_t)f2bf(v1[j]); }
                    }
                }
        }
    }
};
struct EpiGlu {
    static constexpr bool PERM = true;
    bf16_t* SGo;
    __device__ __forceinline__ void operator()(const f32x4 (&acc)[2][2][4][2], const pg8::Unit& u, int wr, int wc, int fr, int fq) const {
        const int row0 = u.pm * 256 + wr * 64 + fr, col = u.pn * 128 + wc * 32 + 8 * fq;
#pragma unroll
        for (int ai = 0; ai < 2; ++ai)
#pragma unroll
            for (int m = 0; m < 4; ++m)
                store8(SGo + (size_t)(row0 + ai * 128 + m * 16) * SW + col, acc[ai][0][m][0] * sigmoid4(acc[ai][1][m][0]), acc[ai][0][m][1] * sigmoid4(acc[ai][1][m][1]));
    }
};
struct EpiUp {
    static constexpr bool PERM = true;
    const bf16_t* gate; bf16_t* tmp; bf16_t* Y; bool second;
    __device__ __forceinline__ void operator()(const f32x4 (&acc)[2][2][4][2], const pg8::Unit& u, int wr, int wc, int fr, int fq) const {
        const int row0 = u.pm * 256 + wr * 64 + fr, col0 = u.pn * 256 + wc * 32 + 8 * fq;
#pragma unroll
        for (int ai = 0; ai < 2; ++ai)
#pragma unroll
            for (int m = 0; m < 4; ++m)
#pragma unroll
                for (int bj = 0; bj < 2; ++bj) {
                    const size_t off = (size_t)(row0 + ai * 128 + m * 16) * DM + col0 + bj * 128;
                    f32x4 g0, g1; load8(gate + off, g0, g1);
                    f32x4 v0 = g0 * acc[ai][bj][m][0], v1 = g1 * acc[ai][bj][m][1];
                    if (second) { f32x4 t0, t1; load8(tmp + off, t0, t1); store8(Y + off, v0 + t0, v1 + t1); }
                    else store8(tmp + off, v0, v1);
                }
    }
};
struct EpiWo {
    static constexpr bool PERM = false;
    const bf16_t* H0; float* R1;
    __device__ __forceinline__ void operator()(const f32x4 (&acc)[2][2][4][2], const pg8::Unit& u, int wr, int wc, int fr, int fq) const {
        const int row0 = u.pm * 256 + wr * 64 + fr, col0 = u.pn * 256 + wc * 32 + 4 * fq;
#pragma unroll
        for (int ai = 0; ai < 2; ++ai)
#pragma unroll
            for (int m = 0; m < 4; ++m)
#pragma unroll
                for (int bj = 0; bj < 2; ++bj)
#pragma unroll
                    for (int n = 0; n < 2; ++n) {
                        const size_t off = (size_t)(row0 + ai * 128 + m * 16) * DM + col0 + bj * 128 + n * 16;
                        const u32x2 w = *(const u32x2*)(H0 + off);
                        const f32x4 h = (f32x4){bf2f(w.x & 0xffffu), bf2f(w.x >> 16), bf2f(w.y & 0xffffu), bf2f(w.y >> 16)};
                        *(f32x4*)(R1 + off) = h * ALPHA + acc[ai][bj][m][n];
                    }
    }
};
struct EpiMoe1 {
    static constexpr bool PERM = true;
    const float* bgu; bf16_t* ACT;
    __device__ __forceinline__ void operator()(const f32x4 (&acc)[2][2][4][2], const pg8::Unit& u, int wr, int wc, int fr, int fq) const {
        const int row0 = u.pm * 256 + wr * 64 + fr, col = u.pn * 128 + wc * 32 + 8 * fq;
        const float* bp = bgu + (size_t)u.ex * 2 * DE + col;
        const f32x4 bg0 = *(const f32x4*)bp, bg1 = *(const f32x4*)(bp + 4), bl0 = *(const f32x4*)(bp + DE), bl1 = *(const f32x4*)(bp + DE + 4);
#pragma unroll
        for (int ai = 0; ai < 2; ++ai)
#pragma unroll
            for (int m = 0; m < 4; ++m) {
                f32x4 o[2];
#pragma unroll
                for (int n = 0; n < 2; ++n) {
                    const f32x4 gv = acc[ai][0][m][n] + (n ? bg1 : bg0), lv = acc[ai][1][m][n] + (n ? bl1 : bl0);
#pragma unroll
                    for (int j = 0; j < 4; ++j) { const float gg = fminf(gv[j], SWIGLU_LIMIT), ll = fminf(fmaxf(lv[j], -SWIGLU_LIMIT), SWIGLU_LIMIT); o[n][j] = gg * sigmoid_f(SWIGLU_ALPHA * gg) * (ll + 1.f); }
                }
                store8(ACT + (size_t)(row0 + ai * 128 + m * 16) * DE + col, o[0], o[1]);
            }
    }
};
struct EpiMoe2 {
    static constexpr bool PERM = true;
    const float* bd; bf16_t* OUTS;
    __device__ __forceinline__ void operator()(const f32x4 (&acc)[2][2][4][2], const pg8::Unit& u, int wr, int wc, int fr, int fq) const {
        const int row0 = u.pm * 256 + wr * 64 + fr, col0 = u.pn * 256 + wc * 32 + 8 * fq;
#pragma unroll
        for (int bj = 0; bj < 2; ++bj) {
            const float* bp = bd + (size_t)u.ex * DM + col0 + bj * 128;
            const f32x4 b0 = *(const f32x4*)bp, b1 = *(const f32x4*)(bp + 4);
#pragma unroll
            for (int ai = 0; ai < 2; ++ai)
#pragma unroll
                for (int m = 0; m < 4; ++m)
                    store8(OUTS + (size_t)(row0 + ai * 128 + m * 16) * DM + col0 + bj * 128, acc[ai][bj][m][0] + b0, acc[ai][bj][m][1] + b1);
        }
    }
};
struct MoeOrder {
    pg8::StaticOrder so; const LAS int* ps; const LAS unsigned* tokl; int bt_per_e;
    __device__ __forceinline__ bool next(int i, pg8::Unit& u) const {
        if (!so.next(i, u)) return false;
        int e = 0; const int r0 = u.pm * 256;
#pragma unroll 1
        for (int k = 1; k < NE; ++k) e += (ps[k] <= r0) ? 1 : 0;
        e = __builtin_amdgcn_readfirstlane(e);
        u.ex = e; u.bn = e * bt_per_e + u.pn; return true;
    }
    __device__ __forceinline__ unsigned rowoff(int ui, int r) const { return tokl[ui * 256 + r]; }
};
__device__ __forceinline__ void ph_ln_in(const Frame& F) {
    const float* x = F.in[I_X]; const f32x4* g4 = (const f32x4*)F.in[I_LNIG]; const f32x4* b4 = (const f32x4*)F.in[I_LNIB];
    bf16_t* H0 = (bf16_t*)(F.ws + WS_H0);
    for (int m = F.gw; m < T; m += F.NGW) {
        const f32x4* xr = (const f32x4*)(x + (size_t)m * DM) + F.lane;
        f32x4 v[4]; float s = 0.f;
#pragma unroll
        for (int j = 0; j < 4; ++j) { v[j] = xr[64 * j]; s += (v[j][0] + v[j][1]) + (v[j][2] + v[j][3]); }
        const float mean = wave_sum(s) * (1.f / DM); float s2 = 0.f;
#pragma unroll
        for (int j = 0; j < 4; ++j) { v[j] = v[j] - mean; s2 += (v[j][0] * v[j][0] + v[j][1] * v[j][1]) + (v[j][2] * v[j][2] + v[j][3] * v[j][3]); }
        const float rstd = 1.f / sqrtf(wave_sum(s2) * (1.f / DM) + LN_EPS);
        u32x2* o = (u32x2*)(H0 + (size_t)m * DM) + F.lane;
#pragma unroll
        for (int j = 0; j < 4; ++j) { const f32x4 y = v[j] * rstd * g4[F.lane + 64 * j] + b4[F.lane + 64 * j]; u32x2 w; w.x = pk2(y[0], y[1]); w.y = pk2(y[2], y[3]); o[64 * j] = w; }
    }
}

struct CfgInProj {
    const bf16_t* H0; const float* W; const float* bgate; bf16_t *Q, *Kb, *V, *U, *GA, *GS;
    __device__ __forceinline__ const bf16_t* arow(int row) const { return H0 + (size_t)row * DM; }
    __device__ __forceinline__ const float* bptr(int) const { return W; }
    __device__ __forceinline__ int ldb() const { return INW; }
    __device__ __forceinline__ int K() const { return DM; }
    __device__ __forceinline__ void one(int row, int col, float v) const {
        if (col < 512) Q[(size_t)row * AW + col] = (bf16_t)f2bf(v * QSCALE);
        else if (col < 1024) Kb[(size_t)row * AW + col - 512] = (bf16_t)f2bf(v);
        else if (col < 1536) V[(size_t)row * AW + col - 1024] = (bf16_t)f2bf(v);
        else if (col < 2048) U[(size_t)row * SW + col - 1536] = (bf16_t)f2bf(v);
        else if (col < 3072) GA[(size_t)row * DM + col - 2048] = (bf16_t)f2bf(sigmoid_f(v + bgate[col - 2048]));
        else GS[(size_t)row * DM + col - 3072] = (bf16_t)f2bf(sigmoid_f(v + bgate[col - 2048]));
    }
    __device__ __forceinline__ void epi(int, int row, int col0, float v0, float v1) const { one(row, col0, v0); one(row, col0 + 16, v1); }
};
__device__ __forceinline__ void ph_inproj(const Frame& F) {
    CfgInProj c{(const bf16_t*)(F.ws + WS_H0), F.in[I_WIN], F.in[I_BGATE], (bf16_t*)(F.ws + WS_Q), (bf16_t*)(F.ws + WS_K), (bf16_t*)(F.ws + WS_V), (bf16_t*)(F.ws + WS_U),
                (bf16_t*)(F.ws + WS_GA), (bf16_t*)(F.ws + WS_GS)};
    constexpr int NTM = T / 128, NTN = INW / 128;
    for (int t = blockIdx.x; t < NTM * NTN; t += F.G) gemm_simple_tile<16>(F, c, t / NTN, t % NTN);
}

__device__ __forceinline__ void ph_attn_simple(const Frame& F) {
    const bf16_t* Q = (const bf16_t*)(F.ws + WS_Q); const bf16_t* Kb = (const bf16_t*)(F.ws + WS_K); const bf16_t* V = (const bf16_t*)(F.ws + WS_V);
    bf16_t* AO = (bf16_t*)(F.ws + WS_AO); const float* relb = F.in[I_RELB];
    const int lane = F.lane;
    for (int it = F.gw; it < T * NH; it += F.NGW) {
        const int m = it / NH, h = it % NH, b = m / SEQ, t = m % SEQ, n = t / CHUNK;
        const float q = bf2f(Q[(size_t)m * AW + h * HD + lane]);
        const int k0 = (n - LEFT) * CHUNK < 0 ? 0 : (n - LEFT) * CHUNK, k1 = n * CHUNK + CHUNK;
        float mx = -1e30f, l = 0.f, o = 0.f;
        for (int kp = k0; kp < k1; ++kp) {
            const size_t kr = (size_t)(b * SEQ + kp) * AW + h * HD + lane;
            float s = wave_sum(q * bf2f(Kb[kr]));
            int dist = t - kp; dist = dist < -(CHUNK - 1) ? -(CHUNK - 1) : (dist > RELMAX ? RELMAX : dist);
            s += relb[h * RELSIZE + dist + (CHUNK - 1)] * LOG2E;
            const float mn = fmaxf(mx, s), a = __builtin_amdgcn_exp2f(mx - mn), pp = __builtin_amdgcn_exp2f(s - mn);
            l = l * a + pp; o = o * a + pp * bf2f(V[kr]); mx = mn;
        }
        AO[(size_t)m * AW + h * HD + lane] = (bf16_t)f2bf(o / l);
    }
}

__device__ __forceinline__ void ph_ssm_simple(const Frame& F) {
    const bf16_t* U = (const bf16_t*)(F.ws + WS_U); bf16_t* GY = (bf16_t*)(F.ws + WS_GY);
    const int lane = F.lane;
    for (int it = F.gw; it < BATCH * NG; it += F.NGW) {
        const int b = it / NG, g = it % NG;
        const double lre = (double)F.in[I_LAMRE][g * NP + lane], lim = (double)F.in[I_LAMIM][g * NP + lane];
        const double dt = (double)expf(F.in[I_LOGDT][g]);
        const double er = (double)expf((float)(lre * dt));
        double sn, cs; sincos_d(lim * dt, sn, cs);
        const double lbr_d = er * cs, lbi_d = er * sn;
        const double nr = lbr_d - 1.0, ni = lbi_d, den = lre * lre + lim * lim;
        const double cr = (nr * lre + ni * lim) / den, ci = (ni * lre - nr * lim) / den;
        const float lbr = (float)lbr_d, lbi = (float)lbi_d;
        float Bre[GSZ], Bim[GSZ], Cre[GSZ], Cim[GSZ];
#pragma unroll
        for (int c = 0; c < GSZ; ++c) {
            const double br = (double)F.in[I_BRE][(g * NP + lane) * GSZ + c], bi = (double)F.in[I_BIM][(g * NP + lane) * GSZ + c];
            Bre[c] = (float)(cr * br - ci * bi); Bim[c] = (float)(cr * bi + ci * br);
            Cre[c] = F.in[I_CRE][(g * GSZ + c) * NP + lane]; Cim[c] = F.in[I_CIM][(g * GSZ + c) * NP + lane];
        }
        const float dsk = F.in[I_SSMD][g * GSZ + (lane & 15)];
        float xr = 0.f, xi = 0.f;
        for (int t = 0; t < SEQ; ++t) {
            const bf16_t* up = U + (size_t)(b * SEQ + t) * SW + g * GSZ;
            const u32x4 u0 = *(const u32x4*)up, u1 = *(const u32x4*)(up + 8);
            float u[GSZ];
#pragma unroll
            for (int i = 0; i < 4; ++i) { u[2 * i] = bf2f(u0[i] & 0xffffu); u[2 * i + 1] = bf2f(u0[i] >> 16); u[8 + 2 * i] = bf2f(u1[i] & 0xffffu); u[8 + 2 * i + 1] = bf2f(u1[i] >> 16); }
            float br = 0.f, bi = 0.f;
#pragma unroll
            for (int c = 0; c < GSZ; ++c) { br += Bre[c] * u[c]; bi += Bim[c] * u[c]; }
            const float nxr = lbr * xr - lbi * xi + br, nxi = lbr * xi + lbi * xr + bi; xr = nxr; xi = nxi;
            float yv = 0.f, uv = 0.f;
#pragma unroll
            for (int c = 0; c < GSZ; ++c) { const float part = wave_sum(Cre[c] * xr - Cim[c] * xi); if ((lane & 15) == c) { yv = part; uv = u[c]; } }
            yv += dsk * uv;
            if (lane < GSZ) GY[(size_t)(b * SEQ + t) * SW + g * GSZ + lane] = (bf16_t)f2bf(gelu_tanh(yv));
        }
    }
}


typedef float f32x16 __attribute__((ext_vector_type(16)));
__device__ __forceinline__ void ph_attn_fast_b(const Frame& F, int bid) {
    const bf16_t* Q = (const bf16_t*)(F.ws + WS_Q); const bf16_t* Kb = (const bf16_t*)(F.ws + WS_K); const bf16_t* VT = (const bf16_t*)(F.ws + WS_VT);
    bf16_t* AO = (bf16_t*)(F.ws + WS_AO);
    LAS float* bl = (LAS float*)F.lds;
    for (int i = F.tid; i < NH * RELSIZE; i += 512) bl[i] = F.in[I_RELB][i] * 1.4426950408889634f;
    __syncthreads();
    const int lane = F.lane, r32 = lane & 31, hi = lane >> 5;
    for (int unit = bid; unit < BATCH * NCH * 2; unit += F.G) {
        const int bn = unit >> 1, b = bn / NCH, n = bn % NCH;
        const int h = (unit & 1) * 4 + (F.wave >> 1), qb = F.wave & 1;
        const size_t qtok = (size_t)b * SEQ + n * CHUNK + qb * 32 + r32;
        bf16x8 qf[4];
#pragma unroll
        for (int ds = 0; ds < 4; ++ds) qf[ds] = *(const bf16x8*)(Q + qtok * AW + h * HD + ds * 16 + hi * 8);
        f32x16 o[2];
#pragma unroll
        for (int r = 0; r < 16; ++r) { o[0][r] = 0.f; o[1][r] = 0.f; }
        float mrun = -1.0e30f, lrun = 0.f;
        const LAS char* blh = (const LAS char*)(bl + h * RELSIZE);
        const int qpos = qb * 32 + r32;
        const bf16_t* vbase = VT + ((size_t)(b * NH + h) * HD + r32) * SEQ + hi * 8;
        for (int c = (n < LEFT ? n : LEFT); c >= 0; --c) {
            const int kc = n - c;
            const bf16_t* Kp = Kb + ((size_t)b * SEQ + kc * CHUNK + r32) * AW + h * HD + hi * 8;
            f32x16 s[2];
#pragma unroll
            for (int kb = 0; kb < 2; ++kb) {
#pragma unroll
                for (int r = 0; r < 16; ++r) s[kb][r] = 0.f;
#pragma unroll
                for (int ds = 0; ds < 4; ++ds) { const bf16x8 kf = *(const bf16x8*)(Kp + (size_t)kb * 32 * AW + ds * 16); s[kb] = __builtin_amdgcn_mfma_f32_32x32x16_bf16(kf, qf[ds], s[kb], 0, 0, 0); }
            }
            bf16x8 vf[2][2][2];
#pragma unroll
            for (int db = 0; db < 2; ++db)
#pragma unroll
                for (int kb = 0; kb < 2; ++kb)
#pragma unroll
                    for (int s2 = 0; s2 < 2; ++s2) vf[db][kb][s2] = *(const bf16x8*)(vbase + (size_t)db * 32 * SEQ + kc * CHUNK + kb * 32 + s2 * 16);
            if (c >= 5) { const float bc = *(const LAS float*)(blh + 319 * 4);
#pragma unroll
                for (int r = 0; r < 16; ++r) { s[0][r] += bc; s[1][r] += bc; } }
            else { const int base4 = (qpos + 64 * c + 63 - 4 * hi) * 4;
#pragma unroll
                for (int kb = 0; kb < 2; ++kb)
#pragma unroll
                    for (int r = 0; r < 16; ++r) { int off = base4 - 4 * (kb * 32 + (r & 3) + 8 * (r >> 2)); off = off < 319 * 4 ? off : 319 * 4; s[kb][r] += *(const LAS float*)(blh + off); } }
            float tm = fmaxf(s[0][0], s[1][0]);
#pragma unroll
            for (int r = 1; r < 16; ++r) tm = fmaxf(tm, fmaxf(s[0][r], s[1][r]));
            tm = fmaxf(tm, __shfl_xor(tm, 32));
            if (__any(tm > mrun + 8.f)) { const float mn = fmaxf(mrun, tm), f = __builtin_amdgcn_exp2f(mrun - mn); lrun *= f; mrun = mn;
#pragma unroll
                for (int r = 0; r < 16; ++r) { o[0][r] *= f; o[1][r] *= f; } }
            float ls = 0.f;
#pragma unroll
            for (int kb = 0; kb < 2; ++kb)
#pragma unroll
                for (int r = 0; r < 16; ++r) { const float p = __builtin_amdgcn_exp2f(s[kb][r] - mrun); ls += p; s[kb][r] = p; }
            lrun += ls;
#pragma unroll
            for (int kb = 0; kb < 2; ++kb)
#pragma unroll
                for (int s2 = 0; s2 < 2; ++s2) {
                    u32x4 pw; pw.x = pg8::cvt_pk_bf16(s[kb][8 * s2 + 0], s[kb][8 * s2 + 1]); pw.y = pg8::cvt_pk_bf16(s[kb][8 * s2 + 2], s[kb][8 * s2 + 3]);
                    pw.z = pg8::cvt_pk_bf16(s[kb][8 * s2 + 4], s[kb][8 * s2 + 5]); pw.w = pg8::cvt_pk_bf16(s[kb][8 * s2 + 6], s[kb][8 * s2 + 7]);
                    const bf16x8 pf = __builtin_bit_cast(bf16x8, pw);
                    o[0] = __builtin_amdgcn_mfma_f32_32x32x16_bf16(vf[0][kb][s2], pf, o[0], 0, 0, 0);
                    o[1] = __builtin_amdgcn_mfma_f32_32x32x16_bf16(vf[1][kb][s2], pf, o[1], 0, 0, 0);
                }
        }
        lrun += __shfl_xor(lrun, 32);
        const float inv = 1.f / lrun;
        bf16_t* op = AO + qtok * AW + h * HD + 4 * hi;
#pragma unroll
        for (int db = 0; db < 2; ++db)
#pragma unroll
            for (int g4 = 0; g4 < 4; ++g4) { u32x2 w; w.x = pg8::cvt_pk_bf16(o[db][4 * g4] * inv, o[db][4 * g4 + 1] * inv); w.y = pg8::cvt_pk_bf16(o[db][4 * g4 + 2] * inv, o[db][4 * g4 + 3] * inv);
                *(u32x2*)(op + db * 32 + 8 * g4) = w; }
    }
    __syncthreads();
}

typedef float f32x2 __attribute__((ext_vector_type(2)));
__device__ __forceinline__ f32x2 cmul(f32x2 a, f32x2 b) { return (f32x2){a.x * b.x - a.y * b.y, a.x * b.y + a.y * b.x}; }
__device__ __forceinline__ void ssm_coef(const Frame& F, int g, int p, double& lre, double& lim, double& dt, double& cr, double& ci) {
    lre = (double)F.in[I_LAMRE][g * NP + p]; lim = (double)F.in[I_LAMIM][g * NP + p]; dt = (double)expf(F.in[I_LOGDT][g]);
    const double y = lre * dt;
    double em = 1.0, term = 1.0;
#pragma unroll
    for (int k = 1; k <= 14; ++k) { term = term * y / (double)k; em += term; }
    double sn, cs; sincos_d(lim * dt, sn, cs);
    const double nr = em * cs - 1.0, ni = em * sn, den = lre * lre + lim * lim;
    cr = (nr * lre + ni * lim) / den; ci = (ni * lre - nr * lim) / den;
}
__device__ __forceinline__ f32x2 lam_pow(double lre, double lim, double dt, double k) {
    const float mag = expf((float)(lre * dt * k)); double sn, cs; sincos_d(lim * dt * k, sn, cs);
    return (f32x2){mag * (float)cs, mag * (float)sn};
}
__device__ __forceinline__ void ph_ssm_tables(const Frame& F) {
    f32x2* LP = (f32x2*)(F.ws + WS_LP); f32x2* LLP = (f32x2*)(F.ws + WS_LLP);
    bf16_t* WsT = (bf16_t*)(F.ws + WS_WST); bf16_t* KdT = (bf16_t*)(F.ws + WS_KDT); bf16_t* Cint = (bf16_t*)(F.ws + WS_CINT);
    const int gt = blockIdx.x * 512 + F.tid, NT = F.G * 512;
    for (int it = gt; it < NG * (65 + 128) * NP; it += NT) {
        const int p = it % NP, q = (it / NP) % (65 + 128), g = it / (NP * (65 + 128));
        const double lre = (double)F.in[I_LAMRE][g * NP + p], lim = (double)F.in[I_LAMIM][g * NP + p], dt = (double)expf(F.in[I_LOGDT][g]);
        if (q < 65) LP[(g * 65 + q) * NP + p] = lam_pow(lre, lim, dt, (double)q);
        else LLP[(g * 128 + (q - 65)) * NP + p] = lam_pow(lre, lim, dt, 64.0 * (double)(q - 65));
    }
    for (int it = gt; it < NG * GSZ * NP; it += NT) {
        const int p = it % NP, c = (it / NP) % GSZ, g = it / (NP * GSZ);
        ((unsigned*)Cint)[(g * GSZ + c) * NP + p] = pk2(F.in[I_CRE][(g * GSZ + c) * NP + p], -F.in[I_CIM][(g * GSZ + c) * NP + p]);
    }
    for (int it = gt; it < NG * NP * 64; it += NT) {
        const int j = it & 63, p = (it >> 6) % NP, g = it / (64 * NP);
        double lre, lim, dt, cr, ci; ssm_coef(F, g, p, lre, lim, dt, cr, ci);
        const f32x2 pw = lam_pow(lre, lim, dt, (double)(63 - j));
        const float crf = (float)cr, cif = (float)ci;
        bf16_t* o0 = WsT + ((size_t)(g * 128 + 2 * p) * 1024 + j * 16); bf16_t* o1 = o0 + 1024;
        const f32x4* br4 = (const f32x4*)(F.in[I_BRE] + (g * NP + p) * GSZ); const f32x4* bi4 = (const f32x4*)(F.in[I_BIM] + (g * NP + p) * GSZ);
#pragma unroll 1
        for (int c4 = 0; c4 < 4; ++c4) {
            const f32x4 br = br4[c4], bi = bi4[c4];
            float re[4], im[4];
#pragma unroll
            for (int k = 0; k < 4; ++k) { const f32x2 v = cmul(pw, (f32x2){crf * br[k] - cif * bi[k], crf * bi[k] + cif * br[k]}); re[k] = v.x; im[k] = v.y; }
            *(u32x2*)(o0 + c4 * 4) = (u32x2){pk2(re[0], re[1]), pk2(re[2], re[3])};
            *(u32x2*)(o1 + c4 * 4) = (u32x2){pk2(im[0], im[1]), pk2(im[2], im[3])};
        }
    }
    LAS f32x2* Ew = (LAS f32x2*)(F.lds + F.wave * 16384);
    for (int it = F.gw; it < NG * 64; it += F.NGW) {
        const int d = it & 63, g = it >> 6, p = F.lane;
        double lre, lim, dt, cr, ci; ssm_coef(F, g, p, lre, lim, dt, cr, ci);
        const f32x2 pw = lam_pow(lre, lim, dt, (double)d);
        { const float crf = (float)cr, cif = (float)ci;
#pragma unroll 4
          for (int c = 0; c < GSZ; ++c) {
            const float br = F.in[I_BRE][(g * NP + p) * GSZ + c], bi = F.in[I_BIM][(g * NP + p) * GSZ + c];
            Ew[p * GSZ + c] = cmul(pw, (f32x2){crf * br - cif * bi, crf * bi + cif * br});
          } }
        asm volatile("s_waitcnt lgkmcnt(0)" ::: "memory");
        const int c = F.lane >> 2, ci0 = (F.lane & 3) * 4;
        const float* cre = F.in[I_CRE] + (g * GSZ + c) * NP; const float* cim = F.in[I_CIM] + (g * GSZ + c) * NP;
        float acc[4] = {0.f, 0.f, 0.f, 0.f};
        for (int pp = 0; pp < NP; ++pp) {
            const float a = cre[pp], bq = cim[pp];
#pragma unroll
            for (int k = 0; k < 4; ++k) { const f32x2 e = Ew[pp * GSZ + ci0 + k]; acc[k] += a * e.x - bq * e.y; }
        }
        if (d == 0) {
#pragma unroll
            for (int k = 0; k < 4; ++k) if (ci0 + k == c) acc[k] += F.in[I_SSMD][g * GSZ + c];
        }
        *(u32x2*)(KdT + ((size_t)((g * 64 + d) * GSZ + c)) * GSZ + ci0) = (u32x2){pk2(acc[0], acc[1]), pk2(acc[2], acc[3])};
        asm volatile("s_waitcnt lgkmcnt(0)" ::: "memory");
    }
}
__device__ __forceinline__ void ph_ssm_xe(const Frame& F, int unit) {
    const int b = unit / (NG * 4), g = (unit >> 2) % NG, qtr = unit & 3, n0 = qtr * 32;
    const bf16_t* U = (const bf16_t*)(F.ws + WS_U); const bf16_t* WsT = (const bf16_t*)(F.ws + WS_WST) + (size_t)g * 128 * 1024;
    const int lane = F.lane, w = F.wave, fr = lane & 15, fq = lane >> 4;
    f32x4 acc[2] = {(f32x4){0.f, 0.f, 0.f, 0.f}, (f32x4){0.f, 0.f, 0.f, 0.f}};
    const bf16_t* bp = WsT + (size_t)(w * 16 + fr) * 1024 + fq * 8;
    const bf16_t* ap = U + ((size_t)b * SEQ + (size_t)(n0 + fr) * CHUNK + (fq >> 1)) * SW + g * GSZ + (fq & 1) * 8;
#pragma unroll 4
    for (int ks = 0; ks < 32; ++ks) {
        const bf16x8 bf = *(const bf16x8*)(bp + ks * 32);
        const bf16x8 a0 = *(const bf16x8*)(ap + (size_t)(2 * ks) * SW), a1 = *(const bf16x8*)(ap + (size_t)(16 * CHUNK + 2 * ks) * SW);
        acc[0] = __builtin_amdgcn_mfma_f32_16x16x32_bf16(a0, bf, acc[0], 0, 0, 0);
        acc[1] = __builtin_amdgcn_mfma_f32_16x16x32_bf16(a1, bf, acc[1], 0, 0, 0);
    }
    LAS float* XEl = (LAS float*)(F.lds + 16384);
#pragma unroll
    for (int rb = 0; rb < 2; ++rb)
#pragma unroll
        for (int r = 0; r < 4; ++r) XEl[(rb * 16 + fq * 4 + r) * 128 + w * 16 + fr] = acc[rb][r];
    __syncthreads();
    if (F.tid < NP) {
        const int p = F.tid;
        const f32x2 lamL = ((const f32x2*)(F.ws + WS_LP))[(g * 65 + 64) * NP + p];
        f32x2* XSL = (f32x2*)(F.ws + WS_XSL); f32x2* UEND = (f32x2*)(F.ws + WS_UEND);
        f32x2 s = (f32x2){0.f, 0.f};
        for (int i = 0; i < 32; ++i) {
            XSL[((size_t)(b * NCH + n0 + i) * NG + g) * NP + p] = s;
            const f32x2 xe = (f32x2){XEl[i * 128 + 2 * p], XEl[i * 128 + 2 * p + 1]};
            s = cmul(lamL, s) + xe;
        }
        UEND[((size_t)(b * 4 + qtr) * NG + g) * NP + p] = s;
    }
    __syncthreads();
}
__device__ __forceinline__ void ph_ssm_out(const Frame& F) {
    const bf16_t* U = (const bf16_t*)(F.ws + WS_U); bf16_t* GY = (bf16_t*)(F.ws + WS_GY);
    const f32x2* LP = (const f32x2*)(F.ws + WS_LP); const f32x2* LLP = (const f32x2*)(F.ws + WS_LLP);
    const bf16_t* KdT = (const bf16_t*)(F.ws + WS_KDT); const bf16_t* Cint = (const bf16_t*)(F.ws + WS_CINT);
    const f32x2* XSL = (const f32x2*)(F.ws + WS_XSL); const f32x2* UEND = (const f32x2*)(F.ws + WS_UEND);
    constexpr int USTR = 1040;
    LAS unsigned char* UL = F.lds; LAS f32x2* xsl = (LAS f32x2*)(F.lds + 64 * USTR) + F.wave * NP;
    const int lane = F.lane, w = F.wave, fr = lane & 15, fq = lane >> 4;
    for (int unit = blockIdx.x; unit < BATCH * NCH; unit += F.G) {
        const int b = unit / NCH, n = unit % NCH, qtr = n >> 5, ni = n & 31;
        __syncthreads();
        for (int idx = F.tid; idx < 64 * 64; idx += 512) { const int row = idx >> 6, c16 = idx & 63;
            *(LAS u32x4*)(UL + row * USTR + c16 * 16) = *(const u32x4*)(U + ((size_t)b * SEQ + n * CHUNK + row) * SW + c16 * 8); }
        __syncthreads();
#pragma unroll 1
        for (int gi = 0; gi < 4; ++gi) {
            const int g = gi * 8 + w;
            {
                f32x2 xs = XSL[((size_t)(b * NCH + n) * NG + g) * NP + lane];
                if (qtr > 0) { f32x2 carry = (f32x2){0.f, 0.f};
                    for (int q = 0; q < qtr; ++q) carry += cmul(LLP[(g * 128 + 32 * (qtr - 1 - q)) * NP + lane], UEND[((size_t)(b * 4 + q) * NG + g) * NP + lane]);
                    xs += cmul(LLP[(g * 128 + ni) * NP + lane], carry); }
                xsl[lane] = xs;
            }
            f32x4 acc[4];
#pragma unroll
            for (int rb = 0; rb < 4; ++rb) acc[rb] = (f32x4){0.f, 0.f, 0.f, 0.f};
#pragma unroll
            for (int ks = 0; ks < 4; ++ks) {
                const bf16x8 cf = *(const bf16x8*)(Cint + (size_t)(g * GSZ + fr) * 128 + ks * 32 + fq * 8);
                const LAS f32x4* xp = (const LAS f32x4*)(xsl + ks * 16 + 4 * fq);
                const f32x4 x01 = xp[0], x23 = xp[1];
#pragma unroll
                for (int rb = 0; rb < 4; ++rb) {
                    const f32x4* lp = (const f32x4*)(LP + (size_t)(g * 65 + rb * 16 + fr + 1) * NP + ks * 16 + 4 * fq);
                    const f32x4 l01 = lp[0], l23 = lp[1];
                    u32x4 zw;
                    zw.x = pg8::cvt_pk_bf16(l01[0] * x01[0] - l01[1] * x01[1], l01[0] * x01[1] + l01[1] * x01[0]);
                    zw.y = pg8::cvt_pk_bf16(l01[2] * x01[2] - l01[3] * x01[3], l01[2] * x01[3] + l01[3] * x01[2]);
                    zw.z = pg8::cvt_pk_bf16(l23[0] * x23[0] - l23[1] * x23[1], l23[0] * x23[1] + l23[1] * x23[0]);
                    zw.w = pg8::cvt_pk_bf16(l23[2] * x23[2] - l23[3] * x23[3], l23[2] * x23[3] + l23[3] * x23[2]);
                    acc[rb] = __builtin_amdgcn_mfma_f32_16x16x32_bf16(cf, __builtin_bit_cast(bf16x8, zw), acc[rb], 0, 0, 0);
                }
            }
            const LAS unsigned char* ub = UL + g * 32 + (fq & 1) * 16;
#pragma unroll
            for (int kq = 0; kq < 4; ++kq) {
#pragma unroll
                for (int k8 = 0; k8 < 8; ++k8) {
                    const int ks = kq * 8 + k8;
                    const bf16x8 kf = *(const bf16x8*)(KdT + ((size_t)((g * 64 + 2 * ks + (fq >> 1)) * GSZ + fr)) * GSZ + (fq & 1) * 8);
#pragma unroll
                    for (int rb = kq; rb < 4; ++rb) {
                        const int src = rb * 16 + fr - 2 * ks - (fq >> 1);
                        bf16x8 af = *(const LAS bf16x8*)(ub + (src < 0 ? 0 : src) * USTR);
                        if (rb == kq) { if (src < 0) af = (bf16x8){0, 0, 0, 0, 0, 0, 0, 0}; }
                        acc[rb] = __builtin_amdgcn_mfma_f32_16x16x32_bf16(kf, af, acc[rb], 0, 0, 0);
                    }
                }
            }
#pragma unroll
            for (int rb = 0; rb < 4; ++rb) {
                u32x2 o; o.x = pg8::cvt_pk_bf16(gelu_tanh(acc[rb][0]), gelu_tanh(acc[rb][1])); o.y = pg8::cvt_pk_bf16(gelu_tanh(acc[rb][2]), gelu_tanh(acc[rb][3]));
                *(u32x2*)(GY + ((size_t)b * SEQ + n * CHUNK + rb * 16 + fr) * SW + g * GSZ + 4 * fq) = o;
            }
        }
    }
    __syncthreads();
}
struct CfgGlu {
    const bf16_t* GY; const float* W; bf16_t* SGo;
    __device__ __forceinline__ const bf16_t* arow(int row) const { return GY + (size_t)row * SW; }
    __device__ __forceinline__ const float* bptr(int) const { return W; }
    __device__ __forceinline__ int ldb() const { return 2 * SW; }
    __device__ __forceinline__ int K() const { return SW; }
    __device__ __forceinline__ void epi(int, int row, int col0, float v0, float v1) const { SGo[(size_t)row * SW + col0] = (bf16_t)f2bf(v0 * sigmoid_f(v1)); }
};
__device__ __forceinline__ void ph_glu(const Frame& F) {
    CfgGlu c{(const bf16_t*)(F.ws + WS_GY), F.in[I_WGLU], (bf16_t*)(F.ws + WS_SG)};
    constexpr int NTM = T / 128, NTN = SW / 64;
    for (int t = blockIdx.x; t < NTM * NTN; t += F.G) gemm_simple_tile<SW>(F, c, t / NTN, t % NTN);
}

struct CfgUp {
    const bf16_t* A; const float* W; const bf16_t* gate; float* tmp; bf16_t* Y; bool second;
    __device__ __forceinline__ const bf16_t* arow(int row) const { return A + (size_t)row * 512; }
    __device__ __forceinline__ const float* bptr(int) const { return W; }
    __device__ __forceinline__ int ldb() const { return DM; }
    __device__ __forceinline__ int K() const { return 512; }
    __device__ __forceinline__ void one(int row, int col, float v) const {
        const size_t i = (size_t)row * DM + col; const float gv = bf2f(gate[i]) * v;
        if (!second) tmp[i] = gv; else Y[i] = (bf16_t)f2bf(tmp[i] + gv);
    }
    __device__ __forceinline__ void epi(int, int row, int col0, float v0, float v1) const { one(row, col0, v0); one(row, col0 + 16, v1); }
};
__device__ __forceinline__ void ph_up(const Frame& F, bool second) {
    CfgUp c{(const bf16_t*)(F.ws + (second ? WS_SG : WS_AO)), F.in[second ? I_WUS : I_WUA], (const bf16_t*)(F.ws + (second ? WS_GS : WS_GA)), (float*)(F.ws + WS_R1), (bf16_t*)(F.ws + WS_Y), second};
    constexpr int NTM = T / 128, NTN = DM / 128;
    for (int t = blockIdx.x; t < NTM * NTN; t += F.G) gemm_simple_tile<16>(F, c, t / NTN, t % NTN);
}

struct CfgWo {
    const bf16_t* Y; const float* W; const bf16_t* H0; float* R1;
    __device__ __forceinline__ const bf16_t* arow(int row) const { return Y + (size_t)row * DM; }
    __device__ __forceinline__ const float* bptr(int) const { return W; }
    __device__ __forceinline__ int ldb() const { return DM; }
    __device__ __forceinline__ int K() const { return DM; }
    __device__ __forceinline__ void one(int row, int col, float v) const { const size_t i = (size_t)row * DM + col; R1[i] = ALPHA * bf2f(H0[i]) + v; }
    __device__ __forceinline__ void epi(int, int row, int col0, float v0, float v1) const { one(row, col0, v0); one(row, col0 + 16, v1); }
};
__device__ __forceinline__ void ph_wo(const Frame& F) {
    CfgWo c{(const bf16_t*)(F.ws + WS_Y), F.in[I_WO], (const bf16_t*)(F.ws + WS_H0), (float*)(F.ws + WS_R1)};
    constexpr int NTM = T / 128, NTN = DM / 128;
    for (int t = blockIdx.x; t < NTM * NTN; t += F.G) gemm_simple_tile<16>(F, c, t / NTN, t % NTN);
}

__device__ __forceinline__ void ph_ln1_router(const Frame& F) {
    const float* R1 = (const float*)(F.ws + WS_R1); bf16_t* H1 = (bf16_t*)(F.ws + WS_H1);
    const f32x4* g4 = (const f32x4*)F.in[I_LN1G]; const f32x4* b4 = (const f32x4*)F.in[I_LN1B];
    const float* rw = F.in[I_RW]; const float* rb = F.in[I_RB];
    int* TOPI = (int*)(F.ws + WS_TOPI); float* TOPG = (float*)(F.ws + WS_TOPG); int* TOK = (int*)(F.ws + WS_TOK);
    const int lane = F.lane;
    for (int i = blockIdx.x * 512 + F.tid; i < NROWS; i += F.G * 512) TOK[i] = T;
    if (blockIdx.x == 0) { for (int i = F.tid; i < DM / 2; i += 512) ((unsigned*)(H1 + (size_t)T * DM))[i] = 0u; }
    for (int m = F.gw; m < T; m += F.NGW) {
        const f32x4* xr = (const f32x4*)(R1 + (size_t)m * DM) + lane;
        f32x4 v[4]; float s = 0.f;
#pragma unroll
        for (int j = 0; j < 4; ++j) { v[j] = xr[64 * j]; s += (v[j][0] + v[j][1]) + (v[j][2] + v[j][3]); }
        const float mean = wave_sum(s) * (1.f / DM); float s2 = 0.f;
#pragma unroll
        for (int j = 0; j < 4; ++j) { v[j] = v[j] - mean; s2 += (v[j][0] * v[j][0] + v[j][1] * v[j][1]) + (v[j][2] * v[j][2] + v[j][3] * v[j][3]); }
        const float rstd = 1.f / sqrtf(wave_sum(s2) * (1.f / DM) + LN_EPS);
        u32x2* o = (u32x2*)(H1 + (size_t)m * DM) + lane;
        float lg[NE];
#pragma unroll
        for (int e = 0; e < NE; ++e) lg[e] = 0.f;
#pragma unroll
        for (int j = 0; j < 4; ++j) {
            const f32x4 y = v[j] * rstd * g4[lane + 64 * j] + b4[lane + 64 * j];
            u32x2 w; w.x = pk2(y[0], y[1]); w.y = pk2(y[2], y[3]); o[64 * j] = w;
            const float* wj = rw + (size_t)(256 * j + 4 * lane) * NE;
            asm volatile("" : "+v"(wj));
#pragma unroll
            for (int i = 0; i < 4; ++i) {
                const f32x4* wr4 = (const f32x4*)(wj + i * NE);
#pragma unroll
                for (int q = 0; q < 8; ++q) { const f32x4 ww = wr4[q]; lg[4 * q] += y[i] * ww[0]; lg[4 * q + 1] += y[i] * ww[1]; lg[4 * q + 2] += y[i] * ww[2]; lg[4 * q + 3] += y[i] * ww[3]; }
                asm volatile("" ::: "memory");
            }
        }
        float r16[16], r8[8], r4[4], r2[2], r1;
        { const bool hb = (lane & 32) != 0;
#pragma unroll
          for (int i = 0; i < 16; ++i) { const float keep = hb ? lg[i + 16] : lg[i], send = hb ? lg[i] : lg[i + 16]; r16[i] = keep + __shfl_xor(send, 32); } }
        { const bool hb = (lane & 16) != 0;
#pragma unroll
          for (int i = 0; i < 8; ++i) { const float keep = hb ? r16[i + 8] : r16[i], send = hb ? r16[i] : r16[i + 8]; r8[i] = keep + __shfl_xor(send, 16); } }
        { const bool hb = (lane & 8) != 0;
#pragma unroll
          for (int i = 0; i < 4; ++i) { const float keep = hb ? r8[i + 4] : r8[i], send = hb ? r8[i] : r8[i + 4]; r4[i] = keep + __shfl_xor(send, 8); } }
        { const bool hb = (lane & 4) != 0;
#pragma unroll
          for (int i = 0; i < 2; ++i) { const float keep = hb ? r4[i + 2] : r4[i], send = hb ? r4[i] : r4[i + 2]; r2[i] = keep + __shfl_xor(send, 4); } }
        { const bool hb = (lane & 2) != 0; const float keep = hb ? r2[1] : r2[0], send = hb ? r2[0] : r2[1]; r1 = keep + __shfl_xor(send, 2); }
        r1 += __shfl_xor(r1, 1);
        const int mye = (lane >> 1) & 31;
        float myv = r1 + rb[mye];
        float tv[TOPK]; int ti[TOPK];
#pragma unroll
        for (int k = 0; k < TOPK; ++k) {
            float bv = myv; int bi = mye;
#pragma unroll
            for (int o = 1; o < 64; o <<= 1) { const float ov = __shfl_xor(bv, o); const int oi = __shfl_xor(bi, o); if (ov > bv || (ov == bv && oi < bi)) { bv = ov; bi = oi; } }
            tv[k] = bv; ti[k] = bi; if (mye == bi) myv = -3.0e38f;
        }
        const float e1 = __expf(tv[1] - tv[0]), e2 = __expf(tv[2] - tv[0]), e3 = __expf(tv[3] - tv[0]);
        const float inv = 1.f / (1.f + e1 + e2 + e3);
        if (lane == 0) {
            TOPI[m * 4 + 0] = ti[0]; TOPI[m * 4 + 1] = ti[1]; TOPI[m * 4 + 2] = ti[2]; TOPI[m * 4 + 3] = ti[3];
            TOPG[m * 4 + 0] = inv; TOPG[m * 4 + 1] = e1 * inv; TOPG[m * 4 + 2] = e2 * inv; TOPG[m * 4 + 3] = e3 * inv;
#pragma unroll
            for (int k = 0; k < TOPK; ++k) atomicAdd(F.ctl + CW_COUNTS + ti[k], 1u);
        }
    }
}

__device__ __forceinline__ void load_pstart(const Frame& F) {
    LAS int* ps = (LAS int*)(F.lds + PS_OFF);
    __syncthreads();
    if (F.tid == 0) { int acc = 0; for (int e = 0; e < NE; ++e) { ps[e] = acc; const int c = (int)__hip_atomic_load(F.ctl + CW_COUNTS + e, __ATOMIC_RELAXED, __HIP_MEMORY_SCOPE_AGENT); acc += ((c + EB - 1) / EB) * EB; } ps[NE] = acc; }
    __syncthreads();
}
__device__ __forceinline__ void ph_dest(const Frame& F) {
    load_pstart(F);
    const LAS int* ps = (const LAS int*)(F.lds + PS_OFF);
    const int* TOPI = (const int*)(F.ws + WS_TOPI); int* DEST = (int*)(F.ws + WS_DEST); int* TOK = (int*)(F.ws + WS_TOK);
    for (int a = blockIdx.x * 512 + F.tid; a < NASSIGN; a += F.G * 512) {
        const int e = TOPI[a]; const int pos = (int)atomicAdd(F.ctl + CW_CURSOR + e, 1u); const int d = ps[e] + pos;
        TOK[d] = a >> 2; DEST[a] = d;
    }
}

struct CfgMoe1 {
    const bf16_t* H1; const int* TOK; const float* W; const float* bgu; bf16_t* ACT; const LAS int* ps;
    __device__ __forceinline__ int expert(int tm) const { const int r0 = tm * 128; int e = 0;
#pragma unroll 1
        for (int i = 1; i < NE; ++i) e += (ps[i] <= r0) ? 1 : 0; return e; }
    __device__ __forceinline__ const bf16_t* arow(int row) const { return H1 + (size_t)TOK[row] * DM; }
    __device__ __forceinline__ const float* bptr(int tm) const { return W + (size_t)expert(tm) * DM * 2 * DE; }
    __device__ __forceinline__ int ldb() const { return 2 * DE; }
    __device__ __forceinline__ int K() const { return DM; }
    __device__ __forceinline__ void epi(int tm, int row, int col0, float v0, float v1) const {
        const int e = expert(tm);
        float g = v0 + bgu[e * 2 * DE + col0], l = v1 + bgu[e * 2 * DE + DE + col0];
        g = fminf(g, SWIGLU_LIMIT); l = fminf(fmaxf(l, -SWIGLU_LIMIT), SWIGLU_LIMIT);
        ACT[(size_t)row * DE + col0] = (bf16_t)f2bf(g * sigmoid_f(SWIGLU_ALPHA * g) * (l + 1.f));
    }
};
__device__ __forceinline__ void ph_moe1(const Frame& F) {
    load_pstart(F);
    const LAS int* ps = (const LAS int*)(F.lds + PS_OFF);
    CfgMoe1 c{(const bf16_t*)(F.ws + WS_H1), (const int*)(F.ws + WS_TOK), F.in[I_WGU], F.in[I_BGU], (bf16_t*)(F.ws + WS_ACT), ps};
    const int ntm = ps[NE] / 128; constexpr int NTN = DE / 64;
    for (int t = blockIdx.x; t < ntm * NTN; t += F.G) gemm_simple_tile<DE>(F, c, t / NTN, t % NTN);
}
struct CfgMoe2 {
    const bf16_t* ACT; const float* W; const float* bd; bf16_t* OUTS; const LAS int* ps;
    __device__ __forceinline__ int expert(int tm) const { const int r0 = tm * 128; int e = 0;
#pragma unroll 1
        for (int i = 1; i < NE; ++i) e += (ps[i] <= r0) ? 1 : 0; return e; }
    __device__ __forceinline__ const bf16_t* arow(int row) const { return ACT + (size_t)row * DE; }
    __device__ __forceinline__ const float* bptr(int tm) const { return W + (size_t)expert(tm) * DE * DM; }
    __device__ __forceinline__ int ldb() const { return DM; }
    __device__ __forceinline__ int K() const { return DE; }
    __device__ __forceinline__ void epi(int tm, int row, int col0, float v0, float v1) const {
        const int e = expert(tm);
        OUTS[(size_t)row * DM + col0] = (bf16_t)f2bf(v0 + bd[e * DM + col0]);
        OUTS[(size_t)row * DM + col0 + 16] = (bf16_t)f2bf(v1 + bd[e * DM + col0 + 16]);
    }
};
__device__ __forceinline__ void ph_moe2(const Frame& F) {
    load_pstart(F);
    const LAS int* ps = (const LAS int*)(F.lds + PS_OFF);
    CfgMoe2 c{(const bf16_t*)(F.ws + WS_ACT), F.in[I_WD], F.in[I_BD], (bf16_t*)(F.ws + WS_OUTS), ps};
    const int ntm = ps[NE] / 128; constexpr int NTN = DM / 128;
    for (int t = blockIdx.x; t < ntm * NTN; t += F.G) gemm_simple_tile<16>(F, c, t / NTN, t % NTN);
}


__device__ __forceinline__ void p0_transpose_item(const float* W, int K, int N, bf16_t* WT, bool paired, LAS float* scr, int item, int lane) {
    const int nblk = N / 32, kb = item / nblk, nb = item % nblk, k0 = 64 * kb, n0 = 32 * nb;
    int drow = n0;
    if (paired) { const int half = N >> 1, j = n0 % half; drow = (j >> 7) * 256 + (n0 / half) * 128 + (j & 127); }
#pragma unroll 8
    for (int i = 0; i < 32; ++i) { const int kk = 2 * i + (lane >> 5); scr[kk * 33 + (lane & 31)] = W[(size_t)(k0 + kk) * N + n0 + (lane & 31)]; }
    asm volatile("s_waitcnt lgkmcnt(0)" ::: "memory");
    const int c = lane & 7;
#pragma unroll
    for (int j = 0; j < 4; ++j) { const int n = (lane >> 3) + 8 * j; const LAS float* s = scr + (8 * c) * 33 + n;
        u32x4 o; o.x = pk2(s[0 * 33], s[1 * 33]); o.y = pk2(s[2 * 33], s[3 * 33]); o.z = pk2(s[4 * 33], s[5 * 33]); o.w = pk2(s[6 * 33], s[7 * 33]);
        *(u32x4*)(WT + (size_t)(drow + n) * K + k0 + 8 * c) = o; }
    asm volatile("s_waitcnt lgkmcnt(0)" ::: "memory");
}
__device__ __forceinline__ void ph_convert(const Frame& F) {
    LAS float* scr = (LAS float*)(F.lds + F.wave * 16384);
    constexpr int I_IN = (DM / 64) * (INW / 32), I_GLU = (SW / 64) * (2 * SW / 32), I_UP = (512 / 64) * (DM / 32), I_O = (DM / 64) * (DM / 32);
    constexpr int I_GU1 = (DM / 64) * (2 * DE / 32), I_D1 = (DE / 64) * (DM / 32);
    constexpr int NITEMS = I_IN + I_GLU + 2 * I_UP + I_O + NE * I_GU1 + NE * I_D1;
    for (int it = F.gw; it < NITEMS; it += F.NGW) {
        int r = it;
        if (r < NE * I_GU1) { const int e = r / I_GU1; p0_transpose_item(F.in[I_WGU] + (size_t)e * DM * 2 * DE, DM, 2 * DE, (bf16_t*)(F.ws + WS_WGU) + (size_t)e * 2 * DE * DM, true, scr, r % I_GU1, F.lane); continue; } r -= NE * I_GU1;
        if (r < NE * I_D1) { const int e = r / I_D1; p0_transpose_item(F.in[I_WD] + (size_t)e * DE * DM, DE, DM, (bf16_t*)(F.ws + WS_WD) + (size_t)e * DM * DE, false, scr, r % I_D1, F.lane); continue; } r -= NE * I_D1;
        if (r < I_IN) { p0_transpose_item(F.in[I_WIN], DM, INW, (bf16_t*)(F.ws + WS_WIN), false, scr, r, F.lane); continue; } r -= I_IN;
        if (r < I_GLU) { p0_transpose_item(F.in[I_WGLU], SW, 2 * SW, (bf16_t*)(F.ws + WS_WGLU), true, scr, r, F.lane); continue; } r -= I_GLU;
        if (r < I_UP) { p0_transpose_item(F.in[I_WUA], 512, DM, (bf16_t*)(F.ws + WS_WUA), false, scr, r, F.lane); continue; } r -= I_UP;
        if (r < I_UP) { p0_transpose_item(F.in[I_WUS], 512, DM, (bf16_t*)(F.ws + WS_WUS), false, scr, r, F.lane); continue; } r -= I_UP;
        p0_transpose_item(F.in[I_WO], DM, DM, (bf16_t*)(F.ws + WS_WO), false, scr, r, F.lane);
    }
    __syncthreads();
}

__device__ __forceinline__ void ph_inproj_fast(const Frame& F) {
    pg8::Gemm g{(const bf16_t*)(F.ws + WS_H0), (const bf16_t*)(F.ws + WS_WIN), DM};
    pg8::StaticOrder S; S.init(T / 256, INW / 256, F.G, (int)blockIdx.x);
    EpiInProj E{(bf16_t*)(F.ws + WS_Q), (bf16_t*)(F.ws + WS_K), (bf16_t*)(F.ws + WS_V), (bf16_t*)(F.ws + WS_U), (bf16_t*)(F.ws + WS_GA), (bf16_t*)(F.ws + WS_GS), F.in[I_BGATE], (bf16_t*)(F.ws + WS_VT)};
    pg8::gemm_phase<EpiInProj, pg8::StaticOrder, false>(F.lds, g, S, E);
}
__device__ __forceinline__ void ph_glu_fast(const Frame& F) {
    pg8::Gemm g{(const bf16_t*)(F.ws + WS_GY), (const bf16_t*)(F.ws + WS_WGLU), SW};
    pg8::StaticOrder S; S.init(T / 256, 2 * SW / 256, F.G, (int)blockIdx.x);
    EpiGlu E{(bf16_t*)(F.ws + WS_SG)};
    pg8::gemm_phase<EpiGlu, pg8::StaticOrder, false>(F.lds, g, S, E);
}
__device__ __forceinline__ void ph_up_fast(const Frame& F, bool second) {
    pg8::Gemm g{(const bf16_t*)(F.ws + (second ? WS_SG : WS_AO)), (const bf16_t*)(F.ws + (second ? WS_WUS : WS_WUA)), 512};
    pg8::StaticOrder S; S.init(T / 256, DM / 256, F.G, (int)blockIdx.x);
    EpiUp E{(const bf16_t*)(F.ws + (second ? WS_GS : WS_GA)), (bf16_t*)(F.ws + WS_TMPB), (bf16_t*)(F.ws + WS_Y), second};
    pg8::gemm_phase<EpiUp, pg8::StaticOrder, false>(F.lds, g, S, E);
}
__device__ __forceinline__ void ph_wo_fast(const Frame& F) {
    pg8::Gemm g{(const bf16_t*)(F.ws + WS_Y), (const bf16_t*)(F.ws + WS_WO), DM};
    pg8::StaticOrder S; S.init(T / 256, DM / 256, F.G, (int)blockIdx.x);
    EpiWo E{(const bf16_t*)(F.ws + WS_H0), (float*)(F.ws + WS_R1)};
    pg8::gemm_phase<EpiWo, pg8::StaticOrder, false>(F.lds, g, S, E);
}
__device__ __forceinline__ void ph_moe1_fast(const Frame& F) {
    load_pstart(F);
    const LAS int* ps = (const LAS int*)(F.lds + PS_OFF); LAS unsigned* tokl = (LAS unsigned*)(F.lds + TOKL_OFF);
    MoeOrder S; S.so.init(__builtin_amdgcn_readfirstlane(ps[NE]) / 256, 2 * DE / 256, F.G, (int)blockIdx.x); S.ps = ps; S.tokl = tokl; S.bt_per_e = 2 * DE / 256;
    const int* TOK = (const int*)(F.ws + WS_TOK);
    pg8::Unit u;
    for (int i = 0; i < TOKL_UNITS; ++i) { if (!S.next(i, u)) break; if (F.tid < 256) tokl[i * 256 + F.tid] = (unsigned)TOK[u.pm * 256 + F.tid] * (unsigned)(DM * 2); }
    __syncthreads();
    pg8::Gemm g{(const bf16_t*)(F.ws + WS_H1), (const bf16_t*)(F.ws + WS_WGU), DM};
    EpiMoe1 E{F.in[I_BGU], (bf16_t*)(F.ws + WS_ACT)};
    pg8::gemm_phase<EpiMoe1, MoeOrder, true>(F.lds, g, S, E);
}
__device__ __forceinline__ void ph_moe2_fast(const Frame& F) {
    load_pstart(F);
    const LAS int* ps = (const LAS int*)(F.lds + PS_OFF);
    MoeOrder S; S.so.init(__builtin_amdgcn_readfirstlane(ps[NE]) / 256, DM / 256, F.G, (int)blockIdx.x); S.ps = ps; S.tokl = nullptr; S.bt_per_e = DM / 256;
    pg8::Gemm g{(const bf16_t*)(F.ws + WS_ACT), (const bf16_t*)(F.ws + WS_WD), DE};
    EpiMoe2 E{F.in[I_BD], (bf16_t*)(F.ws + WS_OUTS)};
    pg8::gemm_phase<EpiMoe2, MoeOrder, false>(F.lds, g, S, E);
}
__device__ __forceinline__ void ph_combine(const Frame& F) {
    const bf16_t* H1 = (const bf16_t*)(F.ws + WS_H1); const bf16_t* OUTS = (const bf16_t*)(F.ws + WS_OUTS);
    const int* DEST = (const int*)(F.ws + WS_DEST); const float* TOPG = (const float*)(F.ws + WS_TOPG);
    const f32x4* g4 = (const f32x4*)F.in[I_LN2G]; const f32x4* b4 = (const f32x4*)F.in[I_LN2B];
    const int lane = F.lane;
    for (int m = F.gw; m < T; m += F.NGW) {
        f32x4 v[4];
        const u32x2* hr = (const u32x2*)(H1 + (size_t)m * DM) + lane;
#pragma unroll
        for (int j = 0; j < 4; ++j) { const u32x2 w = hr[64 * j]; v[j] = (f32x4){bf2f(w.x & 0xffffu), bf2f(w.x >> 16), bf2f(w.y & 0xffffu), bf2f(w.y >> 16)} * ALPHA; }
#pragma unroll
        for (int k = 0; k < TOPK; ++k) {
            const int d = DEST[m * 4 + k]; const float gk = TOPG[m * 4 + k];
            const u32x2* orow = (const u32x2*)(OUTS + (size_t)d * DM) + lane;
#pragma unroll
            for (int j = 0; j < 4; ++j) { const u32x2 w = orow[64 * j]; v[j] += (f32x4){bf2f(w.x & 0xffffu), bf2f(w.x >> 16), bf2f(w.y & 0xffffu), bf2f(w.y >> 16)} * gk; }
        }
        float s = 0.f;
#pragma unroll
        for (int j = 0; j < 4; ++j) s += (v[j][0] + v[j][1]) + (v[j][2] + v[j][3]);
        const float mean = wave_sum(s) * (1.f / DM); float s2 = 0.f;
#pragma unroll
        for (int j = 0; j < 4; ++j) { v[j] = v[j] - mean; s2 += (v[j][0] * v[j][0] + v[j][1] * v[j][1]) + (v[j][2] * v[j][2] + v[j][3] * v[j][3]); }
        const float rstd = 1.f / sqrtf(wave_sum(s2) * (1.f / DM) + LN_EPS);
        f32x4* o = (f32x4*)(F.out + (size_t)m * DM) + lane;
#pragma unroll
        for (int j = 0; j < 4; ++j) o[64 * j] = v[j] * rstd * g4[lane + 64 * j] + b4[lane + 64 * j];
    }
}


constexpr int N_PHASES = 13;

__global__ void __launch_bounds__(NWAVES * 64, 2) mega_fwd(Args args) {
    extern __shared__ __attribute__((aligned(16))) unsigned char lds[];
    Frame F;
    F.lds = (LAS unsigned char*)lds;
    F.tid = threadIdx.x; F.lane = F.tid & 63; F.wave = __builtin_amdgcn_readfirstlane(F.tid >> 6);
    F.G = gridDim.x; F.gw = blockIdx.x * NWAVES + F.wave; F.NGW = F.G * NWAVES;
    F.in = args.in; F.out = args.out; F.ws = args.ws; F.ctl = (unsigned*)(args.ws + WS_CTL);
    volatile LAS unsigned* MISC = (volatile LAS unsigned*)(F.lds + MISC_OFF);
    for (int u = F.tid; u < 64; u += NWAVES * 64) MISC[u] = 0u;
    __syncthreads();
    const int lo = args.ph_lo, hi = args.ph_hi;
    XcdBarrier bar; bar.bar = F.ctl + CW_BAR; bar.x = 0; bar.st = nullptr;
    if (hi - lo > 1) bar = xcd_barrier_post(F.ctl + CW_BAR, MISC + 8);
#define IN(k) (lo <= (k) && (k) < hi)
#define SEAM(k) do { if (IN(k) && IN((k) + 1)) xcd_barrier(bar); } while (0)
    if (IN(0)) { ph_ln_in(F); if (FAST_ANY) ph_convert(F); if (FAST_SSM) ph_ssm_tables(F); } SEAM(0);
    if (IN(1)) { if (FAST_INPROJ) ph_inproj_fast(F); else ph_inproj(F); } SEAM(1);
    if (IN(2)) {
#if FAST_SSM
        for (int u = blockIdx.x; u < BATCH * NG * 4; u += F.G) ph_ssm_xe(F, u);
        ph_attn_fast_b(F, blockIdx.x);
#else
        if (blockIdx.x < 8) ph_ssm_simple(F); else { Frame F2 = F; F2.G = F.G - 8; ph_attn_fast_b(F2, blockIdx.x - 8); }
#endif
    } SEAM(2);
    if (IN(3)) { if (FAST_SSM) ph_ssm_out(F); } SEAM(3);
    if (IN(4)) { if (FAST_MID) ph_glu_fast(F); else ph_glu(F); } SEAM(4);
    if (IN(5)) { if (FAST_MID) ph_up_fast(F, false); else ph_up(F, false); } SEAM(5);
    if (IN(6)) { if (FAST_MID) ph_up_fast(F, true); else ph_up(F, true); } SEAM(6);
    if (IN(7)) { if (FAST_MID) ph_wo_fast(F); else ph_wo(F); } SEAM(7);
    if (IN(8)) { ph_ln1_router(F); } SEAM(8);
    if (IN(9)) { ph_dest(F); } SEAM(9);
    if (IN(10)) { if (FAST_MOE1) ph_moe1_fast(F); else ph_moe1(F); } SEAM(10);
    if (IN(11)) { if (FAST_MOE2) ph_moe2_fast(F); else ph_moe2(F); } SEAM(11);
    if (IN(12)) { ph_combine(F); }
#undef IN
#undef SEAM
}

extern "C" void kernel_launch(void* const* d_in, const int* in_sizes, int n_in, void* d_out, int out_size, void* d_ws, size_t ws_size, hipStream_t stream) {
    static int grid = 0;
    if (grid == 0) {
        if (n_in != 28 || out_size != T * DM || ws_size < WS_END) { fprintf(stderr, "kernel_launch: unexpected shapes (n_in %d out %d ws %zu)\n", n_in, out_size, ws_size); grid = -1; return; }
        int dev = 0, cus = 0;
        if (hipGetDevice(&dev) != hipSuccess || hipDeviceGetAttribute(&cus, hipDeviceAttributeMultiprocessorCount, dev) != hipSuccess) { grid = -1; return; }
        if (hipFuncSetAttribute((const void*)mega_fwd, hipFuncAttributeMaxDynamicSharedMemorySize, LDS_BYTES) != hipSuccess) { fprintf(stderr, "kernel_launch: hipFuncSetAttribute failed\n"); grid = -1; return; }
        grid = cus;
    }
    if (grid < 0) return;
    (void)hipMemsetAsync((char*)d_ws + WS_CTL, 0, CTL_ZERO_BYTES, stream);
    Args a{};
    for (int i = 0; i < 28; ++i) a.in[i] = (const float*)d_in[i];
    a.out = (float*)d_out; a.ws = (unsigned char*)d_ws;
#if MK_ONE_LAUNCH
    a.ph_lo = 0; a.ph_hi = N_PHASES;
    hipLaunchKernelGGL(mega_fwd, dim3(grid), dim3(NWAVES * 64), LDS_BYTES, stream, a);
#else
    for (int p = 0; p < N_PHASES; ++p) { a.ph_lo = p; a.ph_hi = p + 1; hipLaunchKernelGGL(mega_fwd, dim3(grid), dim3(NWAVES * 64), LDS_BYTES, stream, a); }
#endif
}
```

```cpp
#include <hip/hip_runtime.h>
#include <cstdio>
#include <cstdint>

#ifndef FAST_INPROJ
#define FAST_INPROJ 1
#endif
#ifndef FAST_MID
#define FAST_MID 1
#endif
#ifndef FAST_MOE1
#define FAST_MOE1 1
#endif
#ifndef REPEAT_PHASE
#define REPEAT_PHASE (-1)
#endif
#ifndef REPEAT_N
#define REPEAT_N 3
#endif
#ifndef FAST_SSM
#define FAST_SSM 1
#endif
#ifndef FAST_ATTN
#define FAST_ATTN 1
#endif
#ifndef FAST_MOE2
#define FAST_MOE2 1
#endif
#define FAST_ANY (FAST_INPROJ || FAST_MID || FAST_MOE1 || FAST_MOE2)
#ifndef MK_ONE_LAUNCH
#define MK_ONE_LAUNCH 1
#endif

#define GAS __attribute__((address_space(1)))
#define LAS __attribute__((address_space(3)))
typedef unsigned short bf16_t;
typedef short bf16x8 __attribute__((ext_vector_type(8)));
typedef float f32x4 __attribute__((ext_vector_type(4)));
typedef unsigned u32x4 __attribute__((ext_vector_type(4)));
typedef unsigned u32x2 __attribute__((ext_vector_type(2)));

constexpr int BATCH = 2, SEQ = 8192, T = BATCH * SEQ, DM = 1024;
constexpr int CHUNK = 64, LEFT = 8, NCH = SEQ / CHUNK;
constexpr int NH = 8, HD = 64, AW = 512, RELMAX = 256, RELSIZE = 320;
constexpr int SW = 512, GSZ = 16, NG = 32, NP = 64;
constexpr int INW = 4096;
constexpr int NE = 32, TOPK = 4, DE = 1024, EB = 256;
constexpr int NASSIGN = T * TOPK;
constexpr int NROWS = NASSIGN + NE * EB;
constexpr float LN_EPS = 1e-5f;
constexpr float ALPHA = 1.189207115002721f;
constexpr float SWIGLU_LIMIT = 7.0f, SWIGLU_ALPHA = 1.702f;
constexpr int NWAVES = 8;
constexpr float LOG2E = 1.4426950408889634f, QSCALE = 0.125f * LOG2E;
constexpr int LDS_BYTES = 147456;
constexpr int MISC_OFF = 131072 + 320, PS_OFF = 131072 + 1024, TOKL_OFF = 131072 + 2048, TOKL_UNITS = 10;

constexpr size_t MiB = 1u << 20;
constexpr size_t WS_CTL = 0, CTL_ZERO_BYTES = 1 * MiB;
constexpr size_t WS_H0 = 1 * MiB;
constexpr size_t WS_Q = 33 * MiB;
constexpr size_t WS_K = 49 * MiB;
constexpr size_t WS_V = 65 * MiB;
constexpr size_t WS_U = 81 * MiB;
constexpr size_t WS_GA = 97 * MiB;
constexpr size_t WS_GS = 129 * MiB;
constexpr size_t WS_AO = 161 * MiB;
constexpr size_t WS_GY = 177 * MiB;
constexpr size_t WS_SG = 193 * MiB;
constexpr size_t WS_Y = 209 * MiB;
constexpr size_t WS_R1 = 241 * MiB;
constexpr size_t WS_H1 = 305 * MiB;
constexpr size_t WS_TOPI = 338 * MiB;
constexpr size_t WS_TOPG = 339 * MiB;
constexpr size_t WS_DEST = 340 * MiB;
constexpr size_t WS_TOK = 341 * MiB;
constexpr size_t WS_ACT = 342 * MiB;
constexpr size_t WS_OUTS = 486 * MiB;
constexpr size_t WS_WIN = 630 * MiB;
constexpr size_t WS_WGLU = 638 * MiB;
constexpr size_t WS_WUA = 639 * MiB;
constexpr size_t WS_WUS = 640 * MiB;
constexpr size_t WS_WO = 641 * MiB;
constexpr size_t WS_WGU = 643 * MiB;
constexpr size_t WS_WD = 771 * MiB;
constexpr size_t WS_TMPB = WS_R1;
constexpr size_t WS_VT = 835 * MiB;
constexpr size_t WS_LP = 851 * MiB;
constexpr size_t WS_LLP = 853 * MiB;
constexpr size_t WS_WST = 855 * MiB;
constexpr size_t WS_KDT = 863 * MiB;
constexpr size_t WS_CINT = 864 * MiB;
constexpr size_t WS_XSL = 865 * MiB;
constexpr size_t WS_UEND = 869 * MiB;
constexpr size_t WS_GWP = 870 * MiB;
constexpr size_t WS_RC = 871 * MiB;
constexpr size_t WS_HIST = 872 * MiB;
constexpr size_t WS_LRANK = 873 * MiB;
constexpr size_t WS_END = 874 * MiB;
constexpr int CW_COUNTS = 64, CW_CURSOR = 128;
constexpr int CW_BAR = 4096;

__device__ __forceinline__ unsigned f2bf(float f) { unsigned u = __float_as_uint(f); return (u + 0x7fffu + ((u >> 16) & 1u)) >> 16; }
__device__ __forceinline__ float bf2f(unsigned h) { return __uint_as_float(h << 16); }
__device__ __forceinline__ unsigned pk2(float lo, float hi) { return f2bf(lo) | (f2bf(hi) << 16); }
__device__ __forceinline__ float wave_sum(float v) {
#pragma unroll
    for (int o = 1; o < 64; o <<= 1) v += __shfl_xor(v, o);
    return v;
}
__device__ __forceinline__ float sigmoid_f(float x) { return __builtin_amdgcn_rcpf(1.f + __builtin_amdgcn_exp2f(-1.4426950408889634f * x)); }
__device__ __forceinline__ float gelu_tanh(float x) { const float z = 0.7978845608028654f * (x + 0.044715f * x * x * x); return x * sigmoid_f(2.f * z); }

__device__ __forceinline__ void sincos_d(double x, double& s, double& c) {
    const double kd = rint(x * 0.63661977236758134308);
    const int k = (int)kd;
    double r = fma(-kd, 1.57079632679489655800e+00, x);
    r = fma(-kd, 6.12323399573676603587e-17, r);
    const double r2 = r * r;
    double sp = -1.0 / 1307674368000.0;
    sp = sp * r2 + 1.0 / 6227020800.0; sp = sp * r2 - 1.0 / 39916800.0; sp = sp * r2 + 1.0 / 362880.0; sp = sp * r2 - 1.0 / 5040.0; sp = sp * r2 + 1.0 / 120.0; sp = sp * r2 - 1.0 / 6.0;
    sp = r + r * r2 * sp;
    double cp = -1.0 / 87178291200.0;
    cp = cp * r2 + 1.0 / 479001600.0; cp = cp * r2 - 1.0 / 3628800.0; cp = cp * r2 + 1.0 / 40320.0; cp = cp * r2 - 1.0 / 720.0; cp = cp * r2 + 1.0 / 24.0; cp = cp * r2 - 0.5;
    cp = 1.0 + r2 * cp;
    const int q = k & 3;
    s = (q == 0) ? sp : (q == 1) ? cp : (q == 2) ? -sp : -cp;
    c = (q == 0) ? cp : (q == 1) ? -sp : (q == 2) ? -cp : sp;
}

#define XB_TMO      128
#define XB_XCNT(j)  (256  + 64 * (j))
#define XB_XSUB(j)  (1280 + 64 * (j))
#define XB_XGEN(j)  (2304 + 64 * (j))
#define XB_TOP      3328
#define XB_TOPGEN   3392
#define XCD_BAR_WORDS 3456
#define XB_SPIN_CAP (1u << 22)
__device__ __forceinline__ unsigned xb_ld(unsigned* p)              { return __hip_atomic_load(p, __ATOMIC_RELAXED, __HIP_MEMORY_SCOPE_AGENT); }
__device__ __forceinline__ unsigned xb_add(unsigned* p, unsigned v) { return __hip_atomic_fetch_add(p, v, __ATOMIC_RELAXED, __HIP_MEMORY_SCOPE_AGENT); }
__device__ __forceinline__ unsigned xb_xcc_id() { return (unsigned)__builtin_amdgcn_s_getreg((3 << 11) | 20) & 0xFu; }
#define XB_SPIN(cond, bar) do { unsigned _sp = 0; while (cond) { __builtin_amdgcn_s_sleep(1); \
    if ((++_sp & 255u) == 0u) { if (xb_ld(&(bar)[XB_TMO])) break; if (_sp > XB_SPIN_CAP) { atomicAdd(&(bar)[XB_TMO], 1u); break; } } } } while (0)
struct XcdBarrier { unsigned* bar; unsigned x; volatile LAS unsigned* st; };
__device__ __forceinline__ XcdBarrier xcd_barrier_post(unsigned* bar, volatile LAS unsigned* st) {
    XcdBarrier b; b.bar = bar; b.x = xb_xcc_id(); b.st = st;
    if (threadIdx.x == 0) (void)xb_add(&bar[XB_XCNT(b.x)], 1u);
    return b;
}
__device__ __forceinline__ void xcd_barrier_complete(unsigned* bar, unsigned x, unsigned& nloc, unsigned& nx) {
    const unsigned G = gridDim.x * gridDim.y * gridDim.z;
    unsigned sum, cnt, mine, sp = 0u;
    for (;;) {
        sum = 0u; cnt = 0u; mine = 0u;
#pragma unroll
        for (unsigned j = 0; j < 16; ++j) { const unsigned c = xb_ld(&bar[XB_XCNT(j)]); sum += c; cnt += (c > 0u) ? 1u : 0u; mine = (j == x) ? c : mine; }
        if (sum == G) break;
        __builtin_amdgcn_s_sleep(1);
        if ((++sp & 255u) == 0u) { if (xb_ld(&bar[XB_TMO])) break; if (sp > XB_SPIN_CAP) { atomicAdd(&bar[XB_TMO], 1u); break; } }
    }
    nloc = mine > 0u ? mine : 1u; nx = cnt > 0u ? cnt : 1u;
}
__device__ __forceinline__ void xcd_barrier(const XcdBarrier& b) {
    asm volatile("s_waitcnt vmcnt(0)" ::: "memory");
    __syncthreads();
    if (threadIdx.x == 0) {
        unsigned* bar = b.bar;
        __builtin_amdgcn_s_waitcnt(0);
        unsigned nloc = b.st[0], nx = b.st[1];
        if (nloc == 0u) { xcd_barrier_complete(bar, b.x, nloc, nx); b.st[0] = nloc; b.st[1] = nx; }
        const unsigned old = xb_add(&bar[XB_XSUB(b.x)], 1u);
        const unsigned gen = old / nloc;
        if (old + 1u == (gen + 1u) * nloc) {
            __builtin_amdgcn_fence(__ATOMIC_RELEASE, "agent");
            asm volatile("s_waitcnt vmcnt(0)" ::: "memory");
            const unsigned og = xb_add(&bar[XB_TOP], 1u);
            const unsigned tg = og / nx;
            if (og + 1u == (tg + 1u) * nx) xb_add(&bar[XB_TOPGEN], 1u);
            else XB_SPIN(xb_ld(&bar[XB_TOPGEN]) == tg, bar);
            __builtin_amdgcn_fence(__ATOMIC_ACQUIRE, "agent");
            xb_add(&bar[XB_XGEN(b.x)], 1u);
            asm volatile("s_waitcnt vmcnt(0)" ::: "memory");
        } else {
            XB_SPIN(xb_ld(&bar[XB_XGEN(b.x)]) == gen, bar);
            __builtin_amdgcn_fence(__ATOMIC_ACQUIRE, "agent");
            asm volatile("s_waitcnt vmcnt(0)" ::: "memory");
        }
    }
    __syncthreads();
}


namespace pg8 {
#define PG8_LAS __attribute__((address_space(3)))
constexpr int BM = 256, BK = 64, HALF = 128, HTB = HALF * BK * 2, STAGE_BYTES = 8 * HTB, NXCD = 8, WGM = 8;
__host__ __device__ __forceinline__ int lds_byte(int r, int c) { const int st = (r >> 4) * 2 + (c >> 5), rr = r & 15, cc = c & 31, ob = rr * 64 + cc * 2; return st * 1024 + (ob ^ (((ob >> 9) & 1) << 5)); }
__host__ __device__ __forceinline__ void stage_rc(int b, int& R, int& C) { const int st = b / 1024, sb = b % 1024, swz = sb ^ (((sb >> 9) & 1) << 5); R = (st >> 1) * 16 + swz / 64; C = (st & 1) * 32 + (swz % 64) / 2; }
__host__ __device__ __forceinline__ int perm32(int rho) { const int n = rho >> 4, i = rho & 15; return 8 * (i >> 2) + 4 * n + (i & 3); }
struct Unit { int pm, pn, bn, ex; };
struct Gemm { const bf16_t* A; const bf16_t* Bt; int K; };
struct StaticOrder {
    int nM, nN, nwg, G, c;
    __device__ void init(int nM_, int nN_, int G_, int c_) { nM = nM_; nN = nN_; nwg = nM * nN; G = G_; c = c_; }
    __device__ bool next(int i, Unit& u) const {
        const long L = (long)i * G + c; if (L >= nwg) return false;
        int wgid = (int)L; { const int q = nwg / NXCD, r = nwg % NXCD, xcd = wgid % NXCD, off = wgid / NXCD; wgid = (xcd < r ? xcd * (q + 1) : r * (q + 1) + (xcd - r) * q) + off; }
        const int nig = WGM * nN, gid = wgid / nig, fm = gid * WGM, gsz = (nM - fm) < WGM ? (nM - fm) : WGM;
        u.pm = fm + ((wgid % nig) % gsz); u.pn = (wgid % nig) / gsz; u.bn = u.pn; u.ex = 0; return true;
    }
    __device__ __forceinline__ unsigned rowoff(int, int) const { return 0u; }
};
typedef float f32x2_t __attribute__((ext_vector_type(2))); typedef __bf16 bf16x2_t __attribute__((ext_vector_type(2)));
__device__ __forceinline__ unsigned cvt_pk_bf16(float lo, float hi) { const f32x2_t v = {lo, hi}; const bf16x2_t b = __builtin_convertvector(v, bf16x2_t); return __builtin_bit_cast(unsigned, b); }

template <class Epi, class Sched, bool GATHER>
__device__ __forceinline__ void gemm_phase(PG8_LAS unsigned char* lds, const Gemm g, const Sched& S, const Epi& E) {
    const int tid = threadIdx.x, wid = __builtin_amdgcn_readfirstlane(tid >> 6), lane = tid & 63, wr = wid >> 2, wc = wid & 3, fr = lane & 15, fq = lane >> 4;
    const int K = g.K, nt = K / BK;
    unsigned voffA0[2], voffA1[2], voffB[2];
#pragma unroll
    for (int i = 0; i < 2; ++i) { int R, C; stage_rc(tid * 16 + i * 8192, R, C); const int Rb = Epi::PERM ? ((R & ~31) + perm32(R & 31)) : R;
        voffA0[i] = (unsigned)(R * K + C) * 2u; voffA1[i] = voffA0[i] + (unsigned)(HALF * K * 2); voffB[i] = (unsigned)(Rb * K + C) * 2u; }
    const size_t kstep = (size_t)(BK * 2);
    const size_t hstep = (size_t)HALF * K * 2;
    const size_t tstep = 2 * hstep;
    const unsigned ldsw = (unsigned)wid * 1024u;
    const int aoff = lds_byte(wr * 64 + fr, fq * 8), boff = lds_byte(wc * 32 + fr, fq * 8);
#define PG8_SA(b, h) (((b) * 2 + (h)) * HTB)
#define PG8_SB(b, h) ((4 + (b) * 2 + (h)) * HTB)
#define PG8_STAGE(bufoff, gbase, voff) do { _Pragma("unroll") for (int _i = 0; _i < 2; ++_i) \
        __builtin_amdgcn_global_load_lds((const unsigned*)((const char*)(gbase) + (voff)[_i]), (PG8_LAS unsigned*)(lds + (bufoff) + ldsw + _i * 8192), 16, 0, 0); } while (0)
#define PG8_LDA(dst, b, h) do { _Pragma("unroll") for (int m = 0; m < 4; ++m) _Pragma("unroll") for (int k = 0; k < 2; ++k) dst[m][k] = *(const PG8_LAS bf16x8*)(lds + PG8_SA(b, h) + aoff + m * 2048 + k * 1024); } while (0)
#define PG8_LDB(dst, b, h) do { _Pragma("unroll") for (int n = 0; n < 2; ++n) _Pragma("unroll") for (int k = 0; k < 2; ++k) dst[n][k] = *(const PG8_LAS bf16x8*)(lds + PG8_SB(b, h) + boff + n * 2048 + k * 1024); } while (0)
#define PG8_MMA(ai, bj, At, Bt) do { __builtin_amdgcn_s_setprio(1); _Pragma("unroll") for (int m = 0; m < 4; ++m) _Pragma("unroll") for (int n = 0; n < 2; ++n) _Pragma("unroll") for (int k = 0; k < 2; ++k) \
        acc[ai][bj][m][n] = __builtin_amdgcn_mfma_f32_16x16x32_bf16(Bt[n][k], At[m][k], acc[ai][bj][m][n], 0, 0, 0); __builtin_amdgcn_s_setprio(0); } while (0)
#define PG8_WAIT_V(n) asm volatile("s_waitcnt vmcnt(" #n ")" ::: "memory")
#define PG8_WAIT_L(n) asm volatile("s_waitcnt lgkmcnt(" #n ")" ::: "memory")
#define PG8_BAR __builtin_amdgcn_s_barrier()
#define PG8_SCHED __builtin_amdgcn_sched_barrier(0)
#define PG8_GOFF(ui_) do { if constexpr (GATHER) { _Pragma("unroll") for (int _i = 0; _i < 2; ++_i) { int R_, C_; stage_rc(tid * 16 + _i * 8192, R_, C_); \
        voffA0[_i] = S.rowoff((ui_), R_) + (unsigned)(C_ * 2); voffA1[_i] = S.rowoff((ui_), HALF + R_) + (unsigned)(C_ * 2); } } } while (0)
    Unit cur, nxt; int ui = 0;
    if (!S.next(0, cur)) return;
    f32x4 acc[2][2][4][2];
#pragma unroll
    for (int a = 0; a < 2; ++a)
#pragma unroll
        for (int b = 0; b < 2; ++b)
#pragma unroll
            for (int m = 0; m < 4; ++m)
#pragma unroll
                for (int n = 0; n < 2; ++n) acc[a][b][m][n] = (f32x4){0.f, 0.f, 0.f, 0.f};
    bf16x8 At[4][2], B0[2][2], B1[2][2];
    PG8_GOFF(0);
    const char* cA = GATHER ? (const char*)g.A : (const char*)g.A + (size_t)cur.pm * tstep; const char* cB = (const char*)g.Bt + (size_t)cur.bn * tstep;
    PG8_STAGE(PG8_SB(0, 0), cB, voffB); PG8_STAGE(PG8_SB(0, 1), cB + hstep, voffB); PG8_STAGE(PG8_SA(0, 0), cA, voffA0); PG8_STAGE(PG8_SA(0, 1), cA, voffA1);
    if (wr == 1) PG8_BAR;
    PG8_WAIT_V(2); PG8_BAR;
    PG8_STAGE(PG8_SB(1, 0), cB + kstep, voffB); PG8_STAGE(PG8_SA(1, 0), cA + kstep, voffA0); PG8_STAGE(PG8_SB(1, 1), cB + hstep + kstep, voffB);
    PG8_WAIT_V(6); PG8_BAR;
    for (;;) {
        const bool has_next = S.next(ui + 1, nxt);
        const char* nA = GATHER ? (const char*)g.A : (has_next ? (const char*)g.A + (size_t)nxt.pm * tstep : cA);
        const char* nB = has_next ? (const char*)g.Bt + (size_t)nxt.bn * tstep : cB;
        for (int t = 0; t < nt; t += 2) {
            const bool last = (t == nt - 2);
            const char* a1 = cA + (size_t)(t + 1) * kstep;
            const char* a2 = last ? nA : cA + (size_t)(t + 2) * kstep; const char* b2 = last ? nB : cB + (size_t)(t + 2) * kstep;
            const char* a3 = a2 + kstep; const char* b3 = b2 + kstep;
            PG8_LDB(B0, 0, 0); PG8_LDB(B1, 0, 1); PG8_SCHED; PG8_LDA(At, 0, 0); PG8_STAGE(PG8_SA(1, 1), a1, voffA1);
            if (GATHER && last && has_next) { PG8_GOFF(ui + 1); }
            PG8_WAIT_V(8); PG8_WAIT_L(0); PG8_BAR; PG8_MMA(0, 0, At, B0); PG8_MMA(0, 1, At, B1); PG8_BAR; PG8_SCHED;
            PG8_LDA(At, 0, 1); PG8_STAGE(PG8_SB(0, 0), b2, voffB); PG8_STAGE(PG8_SB(0, 1), b2 + hstep, voffB); PG8_STAGE(PG8_SA(0, 0), a2, voffA0);
            PG8_WAIT_V(8); PG8_WAIT_L(0); PG8_BAR; PG8_MMA(1, 0, At, B0); PG8_MMA(1, 1, At, B1); PG8_BAR; PG8_SCHED;
            PG8_LDB(B0, 1, 0); PG8_LDB(B1, 1, 1); PG8_SCHED; PG8_LDA(At, 1, 0); PG8_STAGE(PG8_SA(0, 1), a2, voffA1);
            PG8_WAIT_V(8); PG8_WAIT_L(0); PG8_BAR; PG8_MMA(0, 0, At, B0); PG8_MMA(0, 1, At, B1); PG8_BAR; PG8_SCHED;
            PG8_LDA(At, 1, 1); PG8_STAGE(PG8_SB(1, 0), b3, voffB); PG8_STAGE(PG8_SB(1, 1), b3 + hstep, voffB); PG8_STAGE(PG8_SA(1, 0), a3, voffA0);
            PG8_WAIT_V(8); PG8_WAIT_L(0); PG8_BAR; PG8_MMA(1, 0, At, B0); PG8_MMA(1, 1, At, B1); PG8_BAR; PG8_SCHED;
        }
        if (wr == 0) PG8_BAR;
        E(acc, cur, wr, wc, fr, fq);
        if (!has_next) break;
#pragma unroll
        for (int a = 0; a < 2; ++a)
#pragma unroll
            for (int b = 0; b < 2; ++b)
#pragma unroll
                for (int m = 0; m < 4; ++m)
#pragma unroll
                    for (int n = 0; n < 2; ++n) acc[a][b][m][n] = (f32x4){0.f, 0.f, 0.f, 0.f};
        cur = nxt; cA = nA; cB = nB; ++ui;
        if (wr == 1) PG8_BAR;
    }
    PG8_WAIT_V(0);
    PG8_BAR;
#undef PG8_SA
#undef PG8_SB
#undef PG8_STAGE
#undef PG8_LDA
#undef PG8_LDB
#undef PG8_MMA
#undef PG8_WAIT_V
#undef PG8_WAIT_L
#undef PG8_BAR
#undef PG8_SCHED
#undef PG8_GOFF
}
}

struct Args {
    const float* in[28];
    float* out; unsigned char* ws;
    int ph_lo, ph_hi;
};
enum { I_X = 0, I_LNIG, I_LNIB, I_WIN, I_BGATE, I_RELB, I_LAMRE, I_LAMIM, I_LOGDT, I_BRE, I_BIM, I_CRE, I_CIM, I_SSMD, I_WGLU, I_WUA, I_WUS, I_WO,
       I_LN1G, I_LN1B, I_RW, I_RB, I_WGU, I_BGU, I_WD, I_BD, I_LN2G, I_LN2B };

struct Frame {
    LAS unsigned char* lds;
    int tid, lane, wave, G, gw, NGW;
    const float* const* in;
    float* out; unsigned char* ws;
    unsigned* ctl;
};

template <int PS> __device__ __forceinline__ int colbase(int tn, int wc) { return PS == 16 ? tn * 128 + wc * 32 : tn * 64 + wc * 16; }

template <int PS, class Cfg>
__device__ __forceinline__ void gemm_simple_tile(const Frame& F, const Cfg& c, int tm, int tn) {
    LAS bf16_t* As = (LAS bf16_t*)F.lds;
    LAS bf16_t* Bs = As + 128 * 40;
    const int tid = F.tid, lane = F.lane, w = F.wave, wr = w >> 2, wc = w & 3;
    f32x4 acc[4][2];
#pragma unroll
    for (int m = 0; m < 4; ++m)
#pragma unroll
        for (int n = 0; n < 2; ++n) acc[m][n] = (f32x4){0.f, 0.f, 0.f, 0.f};
    const int ar = tid >> 2, ak = (tid & 3) * 8;
    const bf16_t* ap = c.arow(tm * 128 + ar) + ak;
    const int bk = tid >> 4, bc = (tid & 15) * 8;
    const int pc = colbase<PS>(tn, bc >> 5) + ((bc >> 4) & 1) * PS + (bc & 15);
    const int ldb = c.ldb();
    const float* bp = c.bptr(tm) + (size_t)bk * ldb + pc;
    const int K = c.K();
    for (int k0 = 0; k0 < K; k0 += 32) {
        const u32x4 av = *(const u32x4*)(ap + k0);
        const f32x4 b0 = *(const f32x4*)(bp + (size_t)k0 * ldb), b1 = *(const f32x4*)(bp + (size_t)k0 * ldb + 4);
        __syncthreads();
        *(LAS u32x4*)(As + ar * 40 + ak) = av;
        Bs[(bc + 0) * 40 + bk] = (bf16_t)f2bf(b0[0]); Bs[(bc + 1) * 40 + bk] = (bf16_t)f2bf(b0[1]);
        Bs[(bc + 2) * 40 + bk] = (bf16_t)f2bf(b0[2]); Bs[(bc + 3) * 40 + bk] = (bf16_t)f2bf(b0[3]);
        Bs[(bc + 4) * 40 + bk] = (bf16_t)f2bf(b1[0]); Bs[(bc + 5) * 40 + bk] = (bf16_t)f2bf(b1[1]);
        Bs[(bc + 6) * 40 + bk] = (bf16_t)f2bf(b1[2]); Bs[(bc + 7) * 40 + bk] = (bf16_t)f2bf(b1[3]);
        __syncthreads();
        bf16x8 a[4], b[2];
#pragma unroll
        for (int m = 0; m < 4; ++m) a[m] = *(const LAS bf16x8*)(As + (wr * 64 + m * 16 + (lane & 15)) * 40 + (lane >> 4) * 8);
#pragma unroll
        for (int n = 0; n < 2; ++n) b[n] = *(const LAS bf16x8*)(Bs + (wc * 32 + n * 16 + (lane & 15)) * 40 + (lane >> 4) * 8);
#pragma unroll
        for (int m = 0; m < 4; ++m)
#pragma unroll
            for (int n = 0; n < 2; ++n) acc[m][n] = __builtin_amdgcn_mfma_f32_16x16x32_bf16(a[m], b[n], acc[m][n], 0, 0, 0);
    }
    const int col0 = colbase<PS>(tn, wc) + (lane & 15);
#pragma unroll
    for (int m = 0; m < 4; ++m)
#pragma unroll
        for (int r = 0; r < 4; ++r) {
            const int row = tm * 128 + wr * 64 + m * 16 + (lane >> 4) * 4 + r;
            c.epi(tm, row, col0, acc[m][0][r], acc[m][1][r]);
        }
    __syncthreads();
}


__device__ __forceinline__ void store8(bf16_t* p, const f32x4 v0, const f32x4 v1) {
    u32x4 w; w.x = pg8::cvt_pk_bf16(v0[0], v0[1]); w.y = pg8::cvt_pk_bf16(v0[2], v0[3]); w.z = pg8::cvt_pk_bf16(v1[0], v1[1]); w.w = pg8::cvt_pk_bf16(v1[2], v1[3]);
    *(u32x4*)p = w;
}
__device__ __forceinline__ void load8(const bf16_t* p, f32x4& v0, f32x4& v1) {
    const u32x4 w = *(const u32x4*)p;
    v0 = (f32x4){bf2f(w.x & 0xffffu), bf2f(w.x >> 16), bf2f(w.y & 0xffffu), bf2f(w.y >> 16)};
    v1 = (f32x4){bf2f(w.z & 0xffffu), bf2f(w.z >> 16), bf2f(w.w & 0xffffu), bf2f(w.w >> 16)};
}
__device__ __forceinline__ f32x4 sigmoid4(const f32x4 v) { return (f32x4){sigmoid_f(v[0]), sigmoid_f(v[1]), sigmoid_f(v[2]), sigmoid_f(v[3])}; }

struct EpiInProj {
    static constexpr bool PERM = true;
    bf16_t *Q, *Kb, *V, *U, *GA, *GS; const float* bgate; bf16_t* VT; LAS unsigned char* tl;
    __device__ __forceinline__ void operator()(const f32x4 (&acc)[2][2][4][2], const pg8::Unit& u, int wr, int wc, int fr, int fq) const {
        const int pn = u.pn, row0 = u.pm * 256 + wr * 64 + fr, colin = wc * 32 + 8 * fq;
        bf16_t* base; int ld, cb; float sc = 1.f; const bool gate = pn >= 8;
        if (pn < 8) { base = pn < 2 ? Q : (pn < 4 ? Kb : (pn < 6 ? V : U)); ld = 512; cb = (pn & 1) * 256; if (pn < 2) sc = QSCALE; }
        else { base = pn < 12 ? GA : GS; ld = 1024; cb = (pn & 3) * 256; }
#pragma unroll
        for (int bj = 0; bj < 2; ++bj) {
            f32x4 b0 = (f32x4){0.f, 0.f, 0.f, 0.f}, b1 = b0;
            if (gate) { const float* bp = bgate + (pn - 8) * 256 + bj * 128 + colin; b0 = *(const f32x4*)bp; b1 = *(const f32x4*)(bp + 4); }
#pragma unroll
            for (int ai = 0; ai < 2; ++ai)
#pragma unroll
                for (int m = 0; m < 4; ++m) {
                    f32x4 v0 = acc[ai][bj][m][0], v1 = acc[ai][bj][m][1];
                    if (gate) { v0 = sigmoid4(v0 + b0); v1 = sigmoid4(v1 + b1); } else { v0 = v0 * sc; v1 = v1 * sc; }
                    store8(base + (size_t)(row0 + ai * 128 + m * 16) * ld + cb + bj * 128 + colin, v0, v1);
                    if (pn == 4 || pn == 5) {
                        LAS bf16_t* pl = (LAS bf16_t*)(tl + (wr * 4 + wc) * 1024);
                        const int pos = (fr & 3) | ((fr & 4) << 1) | ((fr & 8) >> 1);
#pragma unroll
                        for (int j = 0; j < 4; ++j) { pl[(8 * fq + j) * 16 + pos] = (bf16_t)f2bf(v0[j]); pl[(8 * fq + 4 + j) * 16 + pos] = (bf16_t)f2bf(v1[j]); }
                        asm volatile("s_waitcnt lgkmcnt(0)" ::: "memory");
                        const int lane = fq * 16 + fr;
                        const u32x4 w = *(const LAS u32x4*)(pl + (lane >> 1) * 16 + 8 * (lane & 1));
                        asm volatile("s_waitcnt lgkmcnt(0)" ::: "memory");
                        const int trow = u.pm * 256 + wr * 64 + ai * 128 + m * 16, b = trow / SEQ, tt0 = trow % SEQ;
                        const int d = cb + bj * 128 + wc * 32 + (lane >> 1);
                        *(u32x4*)(VT + ((size_t)(b * NH) * HD + d) * SEQ + tt0 + 8 * (lane & 1)) = w;
                    }
                }
        }
    }
};
struct EpiGlu {
    static constexpr bool PERM = true;
    bf16_t* SGo;
    __device__ __forceinline__ void operator()(const f32x4 (&acc)[2][2][4][2], const pg8::Unit& u, int wr, int wc, int fr, int fq) const {
        const int row0 = u.pm * 256 + wr * 64 + fr, col = u.pn * 128 + wc * 32 + 8 * fq;
#pragma unroll
        for (int ai = 0; ai < 2; ++ai)
#pragma unroll
            for (int m = 0; m < 4; ++m)
                store8(SGo + (size_t)(row0 + ai * 128 + m * 16) * SW + col, acc[ai][0][m][0] * sigmoid4(acc[ai][1][m][0]), acc[ai][0][m][1] * sigmoid4(acc[ai][1][m][1]));
    }
};
struct EpiUp {
    static constexpr bool PERM = true;
    const bf16_t* gate; bf16_t* tmp; bf16_t* Y; bool second;
    __device__ __forceinline__ void operator()(const f32x4 (&acc)[2][2][4][2], const pg8::Unit& u, int wr, int wc, int fr, int fq) const {
        const int row0 = u.pm * 256 + wr * 64 + fr, col0 = u.pn * 256 + wc * 32 + 8 * fq;
#pragma unroll
        for (int ai = 0; ai < 2; ++ai)
#pragma unroll
            for (int m = 0; m < 4; ++m)
#pragma unroll
                for (int bj = 0; bj < 2; ++bj) {
                    const size_t off = (size_t)(row0 + ai * 128 + m * 16) * DM + col0 + bj * 128;
                    f32x4 g0, g1; load8(gate + off, g0, g1);
                    f32x4 v0 = g0 * acc[ai][bj][m][0], v1 = g1 * acc[ai][bj][m][1];
                    if (second) { f32x4 t0, t1; load8(tmp + off, t0, t1); store8(Y + off, v0 + t0, v1 + t1); }
                    else store8(tmp + off, v0, v1);
                }
    }
};
struct EpiWo {
    static constexpr bool PERM = false;
    const bf16_t* H0; float* R1;
    __device__ __forceinline__ void operator()(const f32x4 (&acc)[2][2][4][2], const pg8::Unit& u, int wr, int wc, int fr, int fq) const {
        const int row0 = u.pm * 256 + wr * 64 + fr, col0 = u.pn * 256 + wc * 32 + 4 * fq;
#pragma unroll
        for (int ai = 0; ai < 2; ++ai)
#pragma unroll
            for (int m = 0; m < 4; ++m)
#pragma unroll
                for (int bj = 0; bj < 2; ++bj)
#pragma unroll
                    for (int n = 0; n < 2; ++n) {
                        const size_t off = (size_t)(row0 + ai * 128 + m * 16) * DM + col0 + bj * 128 + n * 16;
                        const u32x2 w = *(const u32x2*)(H0 + off);
                        const f32x4 h = (f32x4){bf2f(w.x & 0xffffu), bf2f(w.x >> 16), bf2f(w.y & 0xffffu), bf2f(w.y >> 16)};
                        *(f32x4*)(R1 + off) = h * ALPHA + acc[ai][bj][m][n];
                    }
    }
};
struct EpiMoe1 {
    static constexpr bool PERM = true;
    const float* bgu; bf16_t* ACT;
    __device__ __forceinline__ void operator()(const f32x4 (&acc)[2][2][4][2], const pg8::Unit& u, int wr, int wc, int fr, int fq) const {
        const int row0 = u.pm * 256 + wr * 64 + fr, col = u.pn * 128 + wc * 32 + 8 * fq;
        const float* bp = bgu + (size_t)u.ex * 2 * DE + col;
        const f32x4 bg0 = *(const f32x4*)bp, bg1 = *(const f32x4*)(bp + 4), bl0 = *(const f32x4*)(bp + DE), bl1 = *(const f32x4*)(bp + DE + 4);
#pragma unroll
        for (int ai = 0; ai < 2; ++ai)
#pragma unroll
            for (int m = 0; m < 4; ++m) {
                f32x4 o[2];
#pragma unroll
                for (int n = 0; n < 2; ++n) {
                    const f32x4 gv = acc[ai][0][m][n] + (n ? bg1 : bg0), lv = acc[ai][1][m][n] + (n ? bl1 : bl0);
#pragma unroll
                    for (int j = 0; j < 4; ++j) { const float gg = fminf(gv[j], SWIGLU_LIMIT), ll = fminf(fmaxf(lv[j], -SWIGLU_LIMIT), SWIGLU_LIMIT); o[n][j] = gg * sigmoid_f(SWIGLU_ALPHA * gg) * (ll + 1.f); }
                }
                store8(ACT + (size_t)(row0 + ai * 128 + m * 16) * DE + col, o[0], o[1]);
            }
    }
};
struct EpiMoe2 {
    static constexpr bool PERM = true;
    const float* bd; bf16_t* OUTS;
    __device__ __forceinline__ void operator()(const f32x4 (&acc)[2][2][4][2], const pg8::Unit& u, int wr, int wc, int fr, int fq) const {
        const int row0 = u.pm * 256 + wr * 64 + fr, col0 = u.pn * 256 + wc * 32 + 8 * fq;
#pragma unroll
        for (int bj = 0; bj < 2; ++bj) {
            const float* bp = bd + (size_t)u.ex * DM + col0 + bj * 128;
            const f32x4 b0 = *(const f32x4*)bp, b1 = *(const f32x4*)(bp + 4);
#pragma unroll
            for (int ai = 0; ai < 2; ++ai)
#pragma unroll
                for (int m = 0; m < 4; ++m)
                    store8(OUTS + (size_t)(row0 + ai * 128 + m * 16) * DM + col0 + bj * 128, acc[ai][bj][m][0] + b0, acc[ai][bj][m][1] + b1);
        }
    }
};
struct MoeOrder {
    pg8::StaticOrder so; const LAS int* ps; const LAS unsigned* tokl; int bt_per_e;
    __device__ __forceinline__ bool next(int i, pg8::Unit& u) const {
        if (!so.next(i, u)) return false;
        int e = 0; const int r0 = u.pm * 256;
#pragma unroll 1
        for (int k = 1; k < NE; ++k) e += (ps[k] <= r0) ? 1 : 0;
        e = __builtin_amdgcn_readfirstlane(e);
        u.ex = e; u.bn = e * bt_per_e + u.pn; return true;
    }
    __device__ __forceinline__ unsigned rowoff(int ui, int r) const { return tokl[ui * 256 + r]; }
};
__device__ __forceinline__ void ph_ln_in(const Frame& F) {
    const float* x = F.in[I_X]; const f32x4* g4 = (const f32x4*)F.in[I_LNIG]; const f32x4* b4 = (const f32x4*)F.in[I_LNIB];
    bf16_t* H0 = (bf16_t*)(F.ws + WS_H0);
    for (int m = F.gw; m < T; m += F.NGW) {
        const f32x4* xr = (const f32x4*)(x + (size_t)m * DM) + F.lane;
        f32x4 v[4]; float s = 0.f;
#pragma unroll
        for (int j = 0; j < 4; ++j) { v[j] = xr[64 * j]; s += (v[j][0] + v[j][1]) + (v[j][2] + v[j][3]); }
        const float mean = wave_sum(s) * (1.f / DM); float s2 = 0.f;
#pragma unroll
        for (int j = 0; j < 4; ++j) { v[j] = v[j] - mean; s2 += (v[j][0] * v[j][0] + v[j][1] * v[j][1]) + (v[j][2] * v[j][2] + v[j][3] * v[j][3]); }
        const float rstd = 1.f / sqrtf(wave_sum(s2) * (1.f / DM) + LN_EPS);
        u32x2* o = (u32x2*)(H0 + (size_t)m * DM) + F.lane;
#pragma unroll
        for (int j = 0; j < 4; ++j) { const f32x4 y = v[j] * rstd * g4[F.lane + 64 * j] + b4[F.lane + 64 * j]; u32x2 w; w.x = pk2(y[0], y[1]); w.y = pk2(y[2], y[3]); o[64 * j] = w; }
    }
}

struct CfgInProj {
    const bf16_t* H0; const float* W; const float* bgate; bf16_t *Q, *Kb, *V, *U, *GA, *GS;
    __device__ __forceinline__ const bf16_t* arow(int row) const { return H0 + (size_t)row * DM; }
    __device__ __forceinline__ const float* bptr(int) const { return W; }
    __device__ __forceinline__ int ldb() const { return INW; }
    __device__ __forceinline__ int K() const { return DM; }
    __device__ __forceinline__ void one(int row, int col, float v) const {
        if (col < 512) Q[(size_t)row * AW + col] = (bf16_t)f2bf(v * QSCALE);
        else if (col < 1024) Kb[(size_t)row * AW + col - 512] = (bf16_t)f2bf(v);
        else if (col < 1536) V[(size_t)row * AW + col - 1024] = (bf16_t)f2bf(v);
        else if (col < 2048) U[(size_t)row * SW + col - 1536] = (bf16_t)f2bf(v);
        else if (col < 3072) GA[(size_t)row * DM + col - 2048] = (bf16_t)f2bf(sigmoid_f(v + bgate[col - 2048]));
        else GS[(size_t)row * DM + col - 3072] = (bf16_t)f2bf(sigmoid_f(v + bgate[col - 2048]));
    }
    __device__ __forceinline__ void epi(int, int row, int col0, float v0, float v1) const { one(row, col0, v0); one(row, col0 + 16, v1); }
};
__device__ __forceinline__ void ph_inproj(const Frame& F) {
    CfgInProj c{(const bf16_t*)(F.ws + WS_H0), F.in[I_WIN], F.in[I_BGATE], (bf16_t*)(F.ws + WS_Q), (bf16_t*)(F.ws + WS_K), (bf16_t*)(F.ws + WS_V), (bf16_t*)(F.ws + WS_U),
                (bf16_t*)(F.ws + WS_GA), (bf16_t*)(F.ws + WS_GS)};
    constexpr int NTM = T / 128, NTN = INW / 128;
    for (int t = blockIdx.x; t < NTM * NTN; t += F.G) gemm_simple_tile<16>(F, c, t / NTN, t % NTN);
}

__device__ __forceinline__ void ph_attn_simple(const Frame& F) {
    const bf16_t* Q = (const bf16_t*)(F.ws + WS_Q); const bf16_t* Kb = (const bf16_t*)(F.ws + WS_K); const bf16_t* V = (const bf16_t*)(F.ws + WS_V);
    bf16_t* AO = (bf16_t*)(F.ws + WS_AO); const float* relb = F.in[I_RELB];
    const int lane = F.lane;
    for (int it = F.gw; it < T * NH; it += F.NGW) {
        const int m = it / NH, h = it % NH, b = m / SEQ, t = m % SEQ, n = t / CHUNK;
        const float q = bf2f(Q[(size_t)m * AW + h * HD + lane]);
        const int k0 = (n - LEFT) * CHUNK < 0 ? 0 : (n - LEFT) * CHUNK, k1 = n * CHUNK + CHUNK;
        float mx = -1e30f, l = 0.f, o = 0.f;
        for (int kp = k0; kp < k1; ++kp) {
            const size_t kr = (size_t)(b * SEQ + kp) * AW + h * HD + lane;
            float s = wave_sum(q * bf2f(Kb[kr]));
            int dist = t - kp; dist = dist < -(CHUNK - 1) ? -(CHUNK - 1) : (dist > RELMAX ? RELMAX : dist);
            s += relb[h * RELSIZE + dist + (CHUNK - 1)] * LOG2E;
            const float mn = fmaxf(mx, s), a = __builtin_amdgcn_exp2f(mx - mn), pp = __builtin_amdgcn_exp2f(s - mn);
            l = l * a + pp; o = o * a + pp * bf2f(V[kr]); mx = mn;
        }
        AO[(size_t)m * AW + h * HD + lane] = (bf16_t)f2bf(o / l);
    }
}

__device__ __forceinline__ void ph_ssm_simple(const Frame& F) {
    const bf16_t* U = (const bf16_t*)(F.ws + WS_U); bf16_t* GY = (bf16_t*)(F.ws + WS_GY);
    const int lane = F.lane;
    for (int it = F.gw; it < BATCH * NG; it += F.NGW) {
        const int b = it / NG, g = it % NG;
        const double lre = (double)F.in[I_LAMRE][g * NP + lane], lim = (double)F.in[I_LAMIM][g * NP + lane];
        const double dt = (double)expf(F.in[I_LOGDT][g]);
        const double er = (double)expf((float)(lre * dt));
        double sn, cs; sincos_d(lim * dt, sn, cs);
        const double lbr_d = er * cs, lbi_d = er * sn;
        const double nr = lbr_d - 1.0, ni = lbi_d, den = lre * lre + lim * lim;
        const double cr = (nr * lre + ni * lim) / den, ci = (ni * lre - nr * lim) / den;
        const float lbr = (float)lbr_d, lbi = (float)lbi_d;
        float Bre[GSZ], Bim[GSZ], Cre[GSZ], Cim[GSZ];
#pragma unroll
        for (int c = 0; c < GSZ; ++c) {
            const double br = (double)F.in[I_BRE][(g * NP + lane) * GSZ + c], bi = (double)F.in[I_BIM][(g * NP + lane) * GSZ + c];
            Bre[c] = (float)(cr * br - ci * bi); Bim[c] = (float)(cr * bi + ci * br);
            Cre[c] = F.in[I_CRE][(g * GSZ + c) * NP + lane]; Cim[c] = F.in[I_CIM][(g * GSZ + c) * NP + lane];
        }
        const float dsk = F.in[I_SSMD][g * GSZ + (lane & 15)];
        float xr = 0.f, xi = 0.f;
        for (int t = 0; t < SEQ; ++t) {
            const bf16_t* up = U + (size_t)(b * SEQ + t) * SW + g * GSZ;
            const u32x4 u0 = *(const u32x4*)up, u1 = *(const u32x4*)(up + 8);
            float u[GSZ];
#pragma unroll
            for (int i = 0; i < 4; ++i) { u[2 * i] = bf2f(u0[i] & 0xffffu); u[2 * i + 1] = bf2f(u0[i] >> 16); u[8 + 2 * i] = bf2f(u1[i] & 0xffffu); u[8 + 2 * i + 1] = bf2f(u1[i] >> 16); }
            float br = 0.f, bi = 0.f;
#pragma unroll
            for (int c = 0; c < GSZ; ++c) { br += Bre[c] * u[c]; bi += Bim[c] * u[c]; }
            const float nxr = lbr * xr - lbi * xi + br, nxi = lbr * xi + lbi * xr + bi; xr = nxr; xi = nxi;
            float yv = 0.f, uv = 0.f;
#pragma unroll
            for (int c = 0; c < GSZ; ++c) { const float part = wave_sum(Cre[c] * xr - Cim[c] * xi); if ((lane & 15) == c) { yv = part; uv = u[c]; } }
            yv += dsk * uv;
            if (lane < GSZ) GY[(size_t)(b * SEQ + t) * SW + g * GSZ + lane] = (bf16_t)f2bf(gelu_tanh(yv));
        }
    }
}


typedef float f32x16 __attribute__((ext_vector_type(16)));
__device__ __forceinline__ void ph_attn_fast_b(const Frame& F, int bid) {
    const bf16_t* Q = (const bf16_t*)(F.ws + WS_Q); const bf16_t* Kb = (const bf16_t*)(F.ws + WS_K); const bf16_t* VT = (const bf16_t*)(F.ws + WS_VT);
    bf16_t* AO = (bf16_t*)(F.ws + WS_AO);
    LAS float* bl = (LAS float*)F.lds;
    for (int i = F.tid; i < NH * RELSIZE; i += 512) bl[i] = F.in[I_RELB][i] * 1.4426950408889634f;
    __syncthreads();
    const int lane = F.lane, r32 = lane & 31, hi = lane >> 5;
    for (int unit = bid; unit < BATCH * NCH * 2; unit += F.G) {
        const int bn = unit >> 1, b = bn / NCH, n = bn % NCH;
        const int h = (unit & 1) * 4 + (F.wave >> 1), qb = F.wave & 1;
        const size_t qtok = (size_t)b * SEQ + n * CHUNK + qb * 32 + r32;
        bf16x8 qf[4];
#pragma unroll
        for (int ds = 0; ds < 4; ++ds) qf[ds] = *(const bf16x8*)(Q + qtok * AW + h * HD + ds * 16 + hi * 8);
        f32x16 o[2];
#pragma unroll
        for (int r = 0; r < 16; ++r) { o[0][r] = 0.f; o[1][r] = 0.f; }
        float mrun = -1.0e30f, lrun = 0.f;
        const LAS char* blh = (const LAS char*)(bl + h * RELSIZE);
        const int qpos = qb * 32 + r32;
        const bf16_t* vbase = VT + ((size_t)(b * NH + h) * HD + r32) * SEQ + hi * 8;
        for (int c = (n < LEFT ? n : LEFT); c >= 0; --c) {
            const int kc = n - c;
            const bf16_t* Kp = Kb + ((size_t)b * SEQ + kc * CHUNK + r32) * AW + h * HD + hi * 8;
            f32x16 s[2];
#pragma unroll
            for (int kb = 0; kb < 2; ++kb) {
#pragma unroll
                for (int r = 0; r < 16; ++r) s[kb][r] = 0.f;
#pragma unroll
                for (int ds = 0; ds < 4; ++ds) { const bf16x8 kf = *(const bf16x8*)(Kp + (size_t)kb * 32 * AW + ds * 16); s[kb] = __builtin_amdgcn_mfma_f32_32x32x16_bf16(kf, qf[ds], s[kb], 0, 0, 0); }
            }
            bf16x8 vf[2][2][2];
#pragma unroll
            for (int db = 0; db < 2; ++db)
#pragma unroll
                for (int kb = 0; kb < 2; ++kb)
#pragma unroll
                    for (int s2 = 0; s2 < 2; ++s2) vf[db][kb][s2] = *(const bf16x8*)(vbase + (size_t)db * 32 * SEQ + kc * CHUNK + kb * 32 + s2 * 16);
            if (c >= 5) { const float bc = *(const LAS float*)(blh + 319 * 4);
#pragma unroll
                for (int r = 0; r < 16; ++r) { s[0][r] += bc; s[1][r] += bc; } }
            else { const int base4 = (qpos + 64 * c + 63 - 4 * hi) * 4;
#pragma unroll
                for (int kb = 0; kb < 2; ++kb)
#pragma unroll
                    for (int r = 0; r < 16; ++r) { int off = base4 - 4 * (kb * 32 + (r & 3) + 8 * (r >> 2)); off = off < 319 * 4 ? off : 319 * 4; s[kb][r] += *(const LAS float*)(blh + off); } }
            float tm = fmaxf(s[0][0], s[1][0]);
#pragma unroll
            for (int r = 1; r < 16; ++r) tm = fmaxf(tm, fmaxf(s[0][r], s[1][r]));
            tm = fmaxf(tm, __shfl_xor(tm, 32));
            if (__any(tm > mrun + 8.f)) { const float mn = fmaxf(mrun, tm), f = __builtin_amdgcn_exp2f(mrun - mn); lrun *= f; mrun = mn;
#pragma unroll
                for (int r = 0; r < 16; ++r) { o[0][r] *= f; o[1][r] *= f; } }
            float ls = 0.f;
#pragma unroll
            for (int kb = 0; kb < 2; ++kb)
#pragma unroll
                for (int r = 0; r < 16; ++r) { const float p = __builtin_amdgcn_exp2f(s[kb][r] - mrun); ls += p; s[kb][r] = p; }
            lrun += ls;
#pragma unroll
            for (int kb = 0; kb < 2; ++kb)
#pragma unroll
                for (int s2 = 0; s2 < 2; ++s2) {
                    u32x4 pw; pw.x = pg8::cvt_pk_bf16(s[kb][8 * s2 + 0], s[kb][8 * s2 + 1]); pw.y = pg8::cvt_pk_bf16(s[kb][8 * s2 + 2], s[kb][8 * s2 + 3]);
                    pw.z = pg8::cvt_pk_bf16(s[kb][8 * s2 + 4], s[kb][8 * s2 + 5]); pw.w = pg8::cvt_pk_bf16(s[kb][8 * s2 + 6], s[kb][8 * s2 + 7]);
                    const bf16x8 pf = __builtin_bit_cast(bf16x8, pw);
                    o[0] = __builtin_amdgcn_mfma_f32_32x32x16_bf16(vf[0][kb][s2], pf, o[0], 0, 0, 0);
                    o[1] = __builtin_amdgcn_mfma_f32_32x32x16_bf16(vf[1][kb][s2], pf, o[1], 0, 0, 0);
                }
        }
        lrun += __shfl_xor(lrun, 32);
        const float inv = 1.f / lrun;
        bf16_t* op = AO + qtok * AW + h * HD + 4 * hi;
#pragma unroll
        for (int db = 0; db < 2; ++db)
#pragma unroll
            for (int g4 = 0; g4 < 4; ++g4) { u32x2 w; w.x = pg8::cvt_pk_bf16(o[db][4 * g4] * inv, o[db][4 * g4 + 1] * inv); w.y = pg8::cvt_pk_bf16(o[db][4 * g4 + 2] * inv, o[db][4 * g4 + 3] * inv);
                *(u32x2*)(op + db * 32 + 8 * g4) = w; }
    }
    __syncthreads();
}

typedef float f32x2 __attribute__((ext_vector_type(2)));
__device__ __forceinline__ f32x2 cmul(f32x2 a, f32x2 b) { return (f32x2){a.x * b.x - a.y * b.y, a.x * b.y + a.y * b.x}; }
__device__ __forceinline__ void ssm_coef(const Frame& F, int g, int p, double& lre, double& lim, double& dt, double& cr, double& ci) {
    lre = (double)F.in[I_LAMRE][g * NP + p]; lim = (double)F.in[I_LAMIM][g * NP + p]; dt = (double)expf(F.in[I_LOGDT][g]);
    const double y = lre * dt;
    double em = 1.0, term = 1.0;
#pragma unroll
    for (int k = 1; k <= 14; ++k) { term = term * y / (double)k; em += term; }
    double sn, cs; sincos_d(lim * dt, sn, cs);
    const double nr = em * cs - 1.0, ni = em * sn, den = lre * lre + lim * lim;
    cr = (nr * lre + ni * lim) / den; ci = (ni * lre - nr * lim) / den;
}
__device__ __forceinline__ f32x2 lam_pow(double lre, double lim, double dt, double k) {
    const float mag = expf((float)(lre * dt * k)); double sn, cs; sincos_d(lim * dt * k, sn, cs);
    return (f32x2){mag * (float)cs, mag * (float)sn};
}
__device__ __forceinline__ void ph_ssm_tables(const Frame& F) {
    f32x2* LP = (f32x2*)(F.ws + WS_LP); f32x2* LLP = (f32x2*)(F.ws + WS_LLP);
    bf16_t* WsT = (bf16_t*)(F.ws + WS_WST); bf16_t* KdT = (bf16_t*)(F.ws + WS_KDT); bf16_t* Cint = (bf16_t*)(F.ws + WS_CINT);
    const int gt = blockIdx.x * 512 + F.tid, NT = F.G * 512;
    for (int it = gt; it < NG * (65 + 128) * NP; it += NT) {
        const int p = it % NP, q = (it / NP) % (65 + 128), g = it / (NP * (65 + 128));
        const double lre = (double)F.in[I_LAMRE][g * NP + p], lim = (double)F.in[I_LAMIM][g * NP + p], dt = (double)expf(F.in[I_LOGDT][g]);
        if (q < 65) LP[(g * 65 + q) * NP + p] = lam_pow(lre, lim, dt, (double)q);
        else LLP[(g * 128 + (q - 65)) * NP + p] = lam_pow(lre, lim, dt, 64.0 * (double)(q - 65));
    }
    for (int it = gt; it < NG * GSZ * NP; it += NT) {
        const int p = it % NP, c = (it / NP) % GSZ, g = it / (NP * GSZ);
        ((unsigned*)Cint)[(g * GSZ + c) * NP + p] = pk2(F.in[I_CRE][(g * GSZ + c) * NP + p], -F.in[I_CIM][(g * GSZ + c) * NP + p]);
    }
    for (int it = gt; it < NG * NP * 64; it += NT) {
        const int j = it & 63, p = (it >> 6) % NP, g = it / (64 * NP);
        double lre, lim, dt, cr, ci; ssm_coef(F, g, p, lre, lim, dt, cr, ci);
        const f32x2 pw = lam_pow(lre, lim, dt, (double)(63 - j));
        const float crf = (float)cr, cif = (float)ci;
        bf16_t* o0 = WsT + ((size_t)(g * 128 + 2 * p) * 1024 + j * 16); bf16_t* o1 = o0 + 1024;
        const f32x4* br4 = (const f32x4*)(F.in[I_BRE] + (g * NP + p) * GSZ); const f32x4* bi4 = (const f32x4*)(F.in[I_BIM] + (g * NP + p) * GSZ);
#pragma unroll 1
        for (int c4 = 0; c4 < 4; ++c4) {
            const f32x4 br = br4[c4], bi = bi4[c4];
            float re[4], im[4];
#pragma unroll
            for (int k = 0; k < 4; ++k) { const f32x2 v = cmul(pw, (f32x2){crf * br[k] - cif * bi[k], crf * bi[k] + cif * br[k]}); re[k] = v.x; im[k] = v.y; }
            *(u32x2*)(o0 + c4 * 4) = (u32x2){pk2(re[0], re[1]), pk2(re[2], re[3])};
            *(u32x2*)(o1 + c4 * 4) = (u32x2){pk2(im[0], im[1]), pk2(im[2], im[3])};
        }
    }
    LAS f32x2* Ew = (LAS f32x2*)(F.lds + F.wave * 16384);
    for (int it = F.gw; it < NG * 64; it += F.NGW) {
        const int d = it & 63, g = it >> 6, p = F.lane;
        double lre, lim, dt, cr, ci; ssm_coef(F, g, p, lre, lim, dt, cr, ci);
        const f32x2 pw = lam_pow(lre, lim, dt, (double)d);
        { const float crf = (float)cr, cif = (float)ci;
#pragma unroll 4
          for (int c = 0; c < GSZ; ++c) {
            const float br = F.in[I_BRE][(g * NP + p) * GSZ + c], bi = F.in[I_BIM][(g * NP + p) * GSZ + c];
            Ew[p * GSZ + c] = cmul(pw, (f32x2){crf * br - cif * bi, crf * bi + cif * br});
          } }
        asm volatile("s_waitcnt lgkmcnt(0)" ::: "memory");
        const int c = F.lane >> 2, ci0 = (F.lane & 3) * 4;
        const float* cre = F.in[I_CRE] + (g * GSZ + c) * NP; const float* cim = F.in[I_CIM] + (g * GSZ + c) * NP;
        float acc[4] = {0.f, 0.f, 0.f, 0.f};
        for (int pp = 0; pp < NP; ++pp) {
            const float a = cre[pp], bq = cim[pp];
#pragma unroll
            for (int k = 0; k < 4; ++k) { const f32x2 e = Ew[pp * GSZ + ci0 + k]; acc[k] += a * e.x - bq * e.y; }
        }
        if (d == 0) {
#pragma unroll
            for (int k = 0; k < 4; ++k) if (ci0 + k == c) acc[k] += F.in[I_SSMD][g * GSZ + c];
        }
        *(u32x2*)(KdT + ((size_t)((g * 64 + d) * GSZ + c)) * GSZ + ci0) = (u32x2){pk2(acc[0], acc[1]), pk2(acc[2], acc[3])};
        asm volatile("s_waitcnt lgkmcnt(0)" ::: "memory");
    }
}
__device__ __forceinline__ void ph_ssm_xe(const Frame& F, int unit) {
    const int b = unit / (NG * 4), g = (unit >> 2) % NG, qtr = unit & 3, n0 = qtr * 32;
    const bf16_t* U = (const bf16_t*)(F.ws + WS_U); const bf16_t* WsT = (const bf16_t*)(F.ws + WS_WST) + (size_t)g * 128 * 1024;
    const int lane = F.lane, w = F.wave, fr = lane & 15, fq = lane >> 4;
    f32x4 acc[2] = {(f32x4){0.f, 0.f, 0.f, 0.f}, (f32x4){0.f, 0.f, 0.f, 0.f}};
    const bf16_t* bp = WsT + (size_t)(w * 16 + fr) * 1024 + fq * 8;
    const bf16_t* ap = U + ((size_t)b * SEQ + (size_t)(n0 + fr) * CHUNK + (fq >> 1)) * SW + g * GSZ + (fq & 1) * 8;
#pragma unroll 4
    for (int ks = 0; ks < 32; ++ks) {
        const bf16x8 bf = *(const bf16x8*)(bp + ks * 32);
        const bf16x8 a0 = *(const bf16x8*)(ap + (size_t)(2 * ks) * SW), a1 = *(const bf16x8*)(ap + (size_t)(16 * CHUNK + 2 * ks) * SW);
        acc[0] = __builtin_amdgcn_mfma_f32_16x16x32_bf16(a0, bf, acc[0], 0, 0, 0);
        acc[1] = __builtin_amdgcn_mfma_f32_16x16x32_bf16(a1, bf, acc[1], 0, 0, 0);
    }
    LAS float* XEl = (LAS float*)(F.lds + 16384);
#pragma unroll
    for (int rb = 0; rb < 2; ++rb)
#pragma unroll
        for (int r = 0; r < 4; ++r) XEl[(rb * 16 + fq * 4 + r) * 128 + w * 16 + fr] = acc[rb][r];
    __syncthreads();
    if (F.tid < NP) {
        const int p = F.tid;
        const f32x2 lamL = ((const f32x2*)(F.ws + WS_LP))[(g * 65 + 64) * NP + p];
        f32x2* XSL = (f32x2*)(F.ws + WS_XSL); f32x2* UEND = (f32x2*)(F.ws + WS_UEND);
        f32x2 s = (f32x2){0.f, 0.f};
        for (int i = 0; i < 32; ++i) {
            XSL[((size_t)(b * NCH + n0 + i) * NG + g) * NP + p] = s;
            const f32x2 xe = (f32x2){XEl[i * 128 + 2 * p], XEl[i * 128 + 2 * p + 1]};
            s = cmul(lamL, s) + xe;
        }
        UEND[((size_t)(b * 4 + qtr) * NG + g) * NP + p] = s;
    }
    __syncthreads();
}
__device__ __forceinline__ void ph_ssm_out(const Frame& F) {
    const bf16_t* U = (const bf16_t*)(F.ws + WS_U); bf16_t* GY = (bf16_t*)(F.ws + WS_GY);
    const f32x2* LP = (const f32x2*)(F.ws + WS_LP); const f32x2* LLP = (const f32x2*)(F.ws + WS_LLP);
    const bf16_t* KdT = (const bf16_t*)(F.ws + WS_KDT); const bf16_t* Cint = (const bf16_t*)(F.ws + WS_CINT);
    const f32x2* XSL = (const f32x2*)(F.ws + WS_XSL); const f32x2* UEND = (const f32x2*)(F.ws + WS_UEND);
    constexpr int USTR = 1040;
    LAS unsigned char* UL = F.lds; LAS f32x2* xsl = (LAS f32x2*)(F.lds + 64 * USTR) + F.wave * NP;
    const int lane = F.lane, w = F.wave, fr = lane & 15, fq = lane >> 4;
    for (int unit = blockIdx.x; unit < BATCH * NCH; unit += F.G) {
        const int b = unit / NCH, n = unit % NCH, qtr = n >> 5, ni = n & 31;
        __syncthreads();
        for (int idx = F.tid; idx < 64 * 64; idx += 512) { const int row = idx >> 6, c16 = idx & 63;
            *(LAS u32x4*)(UL + row * USTR + c16 * 16) = *(const u32x4*)(U + ((size_t)b * SEQ + n * CHUNK + row) * SW + c16 * 8); }
        __syncthreads();
#pragma unroll 1
        for (int gi = 0; gi < 4; ++gi) {
            const int g = gi * 8 + w;
            {
                f32x2 xs = XSL[((size_t)(b * NCH + n) * NG + g) * NP + lane];
                if (qtr > 0) { f32x2 carry = (f32x2){0.f, 0.f};
                    for (int q = 0; q < qtr; ++q) carry += cmul(LLP[(g * 128 + 32 * (qtr - 1 - q)) * NP + lane], UEND[((size_t)(b * 4 + q) * NG + g) * NP + lane]);
                    xs += cmul(LLP[(g * 128 + ni) * NP + lane], carry); }
                xsl[lane] = xs;
            }
            f32x4 acc[4];
#pragma unroll
            for (int rb = 0; rb < 4; ++rb) acc[rb] = (f32x4){0.f, 0.f, 0.f, 0.f};
#pragma unroll
            for (int ks = 0; ks < 4; ++ks) {
                const bf16x8 cf = *(const bf16x8*)(Cint + (size_t)(g * GSZ + fr) * 128 + ks * 32 + fq * 8);
                const LAS f32x4* xp = (const LAS f32x4*)(xsl + ks * 16 + 4 * fq);
                const f32x4 x01 = xp[0], x23 = xp[1];
#pragma unroll
                for (int rb = 0; rb < 4; ++rb) {
                    const f32x4* lp = (const f32x4*)(LP + (size_t)(g * 65 + rb * 16 + fr + 1) * NP + ks * 16 + 4 * fq);
                    const f32x4 l01 = lp[0], l23 = lp[1];
                    u32x4 zw;
                    zw.x = pg8::cvt_pk_bf16(l01[0] * x01[0] - l01[1] * x01[1], l01[0] * x01[1] + l01[1] * x01[0]);
                    zw.y = pg8::cvt_pk_bf16(l01[2] * x01[2] - l01[3] * x01[3], l01[2] * x01[3] + l01[3] * x01[2]);
                    zw.z = pg8::cvt_pk_bf16(l23[0] * x23[0] - l23[1] * x23[1], l23[0] * x23[1] + l23[1] * x23[0]);
                    zw.w = pg8::cvt_pk_bf16(l23[2] * x23[2] - l23[3] * x23[3], l23[2] * x23[3] + l23[3] * x23[2]);
                    acc[rb] = __builtin_amdgcn_mfma_f32_16x16x32_bf16(cf, __builtin_bit_cast(bf16x8, zw), acc[rb], 0, 0, 0);
                }
            }
#define SSM_LDKF(buf, kq_) do { _Pragma("unroll") for (int k8 = 0; k8 < 8; ++k8) kfb[buf][k8] = *(const bf16x8*)(KdT + ((size_t)((g * 64 + 2 * ((kq_) * 8 + k8) + (fq >> 1)) * GSZ + fr)) * GSZ + (fq & 1) * 8); } while (0)
            bf16x8 kfb[2][8];
            SSM_LDKF(0, 0);
            const LAS unsigned char* ub = UL + g * 32 + (fq & 1) * 16;
#pragma unroll
            for (int kq = 0; kq < 4; ++kq) {
                if (kq < 3) SSM_LDKF((kq + 1) & 1, kq + 1);
#pragma unroll
                for (int k8 = 0; k8 < 8; ++k8) {
                    const int ks = kq * 8 + k8;
                    const bf16x8 kf = kfb[kq & 1][k8];
#pragma unroll
                    for (int rb = kq; rb < 4; ++rb) {
                        const int src = rb * 16 + fr - 2 * ks - (fq >> 1);
                        bf16x8 af = *(const LAS bf16x8*)(ub + (src < 0 ? 0 : src) * USTR);
                        if (rb == kq) { if (src < 0) af = (bf16x8){0, 0, 0, 0, 0, 0, 0, 0}; }
                        acc[rb] = __builtin_amdgcn_mfma_f32_16x16x32_bf16(kf, af, acc[rb], 0, 0, 0);
                    }
                }
            }
#undef SSM_LDKF
#pragma unroll
            for (int rb = 0; rb < 4; ++rb) {
                u32x2 o; o.x = pg8::cvt_pk_bf16(gelu_tanh(acc[rb][0]), gelu_tanh(acc[rb][1])); o.y = pg8::cvt_pk_bf16(gelu_tanh(acc[rb][2]), gelu_tanh(acc[rb][3]));
                *(u32x2*)(GY + ((size_t)b * SEQ + n * CHUNK + rb * 16 + fr) * SW + g * GSZ + 4 * fq) = o;
            }
        }
    }
    __syncthreads();
}
struct CfgGlu {
    const bf16_t* GY; const float* W; bf16_t* SGo;
    __device__ __forceinline__ const bf16_t* arow(int row) const { return GY + (size_t)row * SW; }
    __device__ __forceinline__ const float* bptr(int) const { return W; }
    __device__ __forceinline__ int ldb() const { return 2 * SW; }
    __device__ __forceinline__ int K() const { return SW; }
    __device__ __forceinline__ void epi(int, int row, int col0, float v0, float v1) const { SGo[(size_t)row * SW + col0] = (bf16_t)f2bf(v0 * sigmoid_f(v1)); }
};
__device__ __forceinline__ void ph_glu(const Frame& F) {
    CfgGlu c{(const bf16_t*)(F.ws + WS_GY), F.in[I_WGLU], (bf16_t*)(F.ws + WS_SG)};
    constexpr int NTM = T / 128, NTN = SW / 64;
    for (int t = blockIdx.x; t < NTM * NTN; t += F.G) gemm_simple_tile<SW>(F, c, t / NTN, t % NTN);
}

struct CfgUp {
    const bf16_t* A; const float* W; const bf16_t* gate; float* tmp; bf16_t* Y; bool second;
    __device__ __forceinline__ const bf16_t* arow(int row) const { return A + (size_t)row * 512; }
    __device__ __forceinline__ const float* bptr(int) const { return W; }
    __device__ __forceinline__ int ldb() const { return DM; }
    __device__ __forceinline__ int K() const { return 512; }
    __device__ __forceinline__ void one(int row, int col, float v) const {
        const size_t i = (size_t)row * DM + col; const float gv = bf2f(gate[i]) * v;
        if (!second) tmp[i] = gv; else Y[i] = (bf16_t)f2bf(tmp[i] + gv);
    }
    __device__ __forceinline__ void epi(int, int row, int col0, float v0, float v1) const { one(row, col0, v0); one(row, col0 + 16, v1); }
};
__device__ __forceinline__ void ph_up(const Frame& F, bool second) {
    CfgUp c{(const bf16_t*)(F.ws + (second ? WS_SG : WS_AO)), F.in[second ? I_WUS : I_WUA], (const bf16_t*)(F.ws + (second ? WS_GS : WS_GA)), (float*)(F.ws + WS_R1), (bf16_t*)(F.ws + WS_Y), second};
    constexpr int NTM = T / 128, NTN = DM / 128;
    for (int t = blockIdx.x; t < NTM * NTN; t += F.G) gemm_simple_tile<16>(F, c, t / NTN, t % NTN);
}

struct CfgWo {
    const bf16_t* Y; const float* W; const bf16_t* H0; float* R1;
    __device__ __forceinline__ const bf16_t* arow(int row) const { return Y + (size_t)row * DM; }
    __device__ __forceinline__ const float* bptr(int) const { return W; }
    __device__ __forceinline__ int ldb() const { return DM; }
    __device__ __forceinline__ int K() const { return DM; }
    __device__ __forceinline__ void one(int row, int col, float v) const { const size_t i = (size_t)row * DM + col; R1[i] = ALPHA * bf2f(H0[i]) + v; }
    __device__ __forceinline__ void epi(int, int row, int col0, float v0, float v1) const { one(row, col0, v0); one(row, col0 + 16, v1); }
};
__device__ __forceinline__ void ph_wo(const Frame& F) {
    CfgWo c{(const bf16_t*)(F.ws + WS_Y), F.in[I_WO], (const bf16_t*)(F.ws + WS_H0), (float*)(F.ws + WS_R1)};
    constexpr int NTM = T / 128, NTN = DM / 128;
    for (int t = blockIdx.x; t < NTM * NTN; t += F.G) gemm_simple_tile<16>(F, c, t / NTN, t % NTN);
}

__device__ __forceinline__ void ph_ln1_router(const Frame& F, bool commit) {
    const float* R1 = (const float*)(F.ws + WS_R1); bf16_t* H1 = (bf16_t*)(F.ws + WS_H1);
    const f32x4* g4 = (const f32x4*)F.in[I_LN1G]; const f32x4* b4 = (const f32x4*)F.in[I_LN1B];
    const float* rw = F.in[I_RW]; const float* rb = F.in[I_RB];
    int* TOPI = (int*)(F.ws + WS_TOPI); float* TOPG = (float*)(F.ws + WS_TOPG); int* TOK = (int*)(F.ws + WS_TOK);
    const int lane = F.lane;
    for (int i = blockIdx.x * 512 + F.tid; i < NROWS; i += F.G * 512) TOK[i] = T;
    if (blockIdx.x == 0) { for (int i = F.tid; i < DM / 2; i += 512) ((unsigned*)(H1 + (size_t)T * DM))[i] = 0u; }
    for (int m = F.gw; m < T; m += F.NGW) {
        const f32x4* xr = (const f32x4*)(R1 + (size_t)m * DM) + lane;
        f32x4 v[4]; float s = 0.f;
#pragma unroll
        for (int j = 0; j < 4; ++j) { v[j] = xr[64 * j]; s += (v[j][0] + v[j][1]) + (v[j][2] + v[j][3]); }
        const float mean = wave_sum(s) * (1.f / DM); float s2 = 0.f;
#pragma unroll
        for (int j = 0; j < 4; ++j) { v[j] = v[j] - mean; s2 += (v[j][0] * v[j][0] + v[j][1] * v[j][1]) + (v[j][2] * v[j][2] + v[j][3] * v[j][3]); }
        const float rstd = 1.f / sqrtf(wave_sum(s2) * (1.f / DM) + LN_EPS);
        u32x2* o = (u32x2*)(H1 + (size_t)m * DM) + lane;
        float lg[NE];
#pragma unroll
        for (int e = 0; e < NE; ++e) lg[e] = 0.f;
#pragma unroll
        for (int j = 0; j < 4; ++j) {
            const f32x4 y = v[j] * rstd * g4[lane + 64 * j] + b4[lane + 64 * j];
            u32x2 w; w.x = pk2(y[0], y[1]); w.y = pk2(y[2], y[3]); o[64 * j] = w;
            const float* wj = rw + (size_t)(256 * j + 4 * lane) * NE;
            asm volatile("" : "+v"(wj));
#pragma unroll
            for (int i = 0; i < 4; ++i) {
                const f32x4* wr4 = (const f32x4*)(wj + i * NE);
#pragma unroll
                for (int q = 0; q < 8; ++q) { const f32x4 ww = wr4[q]; lg[4 * q] += y[i] * ww[0]; lg[4 * q + 1] += y[i] * ww[1]; lg[4 * q + 2] += y[i] * ww[2]; lg[4 * q + 3] += y[i] * ww[3]; }
                asm volatile("" ::: "memory");
            }
        }
        float r16[16], r8[8], r4[4], r2[2], r1;
        { const bool hb = (lane & 32) != 0;
#pragma unroll
          for (int i = 0; i < 16; ++i) { const float keep = hb ? lg[i + 16] : lg[i], send = hb ? lg[i] : lg[i + 16]; r16[i] = keep + __shfl_xor(send, 32); } }
        { const bool hb = (lane & 16) != 0;
#pragma unroll
          for (int i = 0; i < 8; ++i) { const float keep = hb ? r16[i + 8] : r16[i], send = hb ? r16[i] : r16[i + 8]; r8[i] = keep + __shfl_xor(send, 16); } }
        { const bool hb = (lane & 8) != 0;
#pragma unroll
          for (int i = 0; i < 4; ++i) { const float keep = hb ? r8[i + 4] : r8[i], send = hb ? r8[i] : r8[i + 4]; r4[i] = keep + __shfl_xor(send, 8); } }
        { const bool hb = (lane & 4) != 0;
#pragma unroll
          for (int i = 0; i < 2; ++i) { const float keep = hb ? r4[i + 2] : r4[i], send = hb ? r4[i] : r4[i + 2]; r2[i] = keep + __shfl_xor(send, 4); } }
        { const bool hb = (lane & 2) != 0; const float keep = hb ? r2[1] : r2[0], send = hb ? r2[0] : r2[1]; r1 = keep + __shfl_xor(send, 2); }
        r1 += __shfl_xor(r1, 1);
        const int mye = (lane >> 1) & 31;
        float myv = r1 + rb[mye];
        float tv[TOPK]; int ti[TOPK];
#pragma unroll
        for (int k = 0; k < TOPK; ++k) {
            float bv = myv; int bi = mye;
#pragma unroll
            for (int o = 1; o < 64; o <<= 1) { const float ov = __shfl_xor(bv, o); const int oi = __shfl_xor(bi, o); if (ov > bv || (ov == bv && oi < bi)) { bv = ov; bi = oi; } }
            tv[k] = bv; ti[k] = bi; if (mye == bi) myv = -3.0e38f;
        }
        const float e1 = __expf(tv[1] - tv[0]), e2 = __expf(tv[2] - tv[0]), e3 = __expf(tv[3] - tv[0]);
        const float inv = 1.f / (1.f + e1 + e2 + e3);
        if (lane == 0 && commit) {
            TOPI[m * 4 + 0] = ti[0]; TOPI[m * 4 + 1] = ti[1]; TOPI[m * 4 + 2] = ti[2]; TOPI[m * 4 + 3] = ti[3];
            TOPG[m * 4 + 0] = inv; TOPG[m * 4 + 1] = e1 * inv; TOPG[m * 4 + 2] = e2 * inv; TOPG[m * 4 + 3] = e3 * inv;
#pragma unroll
            for (int k = 0; k < TOPK; ++k) atomicAdd(F.ctl + CW_COUNTS + ti[k], 1u);
        }
    }
}


__device__ __forceinline__ void ph_router_tables(const Frame& F) {
    const float* g = F.in[I_LN1G]; const float* bb = F.in[I_LN1B]; const float* rw = F.in[I_RW]; const float* rb = F.in[I_RB];
    float* GWp = (float*)(F.ws + WS_GWP); float* RC = (float*)(F.ws + WS_RC);
    for (int idx = blockIdx.x * 512 + F.tid; idx < 128 * 2 * 32 * 4; idx += F.G * 512) {
        const int j = idx & 3, e = (idx >> 2) & 31, kpar = (idx >> 7) & 1, i = idx >> 8, k = 8 * i + 4 * kpar + j;
        GWp[idx] = g[k] * rw[k * NE + e];
    }
    if (blockIdx.x == (F.G > 1 ? 1 : 0) && F.tid < NE) {
        float cs = 0.f, bw = 0.f;
        for (int k = 0; k < DM; ++k) { const float w = rw[k * NE + F.tid]; cs += g[k] * w; bw += bb[k] * w; }
        RC[F.tid] = cs; RC[NE + F.tid] = bw + rb[F.tid];
    }
}
typedef float f32x16r __attribute__((ext_vector_type(16)));
__device__ __forceinline__ void ph_router(const Frame& F) {
    const float* R1 = (const float*)(F.ws + WS_R1); bf16_t* H1 = (bf16_t*)(F.ws + WS_H1);
    const f32x4* g4 = (const f32x4*)F.in[I_LN1G]; const f32x4* b4 = (const f32x4*)F.in[I_LN1B];
    const float* GWp = (const float*)(F.ws + WS_GWP); const float* RC = (const float*)(F.ws + WS_RC);
    int* TOPI = (int*)(F.ws + WS_TOPI); float* TOPG = (float*)(F.ws + WS_TOPG); int* TOK = (int*)(F.ws + WS_TOK);
    int* HIST = (int*)(F.ws + WS_HIST); int* LRANK = (int*)(F.ws + WS_LRANK);
    LAS float* part = (LAS float*)F.lds;
    LAS float* stats = (LAS float*)(F.lds + 32768);
    const int lane = F.lane, w = F.wave;
    for (int i = blockIdx.x * 512 + F.tid; i < NROWS; i += F.G * 512) TOK[i] = T;
    if (blockIdx.x == 0) { for (int i = F.tid; i < DM / 2; i += 512) ((unsigned*)(H1 + (size_t)T * DM))[i] = 0u; }
    for (int tile = blockIdx.x; tile < T / 64; tile += F.G) {
        __syncthreads();
#pragma unroll 1
        for (int rr = 0; rr < 8; ++rr) {
            const int m = tile * 64 + rr * 8 + w;
            const f32x4* xr = (const f32x4*)(R1 + (size_t)m * DM) + lane;
            f32x4 v[4]; float s = 0.f;
#pragma unroll
            for (int j = 0; j < 4; ++j) { v[j] = xr[64 * j]; s += (v[j][0] + v[j][1]) + (v[j][2] + v[j][3]); }
            const float mean = wave_sum(s) * (1.f / DM); float s2 = 0.f;
#pragma unroll
            for (int j = 0; j < 4; ++j) { v[j] = v[j] - mean; s2 += (v[j][0] * v[j][0] + v[j][1] * v[j][1]) + (v[j][2] * v[j][2] + v[j][3] * v[j][3]); }
            const float rstd = 1.f / sqrtf(wave_sum(s2) * (1.f / DM) + LN_EPS);
            u32x2* o = (u32x2*)(H1 + (size_t)m * DM) + lane;
#pragma unroll
            for (int j = 0; j < 4; ++j) { const f32x4 y = v[j] * rstd * g4[lane + 64 * j] + b4[lane + 64 * j]; u32x2 ww; ww.x = pk2(y[0], y[1]); ww.y = pk2(y[2], y[3]); o[64 * j] = ww; }
            if (lane == 0) { stats[(rr * 8 + w) * 2] = mean; stats[(rr * 8 + w) * 2 + 1] = rstd; }
        }
        {
            const int mblk = w & 1, kq = w >> 1, r32 = lane & 31, kpar = lane >> 5;
            const float* ap = GWp + (size_t)((kq * 32) * 2 + kpar) * 128 + r32 * 4;
            const float* bp = R1 + (size_t)(tile * 64 + mblk * 32 + r32) * DM + kq * 256 + 4 * kpar;
            f32x16r acc;
#pragma unroll
            for (int r = 0; r < 16; ++r) acc[r] = 0.f;
#pragma unroll 4
            for (int i = 0; i < 32; ++i) {
                const f32x4 a4 = *(const f32x4*)(ap + i * 256), b4v = *(const f32x4*)(bp + i * 8);
#pragma unroll
                for (int j = 0; j < 4; ++j) acc = __builtin_amdgcn_mfma_f32_32x32x2f32(a4[j], b4v[j], acc, 0, 0, 0);
            }
#pragma unroll
            for (int r = 0; r < 16; ++r) part[((mblk * 4 + kq) * 32 + (r & 3) + 8 * (r >> 2) + 4 * kpar) * 32 + r32] = acc[r];
        }
        __syncthreads();
        if (w == 0) {
            const int mblk = lane >> 5, tl = lane & 31, m = tile * 64 + lane;
            const float mean = stats[lane * 2], rstd = stats[lane * 2 + 1];
            float lg[NE];
#pragma unroll
            for (int e = 0; e < NE; ++e) {
                const float raw = (part[((mblk * 4 + 0) * 32 + e) * 32 + tl] + part[((mblk * 4 + 1) * 32 + e) * 32 + tl]) + (part[((mblk * 4 + 2) * 32 + e) * 32 + tl] + part[((mblk * 4 + 3) * 32 + e) * 32 + tl]);
                lg[e] = rstd * (raw - mean * RC[e]) + RC[NE + e];
            }
            float tv[TOPK]; int ti[TOPK];
#pragma unroll
            for (int k = 0; k < TOPK; ++k) {
                float bv = -3.0e38f; int bi = 0;
#pragma unroll
                for (int e = 0; e < NE; ++e) if (lg[e] > bv) { bv = lg[e]; bi = e; }
                tv[k] = bv; ti[k] = bi;
#pragma unroll
                for (int e = 0; e < NE; ++e) if (e == bi) lg[e] = -3.0e38f;
            }
            const float e1 = __expf(tv[1] - tv[0]), e2 = __expf(tv[2] - tv[0]), e3 = __expf(tv[3] - tv[0]);
            const float inv = 1.f / (1.f + e1 + e2 + e3);
            int lr[TOPK] = {0, 0, 0, 0}; int mycnt = 0;
            const unsigned long long lt = (lane == 0) ? 0ull : (~0ull >> (64 - lane));
#pragma unroll 1
            for (int e = 0; e < NE; ++e) {
                int c = 0;
#pragma unroll
                for (int k = 0; k < TOPK; ++k) { const unsigned long long mk = __ballot(ti[k] == e); if (ti[k] == e) lr[k] = c + __popcll(mk & lt); c += __popcll(mk); }
                if (lane == e) mycnt = c;
            }
            *(int4*)(TOPI + m * 4) = make_int4(ti[0], ti[1], ti[2], ti[3]);
            *(float4*)(TOPG + m * 4) = make_float4(inv, e1 * inv, e2 * inv, e3 * inv);
            *(int4*)(LRANK + m * 4) = make_int4(lr[0], lr[1], lr[2], lr[3]);
            if (lane < NE) HIST[tile * NE + lane] = mycnt;
        }
    }
    __syncthreads();
}
__device__ __forceinline__ void ph_dest2(const Frame& F) {
    const int* HIST = (const int*)(F.ws + WS_HIST); const int* LRANK = (const int*)(F.ws + WS_LRANK); const int* TOPI = (const int*)(F.ws + WS_TOPI);
    int* DEST = (int*)(F.ws + WS_DEST); int* TOK = (int*)(F.ws + WS_TOK);
    LAS int* sumL = (LAS int*)F.lds; LAS int* ownL = sumL + 512; LAS int* totL = ownL + 512; LAS int* preL = totL + 32; LAS int* psL = preL + 32;
    constexpr int NTILE = T / 64;
    for (int tile = blockIdx.x; tile < NTILE; tile += F.G) {
        __syncthreads();
        { const int e = F.tid & 31, pt = F.tid >> 5; int s = 0, own = 0;
#pragma unroll 4
          for (int i = 0; i < NTILE / 16; ++i) { const int tt = pt * (NTILE / 16) + i; const int h = HIST[tt * NE + e]; s += h; own += (tt < tile) ? h : 0; }
          sumL[pt * 32 + e] = s; ownL[pt * 32 + e] = own; }
        __syncthreads();
        if (F.tid < 32) { int t = 0, p = 0;
#pragma unroll
            for (int pt = 0; pt < 16; ++pt) { t += sumL[pt * 32 + F.tid]; p += ownL[pt * 32 + F.tid]; }
            totL[F.tid] = t; preL[F.tid] = p; if (tile == 0) F.ctl[CW_COUNTS + F.tid] = (unsigned)t; }
        __syncthreads();
        if (F.tid == 0) { int acc = 0; for (int e = 0; e < NE; ++e) { psL[e] = acc; acc += ((totL[e] + EB - 1) / EB) * EB; } }
        __syncthreads();
        if (F.tid < 256) { const int a = tile * 256 + F.tid, e = TOPI[a], d = psL[e] + preL[e] + LRANK[a]; DEST[a] = d; TOK[d] = a >> 2; }
    }
    __syncthreads();
}
__device__ __forceinline__ void load_pstart(const Frame& F) {
    LAS int* ps = (LAS int*)(F.lds + PS_OFF);
    __syncthreads();
    if (F.tid == 0) { int acc = 0; for (int e = 0; e < NE; ++e) { ps[e] = acc; const int c = (int)__hip_atomic_load(F.ctl + CW_COUNTS + e, __ATOMIC_RELAXED, __HIP_MEMORY_SCOPE_AGENT); acc += ((c + EB - 1) / EB) * EB; } ps[NE] = acc; }
    __syncthreads();
}
__device__ __forceinline__ void ph_dest(const Frame& F) {
    load_pstart(F);
    const LAS int* ps = (const LAS int*)(F.lds + PS_OFF);
    const int* TOPI = (const int*)(F.ws + WS_TOPI); int* DEST = (int*)(F.ws + WS_DEST); int* TOK = (int*)(F.ws + WS_TOK);
    for (int a = blockIdx.x * 512 + F.tid; a < NASSIGN; a += F.G * 512) {
        const int e = TOPI[a]; const int pos = (int)atomicAdd(F.ctl + CW_CURSOR + e, 1u); const int d = ps[e] + pos;
        TOK[d] = a >> 2; DEST[a] = d;
    }
}

struct CfgMoe1 {
    const bf16_t* H1; const int* TOK; const float* W; const float* bgu; bf16_t* ACT; const LAS int* ps;
    __device__ __forceinline__ int expert(int tm) const { const int r0 = tm * 128; int e = 0;
#pragma unroll 1
        for (int i = 1; i < NE; ++i) e += (ps[i] <= r0) ? 1 : 0; return e; }
    __device__ __forceinline__ const bf16_t* arow(int row) const { return H1 + (size_t)TOK[row] * DM; }
    __device__ __forceinline__ const float* bptr(int tm) const { return W + (size_t)expert(tm) * DM * 2 * DE; }
    __device__ __forceinline__ int ldb() const { return 2 * DE; }
    __device__ __forceinline__ int K() const { return DM; }
    __device__ __forceinline__ void epi(int tm, int row, int col0, float v0, float v1) const {
        const int e = expert(tm);
        float g = v0 + bgu[e * 2 * DE + col0], l = v1 + bgu[e * 2 * DE + DE + col0];
        g = fminf(g, SWIGLU_LIMIT); l = fminf(fmaxf(l, -SWIGLU_LIMIT), SWIGLU_LIMIT);
        ACT[(size_t)row * DE + col0] = (bf16_t)f2bf(g * sigmoid_f(SWIGLU_ALPHA * g) * (l + 1.f));
    }
};
__device__ __forceinline__ void ph_moe1(const Frame& F) {
    load_pstart(F);
    const LAS int* ps = (const LAS int*)(F.lds + PS_OFF);
    CfgMoe1 c{(const bf16_t*)(F.ws + WS_H1), (const int*)(F.ws + WS_TOK), F.in[I_WGU], F.in[I_BGU], (bf16_t*)(F.ws + WS_ACT), ps};
    const int ntm = ps[NE] / 128; constexpr int NTN = DE / 64;
    for (int t = blockIdx.x; t < ntm * NTN; t += F.G) gemm_simple_tile<DE>(F, c, t / NTN, t % NTN);
}
struct CfgMoe2 {
    const bf16_t* ACT; const float* W; const float* bd; bf16_t* OUTS; const LAS int* ps;
    __device__ __forceinline__ int expert(int tm) const { const int r0 = tm * 128; int e = 0;
#pragma unroll 1
        for (int i = 1; i < NE; ++i) e += (ps[i] <= r0) ? 1 : 0; return e; }
    __device__ __forceinline__ const bf16_t* arow(int row) const { return ACT + (size_t)row * DE; }
    __device__ __forceinline__ const float* bptr(int tm) const { return W + (size_t)expert(tm) * DE * DM; }
    __device__ __forceinline__ int ldb() const { return DM; }
    __device__ __forceinline__ int K() const { return DE; }
    __device__ __forceinline__ void epi(int tm, int row, int col0, float v0, float v1) const {
        const int e = expert(tm);
        OUTS[(size_t)row * DM + col0] = (bf16_t)f2bf(v0 + bd[e * DM + col0]);
        OUTS[(size_t)row * DM + col0 + 16] = (bf16_t)f2bf(v1 + bd[e * DM + col0 + 16]);
    }
};
__device__ __forceinline__ void ph_moe2(const Frame& F) {
    load_pstart(F);
    const LAS int* ps = (const LAS int*)(F.lds + PS_OFF);
    CfgMoe2 c{(const bf16_t*)(F.ws + WS_ACT), F.in[I_WD], F.in[I_BD], (bf16_t*)(F.ws + WS_OUTS), ps};
    const int ntm = ps[NE] / 128; constexpr int NTN = DM / 128;
    for (int t = blockIdx.x; t < ntm * NTN; t += F.G) gemm_simple_tile<16>(F, c, t / NTN, t % NTN);
}


__device__ __forceinline__ void p0_transpose_item(const float* W, int K, int N, bf16_t* WT, bool paired, LAS float* scr, int item, int lane) {
    const int nblk = N / 32, kb = item / nblk, nb = item % nblk, k0 = 64 * kb, n0 = 32 * nb;
    int drow = n0;
    if (paired) { const int half = N >> 1, j = n0 % half; drow = (j >> 7) * 256 + (n0 / half) * 128 + (j & 127); }
#pragma unroll 8
    for (int i = 0; i < 32; ++i) { const int kk = 2 * i + (lane >> 5); scr[kk * 33 + (lane & 31)] = W[(size_t)(k0 + kk) * N + n0 + (lane & 31)]; }
    asm volatile("s_waitcnt lgkmcnt(0)" ::: "memory");
    const int c = lane & 7;
#pragma unroll
    for (int j = 0; j < 4; ++j) { const int n = (lane >> 3) + 8 * j; const LAS float* s = scr + (8 * c) * 33 + n;
        u32x4 o; o.x = pk2(s[0 * 33], s[1 * 33]); o.y = pk2(s[2 * 33], s[3 * 33]); o.z = pk2(s[4 * 33], s[5 * 33]); o.w = pk2(s[6 * 33], s[7 * 33]);
        *(u32x4*)(WT + (size_t)(drow + n) * K + k0 + 8 * c) = o; }
    asm volatile("s_waitcnt lgkmcnt(0)" ::: "memory");
}
__device__ __forceinline__ void ph_convert(const Frame& F) {
    LAS float* scr = (LAS float*)(F.lds + F.wave * 16384);
    constexpr int I_IN = (DM / 64) * (INW / 32), I_GLU = (SW / 64) * (2 * SW / 32), I_UP = (512 / 64) * (DM / 32), I_O = (DM / 64) * (DM / 32);
    constexpr int I_GU1 = (DM / 64) * (2 * DE / 32), I_D1 = (DE / 64) * (DM / 32);
    constexpr int NITEMS = I_IN + I_GLU + 2 * I_UP + I_O + NE * I_GU1 + NE * I_D1;
    for (int it = F.gw; it < NITEMS; it += F.NGW) {
        int r = it;
        if (r < NE * I_GU1) { const int e = r / I_GU1; p0_transpose_item(F.in[I_WGU] + (size_t)e * DM * 2 * DE, DM, 2 * DE, (bf16_t*)(F.ws + WS_WGU) + (size_t)e * 2 * DE * DM, true, scr, r % I_GU1, F.lane); continue; } r -= NE * I_GU1;
        if (r < NE * I_D1) { const int e = r / I_D1; p0_transpose_item(F.in[I_WD] + (size_t)e * DE * DM, DE, DM, (bf16_t*)(F.ws + WS_WD) + (size_t)e * DM * DE, false, scr, r % I_D1, F.lane); continue; } r -= NE * I_D1;
        if (r < I_IN) { p0_transpose_item(F.in[I_WIN], DM, INW, (bf16_t*)(F.ws + WS_WIN), false, scr, r, F.lane); continue; } r -= I_IN;
        if (r < I_GLU) { p0_transpose_item(F.in[I_WGLU], SW, 2 * SW, (bf16_t*)(F.ws + WS_WGLU), true, scr, r, F.lane); continue; } r -= I_GLU;
        if (r < I_UP) { p0_transpose_item(F.in[I_WUA], 512, DM, (bf16_t*)(F.ws + WS_WUA), false, scr, r, F.lane); continue; } r -= I_UP;
        if (r < I_UP) { p0_transpose_item(F.in[I_WUS], 512, DM, (bf16_t*)(F.ws + WS_WUS), false, scr, r, F.lane); continue; } r -= I_UP;
        p0_transpose_item(F.in[I_WO], DM, DM, (bf16_t*)(F.ws + WS_WO), false, scr, r, F.lane);
    }
    __syncthreads();
}

__device__ __forceinline__ void ph_inproj_fast(const Frame& F) {
    pg8::Gemm g{(const bf16_t*)(F.ws + WS_H0), (const bf16_t*)(F.ws + WS_WIN), DM};
    pg8::StaticOrder S; S.init(T / 256, INW / 256, F.G, (int)blockIdx.x);
    EpiInProj E{(bf16_t*)(F.ws + WS_Q), (bf16_t*)(F.ws + WS_K), (bf16_t*)(F.ws + WS_V), (bf16_t*)(F.ws + WS_U), (bf16_t*)(F.ws + WS_GA), (bf16_t*)(F.ws + WS_GS), F.in[I_BGATE], (bf16_t*)(F.ws + WS_VT), F.lds + TOKL_OFF};
    pg8::gemm_phase<EpiInProj, pg8::StaticOrder, false>(F.lds, g, S, E);
}
__device__ __forceinline__ void ph_glu_fast(const Frame& F) {
    pg8::Gemm g{(const bf16_t*)(F.ws + WS_GY), (const bf16_t*)(F.ws + WS_WGLU), SW};
    pg8::StaticOrder S; S.init(T / 256, 2 * SW / 256, F.G, (int)blockIdx.x);
    EpiGlu E{(bf16_t*)(F.ws + WS_SG)};
    pg8::gemm_phase<EpiGlu, pg8::StaticOrder, false>(F.lds, g, S, E);
}
__device__ __forceinline__ void ph_up_fast(const Frame& F, bool second) {
    pg8::Gemm g{(const bf16_t*)(F.ws + (second ? WS_SG : WS_AO)), (const bf16_t*)(F.ws + (second ? WS_WUS : WS_WUA)), 512};
    pg8::StaticOrder S; S.init(T / 256, DM / 256, F.G, (int)blockIdx.x);
    EpiUp E{(const bf16_t*)(F.ws + (second ? WS_GS : WS_GA)), (bf16_t*)(F.ws + WS_TMPB), (bf16_t*)(F.ws + WS_Y), second};
    pg8::gemm_phase<EpiUp, pg8::StaticOrder, false>(F.lds, g, S, E);
}
__device__ __forceinline__ void ph_wo_fast(const Frame& F) {
    pg8::Gemm g{(const bf16_t*)(F.ws + WS_Y), (const bf16_t*)(F.ws + WS_WO), DM};
    pg8::StaticOrder S; S.init(T / 256, DM / 256, F.G, (int)blockIdx.x);
    EpiWo E{(const bf16_t*)(F.ws + WS_H0), (float*)(F.ws + WS_R1)};
    pg8::gemm_phase<EpiWo, pg8::StaticOrder, false>(F.lds, g, S, E);
}
__device__ __forceinline__ void ph_moe1_fast(const Frame& F) {
    load_pstart(F);
    const LAS int* ps = (const LAS int*)(F.lds + PS_OFF); LAS unsigned* tokl = (LAS unsigned*)(F.lds + TOKL_OFF);
    MoeOrder S; S.so.init(__builtin_amdgcn_readfirstlane(ps[NE]) / 256, 2 * DE / 256, F.G, (int)blockIdx.x); S.ps = ps; S.tokl = tokl; S.bt_per_e = 2 * DE / 256;
    const int* TOK = (const int*)(F.ws + WS_TOK);
    pg8::Unit u;
    for (int i = 0; i < TOKL_UNITS; ++i) { if (!S.next(i, u)) break; if (F.tid < 256) tokl[i * 256 + F.tid] = (unsigned)TOK[u.pm * 256 + F.tid] * (unsigned)(DM * 2); }
    __syncthreads();
    pg8::Gemm g{(const bf16_t*)(F.ws + WS_H1), (const bf16_t*)(F.ws + WS_WGU), DM};
    EpiMoe1 E{F.in[I_BGU], (bf16_t*)(F.ws + WS_ACT)};
    pg8::gemm_phase<EpiMoe1, MoeOrder, true>(F.lds, g, S, E);
}
__device__ __forceinline__ void ph_moe2_fast(const Frame& F) {
    load_pstart(F);
    const LAS int* ps = (const LAS int*)(F.lds + PS_OFF);
    MoeOrder S; S.so.init(__builtin_amdgcn_readfirstlane(ps[NE]) / 256, DM / 256, F.G, (int)blockIdx.x); S.ps = ps; S.tokl = nullptr; S.bt_per_e = DM / 256;
    pg8::Gemm g{(const bf16_t*)(F.ws + WS_ACT), (const bf16_t*)(F.ws + WS_WD), DE};
    EpiMoe2 E{F.in[I_BD], (bf16_t*)(F.ws + WS_OUTS)};
    pg8::gemm_phase<EpiMoe2, MoeOrder, false>(F.lds, g, S, E);
}
__device__ __forceinline__ void ph_combine(const Frame& F) {
    const bf16_t* H1 = (const bf16_t*)(F.ws + WS_H1); const bf16_t* OUTS = (const bf16_t*)(F.ws + WS_OUTS);
    const int* DEST = (const int*)(F.ws + WS_DEST); const float* TOPG = (const float*)(F.ws + WS_TOPG);
    const f32x4* g4 = (const f32x4*)F.in[I_LN2G]; const f32x4* b4 = (const f32x4*)F.in[I_LN2B];
    const int lane = F.lane;
    for (int m = F.gw; m < T; m += F.NGW) {
        f32x4 v[4];
        const u32x2* hr = (const u32x2*)(H1 + (size_t)m * DM) + lane;
#pragma unroll
        for (int j = 0; j < 4; ++j) { const u32x2 w = hr[64 * j]; v[j] = (f32x4){bf2f(w.x & 0xffffu), bf2f(w.x >> 16), bf2f(w.y & 0xffffu), bf2f(w.y >> 16)} * ALPHA; }
#pragma unroll
        for (int k = 0; k < TOPK; ++k) {
            const int d = DEST[m * 4 + k]; const float gk = TOPG[m * 4 + k];
            const u32x2* orow = (const u32x2*)(OUTS + (size_t)d * DM) + lane;
#pragma unroll
            for (int j = 0; j < 4; ++j) { const u32x2 w = orow[64 * j]; v[j] += (f32x4){bf2f(w.x & 0xffffu), bf2f(w.x >> 16), bf2f(w.y & 0xffffu), bf2f(w.y >> 16)} * gk; }
        }
        float s = 0.f;
#pragma unroll
        for (int j = 0; j < 4; ++j) s += (v[j][0] + v[j][1]) + (v[j][2] + v[j][3]);
        const float mean = wave_sum(s) * (1.f / DM); float s2 = 0.f;
#pragma unroll
        for (int j = 0; j < 4; ++j) { v[j] = v[j] - mean; s2 += (v[j][0] * v[j][0] + v[j][1] * v[j][1]) + (v[j][2] * v[j][2] + v[j][3] * v[j][3]); }
        const float rstd = 1.f / sqrtf(wave_sum(s2) * (1.f / DM) + LN_EPS);
        f32x4* o = (f32x4*)(F.out + (size_t)m * DM) + lane;
#pragma unroll
        for (int j = 0; j < 4; ++j) o[64 * j] = v[j] * rstd * g4[lane + 64 * j] + b4[lane + 64 * j];
    }
}


constexpr int N_PHASES = 13;

__global__ void __launch_bounds__(NWAVES * 64, 2) mega_fwd(Args args) {
    extern __shared__ __attribute__((aligned(16))) unsigned char lds[];
    Frame F;
    F.lds = (LAS unsigned char*)lds;
    F.tid = threadIdx.x; F.lane = F.tid & 63; F.wave = __builtin_amdgcn_readfirstlane(F.tid >> 6);
    F.G = gridDim.x; F.gw = blockIdx.x * NWAVES + F.wave; F.NGW = F.G * NWAVES;
    F.in = args.in; F.out = args.out; F.ws = args.ws; F.ctl = (unsigned*)(args.ws + WS_CTL);
    volatile LAS unsigned* MISC = (volatile LAS unsigned*)(F.lds + MISC_OFF);
    for (int u = F.tid; u < 64; u += NWAVES * 64) MISC[u] = 0u;
    __syncthreads();
    const int lo = args.ph_lo, hi = args.ph_hi;
    XcdBarrier bar; bar.bar = F.ctl + CW_BAR; bar.x = 0; bar.st = nullptr;
    if (hi - lo > 1) bar = xcd_barrier_post(F.ctl + CW_BAR, MISC + 8);
#define IN(k) (lo <= (k) && (k) < hi)
#define SEAM(k) do { if (IN(k) && IN((k) + 1)) xcd_barrier(bar); } while (0)
#define PHASE(k, ...) if (IN(k)) { for (int rep_ = 0; rep_ < ((k) == REPEAT_PHASE ? REPEAT_N : 1); ++rep_) { if (rep_) xcd_barrier(bar); __VA_ARGS__ } } SEAM(k);
    PHASE(0, ph_ln_in(F); ph_convert(F); ph_ssm_tables(F); ph_router_tables(F);)
    PHASE(1, ph_inproj_fast(F);)
    PHASE(2, for (int u = blockIdx.x; u < BATCH * NG * 4; u += F.G) ph_ssm_xe(F, u); ph_attn_fast_b(F, blockIdx.x);)
    PHASE(3, ph_ssm_out(F);)
    PHASE(4, ph_glu_fast(F);)
    PHASE(5, ph_up_fast(F, false);)
    PHASE(6, ph_up_fast(F, true);)
    PHASE(7, ph_wo_fast(F);)
    PHASE(8, ph_router(F);)
    PHASE(9, ph_dest2(F);)
    PHASE(10, ph_moe1_fast(F);)
    PHASE(11, ph_moe2_fast(F);)
    PHASE(12, ph_combine(F);)
#undef PHASE
#undef IN
#undef SEAM
}

extern "C" void kernel_launch(void* const* d_in, const int* in_sizes, int n_in, void* d_out, int out_size, void* d_ws, size_t ws_size, hipStream_t stream) {
    static int grid = 0;
    if (grid == 0) {
        if (n_in != 28 || out_size != T * DM || ws_size < WS_END) { fprintf(stderr, "kernel_launch: unexpected shapes (n_in %d out %d ws %zu)\n", n_in, out_size, ws_size); grid = -1; return; }
        int dev = 0, cus = 0;
        if (hipGetDevice(&dev) != hipSuccess || hipDeviceGetAttribute(&cus, hipDeviceAttributeMultiprocessorCount, dev) != hipSuccess) { grid = -1; return; }
        if (hipFuncSetAttribute((const void*)mega_fwd, hipFuncAttributeMaxDynamicSharedMemorySize, LDS_BYTES) != hipSuccess) { fprintf(stderr, "kernel_launch: hipFuncSetAttribute failed\n"); grid = -1; return; }
        grid = cus;
    }
    if (grid < 0) return;
    (void)hipMemsetAsync((char*)d_ws + WS_CTL, 0, CTL_ZERO_BYTES, stream);
    Args a{};
    for (int i = 0; i < 28; ++i) a.in[i] = (const float*)d_in[i];
    a.out = (float*)d_out; a.ws = (unsigned char*)d_ws;
#if MK_ONE_LAUNCH
    a.ph_lo = 0; a.ph_hi = N_PHASES;
    hipLaunchKernelGGL(mega_fwd, dim3(grid), dim3(NWAVES * 64), LDS_BYTES, stream, a);
#else
    for (int p = 0; p < N_PHASES; ++p) { a.ph_lo = p; a.ph_hi = p + 1; hipLaunchKernelGGL(mega_fwd, dim3(grid), dim3(NWAVES * 64), LDS_BYTES, stream, a); }
#endif
}
```

```cpp
#include <hip/hip_runtime.h>
#include <cstdio>
#include <cstdint>

#ifndef FAST_INPROJ
#define FAST_INPROJ 1
#endif
#ifndef FAST_MID
#define FAST_MID 1
#endif
#ifndef FAST_MOE1
#define FAST_MOE1 1
#endif
#ifndef REPEAT_PHASE
#define REPEAT_PHASE (-1)
#endif
#ifndef REPEAT_N
#define REPEAT_N 3
#endif
#ifndef FAST_SSM
#define FAST_SSM 1
#endif
#ifndef FAST_ATTN
#define FAST_ATTN 1
#endif
#ifndef FAST_MOE2
#define FAST_MOE2 1
#endif
#define FAST_ANY (FAST_INPROJ || FAST_MID || FAST_MOE1 || FAST_MOE2)
#ifndef MK_ONE_LAUNCH
#define MK_ONE_LAUNCH 1
#endif

#define GAS __attribute__((address_space(1)))
#define LAS __attribute__((address_space(3)))
typedef unsigned short bf16_t;
typedef short bf16x8 __attribute__((ext_vector_type(8)));
typedef float f32x4 __attribute__((ext_vector_type(4)));
typedef unsigned u32x4 __attribute__((ext_vector_type(4)));
typedef unsigned u32x2 __attribute__((ext_vector_type(2)));

constexpr int BATCH = 2, SEQ = 8192, T = BATCH * SEQ, DM = 1024;
constexpr int CHUNK = 64, LEFT = 8, NCH = SEQ / CHUNK;
constexpr int NH = 8, HD = 64, AW = 512, RELMAX = 256, RELSIZE = 320;
constexpr int SW = 512, GSZ = 16, NG = 32, NP = 64;
constexpr int INW = 4096;
constexpr int NE = 32, TOPK = 4, DE = 1024, EB = 256;
constexpr int NASSIGN = T * TOPK;
constexpr int NROWS = NASSIGN + NE * EB;
constexpr float LN_EPS = 1e-5f;
constexpr float ALPHA = 1.189207115002721f;
constexpr float SWIGLU_LIMIT = 7.0f, SWIGLU_ALPHA = 1.702f;
constexpr int NWAVES = 8;
constexpr float LOG2E = 1.4426950408889634f, QSCALE = 0.125f * LOG2E;
constexpr int LDS_BYTES = 147456;
constexpr int MISC_OFF = 131072 + 320, PS_OFF = 131072 + 1024, TOKL_OFF = 131072 + 2048, TOKL_UNITS = 10;

constexpr size_t MiB = 1u << 20;
constexpr size_t WS_CTL = 0, CTL_ZERO_BYTES = 1 * MiB;
constexpr size_t WS_H0 = 1 * MiB;
constexpr size_t WS_Q = 33 * MiB;
constexpr size_t WS_K = 49 * MiB;
constexpr size_t WS_V = 65 * MiB;
constexpr size_t WS_U = 81 * MiB;
constexpr size_t WS_GA = 97 * MiB;
constexpr size_t WS_GS = 129 * MiB;
constexpr size_t WS_AO = 161 * MiB;
constexpr size_t WS_GY = 177 * MiB;
constexpr size_t WS_SG = 193 * MiB;
constexpr size_t WS_Y = 209 * MiB;
constexpr size_t WS_R1 = 241 * MiB;
constexpr size_t WS_H1 = 305 * MiB;
constexpr size_t WS_TOPI = 338 * MiB;
constexpr size_t WS_TOPG = 339 * MiB;
constexpr size_t WS_DEST = 340 * MiB;
constexpr size_t WS_TOK = 341 * MiB;
constexpr size_t WS_ACT = 342 * MiB;
constexpr size_t WS_OUTS = 486 * MiB;
constexpr size_t WS_WIN = 630 * MiB;
constexpr size_t WS_WGLU = 638 * MiB;
constexpr size_t WS_WUA = 639 * MiB;
constexpr size_t WS_WUS = 640 * MiB;
constexpr size_t WS_WO = 641 * MiB;
constexpr size_t WS_WGU = 643 * MiB;
constexpr size_t WS_WD = 771 * MiB;
constexpr size_t WS_TMPB = WS_R1;
constexpr size_t WS_VT = 835 * MiB;
constexpr size_t WS_LP = 851 * MiB;
constexpr size_t WS_LLP = 853 * MiB;
constexpr size_t WS_WST = 855 * MiB;
constexpr size_t WS_KDT = 863 * MiB;
constexpr size_t WS_CINT = 864 * MiB;
constexpr size_t WS_XSL = 865 * MiB;
constexpr size_t WS_UEND = 869 * MiB;
constexpr size_t WS_GWP = 870 * MiB;
constexpr size_t WS_RC = 871 * MiB;
constexpr size_t WS_HIST = 872 * MiB;
constexpr size_t WS_LRANK = 873 * MiB;
constexpr size_t WS_UG = 874 * MiB;
constexpr size_t WS_END = 890 * MiB;
constexpr int CW_COUNTS = 64, CW_CURSOR = 128;
constexpr int CW_BAR = 4096;

__device__ __forceinline__ unsigned f2bf(float f) { unsigned u = __float_as_uint(f); return (u + 0x7fffu + ((u >> 16) & 1u)) >> 16; }
__device__ __forceinline__ float bf2f(unsigned h) { return __uint_as_float(h << 16); }
__device__ __forceinline__ unsigned pk2(float lo, float hi) { return f2bf(lo) | (f2bf(hi) << 16); }
__device__ __forceinline__ float wave_sum(float v) {
#pragma unroll
    for (int o = 1; o < 64; o <<= 1) v += __shfl_xor(v, o);
    return v;
}
__device__ __forceinline__ float sigmoid_f(float x) { return __builtin_amdgcn_rcpf(1.f + __builtin_amdgcn_exp2f(-1.4426950408889634f * x)); }
__device__ __forceinline__ float gelu_tanh(float x) { const float z = 0.7978845608028654f * (x + 0.044715f * x * x * x); return x * sigmoid_f(2.f * z); }

__device__ __forceinline__ void sincos_d(double x, double& s, double& c) {
    const double kd = rint(x * 0.63661977236758134308);
    const int k = (int)kd;
    double r = fma(-kd, 1.57079632679489655800e+00, x);
    r = fma(-kd, 6.12323399573676603587e-17, r);
    const double r2 = r * r;
    double sp = -1.0 / 1307674368000.0;
    sp = sp * r2 + 1.0 / 6227020800.0; sp = sp * r2 - 1.0 / 39916800.0; sp = sp * r2 + 1.0 / 362880.0; sp = sp * r2 - 1.0 / 5040.0; sp = sp * r2 + 1.0 / 120.0; sp = sp * r2 - 1.0 / 6.0;
    sp = r + r * r2 * sp;
    double cp = -1.0 / 87178291200.0;
    cp = cp * r2 + 1.0 / 479001600.0; cp = cp * r2 - 1.0 / 3628800.0; cp = cp * r2 + 1.0 / 40320.0; cp = cp * r2 - 1.0 / 720.0; cp = cp * r2 + 1.0 / 24.0; cp = cp * r2 - 0.5;
    cp = 1.0 + r2 * cp;
    const int q = k & 3;
    s = (q == 0) ? sp : (q == 1) ? cp : (q == 2) ? -sp : -cp;
    c = (q == 0) ? cp : (q == 1) ? -sp : (q == 2) ? -cp : sp;
}

#define XB_TMO      128
#define XB_XCNT(j)  (256  + 64 * (j))
#define XB_XSUB(j)  (1280 + 64 * (j))
#define XB_XGEN(j)  (2304 + 64 * (j))
#define XB_TOP      3328
#define XB_TOPGEN   3392
#define XCD_BAR_WORDS 3456
#define XB_SPIN_CAP (1u << 22)
__device__ __forceinline__ unsigned xb_ld(unsigned* p)              { return __hip_atomic_load(p, __ATOMIC_RELAXED, __HIP_MEMORY_SCOPE_AGENT); }
__device__ __forceinline__ unsigned xb_add(unsigned* p, unsigned v) { return __hip_atomic_fetch_add(p, v, __ATOMIC_RELAXED, __HIP_MEMORY_SCOPE_AGENT); }
__device__ __forceinline__ unsigned xb_xcc_id() { return (unsigned)__builtin_amdgcn_s_getreg((3 << 11) | 20) & 0xFu; }
#define XB_SPIN(cond, bar) do { unsigned _sp = 0; while (cond) { __builtin_amdgcn_s_sleep(1); \
    if ((++_sp & 255u) == 0u) { if (xb_ld(&(bar)[XB_TMO])) break; if (_sp > XB_SPIN_CAP) { atomicAdd(&(bar)[XB_TMO], 1u); break; } } } } while (0)
struct XcdBarrier { unsigned* bar; unsigned x; volatile LAS unsigned* st; };
__device__ __forceinline__ XcdBarrier xcd_barrier_post(unsigned* bar, volatile LAS unsigned* st) {
    XcdBarrier b; b.bar = bar; b.x = xb_xcc_id(); b.st = st;
    if (threadIdx.x == 0) (void)xb_add(&bar[XB_XCNT(b.x)], 1u);
    return b;
}
__device__ __forceinline__ void xcd_barrier_complete(unsigned* bar, unsigned x, unsigned& nloc, unsigned& nx) {
    const unsigned G = gridDim.x * gridDim.y * gridDim.z;
    unsigned sum, cnt, mine, sp = 0u;
    for (;;) {
        sum = 0u; cnt = 0u; mine = 0u;
#pragma unroll
        for (unsigned j = 0; j < 16; ++j) { const unsigned c = xb_ld(&bar[XB_XCNT(j)]); sum += c; cnt += (c > 0u) ? 1u : 0u; mine = (j == x) ? c : mine; }
        if (sum == G) break;
        __builtin_amdgcn_s_sleep(1);
        if ((++sp & 255u) == 0u) { if (xb_ld(&bar[XB_TMO])) break; if (sp > XB_SPIN_CAP) { atomicAdd(&bar[XB_TMO], 1u); break; } }
    }
    nloc = mine > 0u ? mine : 1u; nx = cnt > 0u ? cnt : 1u;
}
__device__ __forceinline__ void xcd_barrier(const XcdBarrier& b) {
    asm volatile("s_waitcnt vmcnt(0)" ::: "memory");
    __syncthreads();
    if (threadIdx.x == 0) {
        unsigned* bar = b.bar;
        __builtin_amdgcn_s_waitcnt(0);
        unsigned nloc = b.st[0], nx = b.st[1];
        if (nloc == 0u) { xcd_barrier_complete(bar, b.x, nloc, nx); b.st[0] = nloc; b.st[1] = nx; }
        const unsigned old = xb_add(&bar[XB_XSUB(b.x)], 1u);
        const unsigned gen = old / nloc;
        if (old + 1u == (gen + 1u) * nloc) {
            __builtin_amdgcn_fence(__ATOMIC_RELEASE, "agent");
            asm volatile("s_waitcnt vmcnt(0)" ::: "memory");
            const unsigned og = xb_add(&bar[XB_TOP], 1u);
            const unsigned tg = og / nx;
            if (og + 1u == (tg + 1u) * nx) xb_add(&bar[XB_TOPGEN], 1u);
            else XB_SPIN(xb_ld(&bar[XB_TOPGEN]) == tg, bar);
            __builtin_amdgcn_fence(__ATOMIC_ACQUIRE, "agent");
            xb_add(&bar[XB_XGEN(b.x)], 1u);
            asm volatile("s_waitcnt vmcnt(0)" ::: "memory");
        } else {
            XB_SPIN(xb_ld(&bar[XB_XGEN(b.x)]) == gen, bar);
            __builtin_amdgcn_fence(__ATOMIC_ACQUIRE, "agent");
            asm volatile("s_waitcnt vmcnt(0)" ::: "memory");
        }
    }
    __syncthreads();
}


namespace pg8 {
#define PG8_LAS __attribute__((address_space(3)))
constexpr int BM = 256, BK = 64, HALF = 128, HTB = HALF * BK * 2, STAGE_BYTES = 8 * HTB, NXCD = 8, WGM = 8;
__host__ __device__ __forceinline__ int lds_byte(int r, int c) { const int st = (r >> 4) * 2 + (c >> 5), rr = r & 15, cc = c & 31, ob = rr * 64 + cc * 2; return st * 1024 + (ob ^ (((ob >> 9) & 1) << 5)); }
__host__ __device__ __forceinline__ void stage_rc(int b, int& R, int& C) { const int st = b / 1024, sb = b % 1024, swz = sb ^ (((sb >> 9) & 1) << 5); R = (st >> 1) * 16 + swz / 64; C = (st & 1) * 32 + (swz % 64) / 2; }
__host__ __device__ __forceinline__ int perm32(int rho) { const int n = rho >> 4, i = rho & 15; return 8 * (i >> 2) + 4 * n + (i & 3); }
struct Unit { int pm, pn, bn, ex; };
struct Gemm { const bf16_t* A; const bf16_t* Bt; int K; };
struct StaticOrder {
    int nM, nN, nwg, G, c;
    __device__ void init(int nM_, int nN_, int G_, int c_) { nM = nM_; nN = nN_; nwg = nM * nN; G = G_; c = c_; }
    __device__ bool next(int i, Unit& u) const {
        const long L = (long)i * G + c; if (L >= nwg) return false;
        int wgid = (int)L; { const int q = nwg / NXCD, r = nwg % NXCD, xcd = wgid % NXCD, off = wgid / NXCD; wgid = (xcd < r ? xcd * (q + 1) : r * (q + 1) + (xcd - r) * q) + off; }
        const int nig = WGM * nN, gid = wgid / nig, fm = gid * WGM, gsz = (nM - fm) < WGM ? (nM - fm) : WGM;
        u.pm = fm + ((wgid % nig) % gsz); u.pn = (wgid % nig) / gsz; u.bn = u.pn; u.ex = 0; return true;
    }
    __device__ __forceinline__ unsigned rowoff(int, int) const { return 0u; }
};
typedef float f32x2_t __attribute__((ext_vector_type(2))); typedef __bf16 bf16x2_t __attribute__((ext_vector_type(2)));
__device__ __forceinline__ unsigned cvt_pk_bf16(float lo, float hi) { const f32x2_t v = {lo, hi}; const bf16x2_t b = __builtin_convertvector(v, bf16x2_t); return __builtin_bit_cast(unsigned, b); }

template <class Epi, class Sched, bool GATHER>
__device__ __forceinline__ void gemm_phase(PG8_LAS unsigned char* lds, const Gemm g, const Sched& S, const Epi& E) {
    const int tid = threadIdx.x, wid = __builtin_amdgcn_readfirstlane(tid >> 6), lane = tid & 63, wr = wid >> 2, wc = wid & 3, fr = lane & 15, fq = lane >> 4;
    const int K = g.K, nt = K / BK;
    unsigned voffA0[2], voffA1[2], voffB[2];
#pragma unroll
    for (int i = 0; i < 2; ++i) { int R, C; stage_rc(tid * 16 + i * 8192, R, C); const int Rb = Epi::PERM ? ((R & ~31) + perm32(R & 31)) : R;
        voffA0[i] = (unsigned)(R * K + C) * 2u; voffA1[i] = voffA0[i] + (unsigned)(HALF * K * 2); voffB[i] = (unsigned)(Rb * K + C) * 2u; }
    const size_t kstep = (size_t)(BK * 2);
    const size_t hstep = (size_t)HALF * K * 2;
    const size_t tstep = 2 * hstep;
    const unsigned ldsw = (unsigned)wid * 1024u;
    const int aoff = lds_byte(wr * 64 + fr, fq * 8), boff = lds_byte(wc * 32 + fr, fq * 8);
#define PG8_SA(b, h) (((b) * 2 + (h)) * HTB)
#define PG8_SB(b, h) ((4 + (b) * 2 + (h)) * HTB)
#define PG8_STAGE(bufoff, gbase, voff) do { _Pragma("unroll") for (int _i = 0; _i < 2; ++_i) \
        __builtin_amdgcn_global_load_lds((const unsigned*)((const char*)(gbase) + (voff)[_i]), (PG8_LAS unsigned*)(lds + (bufoff) + ldsw + _i * 8192), 16, 0, 0); } while (0)
#define PG8_LDA(dst, b, h) do { _Pragma("unroll") for (int m = 0; m < 4; ++m) _Pragma("unroll") for (int k = 0; k < 2; ++k) dst[m][k] = *(const PG8_LAS bf16x8*)(lds + PG8_SA(b, h) + aoff + m * 2048 + k * 1024); } while (0)
#define PG8_LDB(dst, b, h) do { _Pragma("unroll") for (int n = 0; n < 2; ++n) _Pragma("unroll") for (int k = 0; k < 2; ++k) dst[n][k] = *(const PG8_LAS bf16x8*)(lds + PG8_SB(b, h) + boff + n * 2048 + k * 1024); } while (0)
#define PG8_MMA(ai, bj, At, Bt) do { __builtin_amdgcn_s_setprio(1); _Pragma("unroll") for (int m = 0; m < 4; ++m) _Pragma("unroll") for (int n = 0; n < 2; ++n) _Pragma("unroll") for (int k = 0; k < 2; ++k) \
        acc[ai][bj][m][n] = __builtin_amdgcn_mfma_f32_16x16x32_bf16(Bt[n][k], At[m][k], acc[ai][bj][m][n], 0, 0, 0); __builtin_amdgcn_s_setprio(0); } while (0)
#define PG8_WAIT_V(n) asm volatile("s_waitcnt vmcnt(" #n ")" ::: "memory")
#define PG8_WAIT_L(n) asm volatile("s_waitcnt lgkmcnt(" #n ")" ::: "memory")
#define PG8_BAR __builtin_amdgcn_s_barrier()
#define PG8_SCHED __builtin_amdgcn_sched_barrier(0)
#define PG8_GOFF(ui_) do { if constexpr (GATHER) { _Pragma("unroll") for (int _i = 0; _i < 2; ++_i) { int R_, C_; stage_rc(tid * 16 + _i * 8192, R_, C_); \
        voffA0[_i] = S.rowoff((ui_), R_) + (unsigned)(C_ * 2); voffA1[_i] = S.rowoff((ui_), HALF + R_) + (unsigned)(C_ * 2); } } } while (0)
    Unit cur, nxt; int ui = 0;
    if (!S.next(0, cur)) return;
    f32x4 acc[2][2][4][2];
#pragma unroll
    for (int a = 0; a < 2; ++a)
#pragma unroll
        for (int b = 0; b < 2; ++b)
#pragma unroll
            for (int m = 0; m < 4; ++m)
#pragma unroll
                for (int n = 0; n < 2; ++n) acc[a][b][m][n] = (f32x4){0.f, 0.f, 0.f, 0.f};
    bf16x8 At[4][2], B0[2][2], B1[2][2];
    PG8_GOFF(0);
    const char* cA = GATHER ? (const char*)g.A : (const char*)g.A + (size_t)cur.pm * tstep; const char* cB = (const char*)g.Bt + (size_t)cur.bn * tstep;
    PG8_STAGE(PG8_SB(0, 0), cB, voffB); PG8_STAGE(PG8_SB(0, 1), cB + hstep, voffB); PG8_STAGE(PG8_SA(0, 0), cA, voffA0); PG8_STAGE(PG8_SA(0, 1), cA, voffA1);
    if (wr == 1) PG8_BAR;
    PG8_WAIT_V(2); PG8_BAR;
    PG8_STAGE(PG8_SB(1, 0), cB + kstep, voffB); PG8_STAGE(PG8_SA(1, 0), cA + kstep, voffA0); PG8_STAGE(PG8_SB(1, 1), cB + hstep + kstep, voffB);
    PG8_WAIT_V(6); PG8_BAR;
    for (;;) {
        const bool has_next = S.next(ui + 1, nxt);
        const char* nA = GATHER ? (const char*)g.A : (has_next ? (const char*)g.A + (size_t)nxt.pm * tstep : cA);
        const char* nB = has_next ? (const char*)g.Bt + (size_t)nxt.bn * tstep : cB;
        for (int t = 0; t < nt; t += 2) {
            const bool last = (t == nt - 2);
            const char* a1 = cA + (size_t)(t + 1) * kstep;
            const char* a2 = last ? nA : cA + (size_t)(t + 2) * kstep; const char* b2 = last ? nB : cB + (size_t)(t + 2) * kstep;
            const char* a3 = a2 + kstep; const char* b3 = b2 + kstep;
            PG8_LDB(B0, 0, 0); PG8_LDB(B1, 0, 1); PG8_SCHED; PG8_LDA(At, 0, 0); PG8_STAGE(PG8_SA(1, 1), a1, voffA1);
            if (GATHER && last && has_next) { PG8_GOFF(ui + 1); }
            PG8_WAIT_V(8); PG8_WAIT_L(0); PG8_BAR; PG8_MMA(0, 0, At, B0); PG8_MMA(0, 1, At, B1); PG8_BAR; PG8_SCHED;
            PG8_LDA(At, 0, 1); PG8_STAGE(PG8_SB(0, 0), b2, voffB); PG8_STAGE(PG8_SB(0, 1), b2 + hstep, voffB); PG8_STAGE(PG8_SA(0, 0), a2, voffA0);
            PG8_WAIT_V(8); PG8_WAIT_L(0); PG8_BAR; PG8_MMA(1, 0, At, B0); PG8_MMA(1, 1, At, B1); PG8_BAR; PG8_SCHED;
            PG8_LDB(B0, 1, 0); PG8_LDB(B1, 1, 1); PG8_SCHED; PG8_LDA(At, 1, 0); PG8_STAGE(PG8_SA(0, 1), a2, voffA1);
            PG8_WAIT_V(8); PG8_WAIT_L(0); PG8_BAR; PG8_MMA(0, 0, At, B0); PG8_MMA(0, 1, At, B1); PG8_BAR; PG8_SCHED;
            PG8_LDA(At, 1, 1); PG8_STAGE(PG8_SB(1, 0), b3, voffB); PG8_STAGE(PG8_SB(1, 1), b3 + hstep, voffB); PG8_STAGE(PG8_SA(1, 0), a3, voffA0);
            PG8_WAIT_V(8); PG8_WAIT_L(0); PG8_BAR; PG8_MMA(1, 0, At, B0); PG8_MMA(1, 1, At, B1); PG8_BAR; PG8_SCHED;
        }
        if (wr == 0) PG8_BAR;
        E(acc, cur, wr, wc, fr, fq);
        if (!has_next) break;
#pragma unroll
        for (int a = 0; a < 2; ++a)
#pragma unroll
            for (int b = 0; b < 2; ++b)
#pragma unroll
                for (int m = 0; m < 4; ++m)
#pragma unroll
                    for (int n = 0; n < 2; ++n) acc[a][b][m][n] = (f32x4){0.f, 0.f, 0.f, 0.f};
        cur = nxt; cA = nA; cB = nB; ++ui;
        if (wr == 1) PG8_BAR;
    }
    PG8_WAIT_V(0);
    PG8_BAR;
#undef PG8_SA
#undef PG8_SB
#undef PG8_STAGE
#undef PG8_LDA
#undef PG8_LDB
#undef PG8_MMA
#undef PG8_WAIT_V
#undef PG8_WAIT_L
#undef PG8_BAR
#undef PG8_SCHED
#undef PG8_GOFF
}
}

struct Args {
    const float* in[28];
    float* out; unsigned char* ws;
    int ph_lo, ph_hi;
};
enum { I_X = 0, I_LNIG, I_LNIB, I_WIN, I_BGATE, I_RELB, I_LAMRE, I_LAMIM, I_LOGDT, I_BRE, I_BIM, I_CRE, I_CIM, I_SSMD, I_WGLU, I_WUA, I_WUS, I_WO,
       I_LN1G, I_LN1B, I_RW, I_RB, I_WGU, I_BGU, I_WD, I_BD, I_LN2G, I_LN2B };

struct Frame {
    LAS unsigned char* lds;
    int tid, lane, wave, G, gw, NGW;
    const float* const* in;
    float* out; unsigned char* ws;
    unsigned* ctl;
};

template <int PS> __device__ __forceinline__ int colbase(int tn, int wc) { return PS == 16 ? tn * 128 + wc * 32 : tn * 64 + wc * 16; }

template <int PS, class Cfg>
__device__ __forceinline__ void gemm_simple_tile(const Frame& F, const Cfg& c, int tm, int tn) {
    LAS bf16_t* As = (LAS bf16_t*)F.lds;
    LAS bf16_t* Bs = As + 128 * 40;
    const int tid = F.tid, lane = F.lane, w = F.wave, wr = w >> 2, wc = w & 3;
    f32x4 acc[4][2];
#pragma unroll
    for (int m = 0; m < 4; ++m)
#pragma unroll
        for (int n = 0; n < 2; ++n) acc[m][n] = (f32x4){0.f, 0.f, 0.f, 0.f};
    const int ar = tid >> 2, ak = (tid & 3) * 8;
    const bf16_t* ap = c.arow(tm * 128 + ar) + ak;
    const int bk = tid >> 4, bc = (tid & 15) * 8;
    const int pc = colbase<PS>(tn, bc >> 5) + ((bc >> 4) & 1) * PS + (bc & 15);
    const int ldb = c.ldb();
    const float* bp = c.bptr(tm) + (size_t)bk * ldb + pc;
    const int K = c.K();
    for (int k0 = 0; k0 < K; k0 += 32) {
        const u32x4 av = *(const u32x4*)(ap + k0);
        const f32x4 b0 = *(const f32x4*)(bp + (size_t)k0 * ldb), b1 = *(const f32x4*)(bp + (size_t)k0 * ldb + 4);
        __syncthreads();
        *(LAS u32x4*)(As + ar * 40 + ak) = av;
        Bs[(bc + 0) * 40 + bk] = (bf16_t)f2bf(b0[0]); Bs[(bc + 1) * 40 + bk] = (bf16_t)f2bf(b0[1]);
        Bs[(bc + 2) * 40 + bk] = (bf16_t)f2bf(b0[2]); Bs[(bc + 3) * 40 + bk] = (bf16_t)f2bf(b0[3]);
        Bs[(bc + 4) * 40 + bk] = (bf16_t)f2bf(b1[0]); Bs[(bc + 5) * 40 + bk] = (bf16_t)f2bf(b1[1]);
        Bs[(bc + 6) * 40 + bk] = (bf16_t)f2bf(b1[2]); Bs[(bc + 7) * 40 + bk] = (bf16_t)f2bf(b1[3]);
        __syncthreads();
        bf16x8 a[4], b[2];
#pragma unroll
        for (int m = 0; m < 4; ++m) a[m] = *(const LAS bf16x8*)(As + (wr * 64 + m * 16 + (lane & 15)) * 40 + (lane >> 4) * 8);
#pragma unroll
        for (int n = 0; n < 2; ++n) b[n] = *(const LAS bf16x8*)(Bs + (wc * 32 + n * 16 + (lane & 15)) * 40 + (lane >> 4) * 8);
#pragma unroll
        for (int m = 0; m < 4; ++m)
#pragma unroll
            for (int n = 0; n < 2; ++n) acc[m][n] = __builtin_amdgcn_mfma_f32_16x16x32_bf16(a[m], b[n], acc[m][n], 0, 0, 0);
    }
    const int col0 = colbase<PS>(tn, wc) + (lane & 15);
#pragma unroll
    for (int m = 0; m < 4; ++m)
#pragma unroll
        for (int r = 0; r < 4; ++r) {
            const int row = tm * 128 + wr * 64 + m * 16 + (lane >> 4) * 4 + r;
            c.epi(tm, row, col0, acc[m][0][r], acc[m][1][r]);
        }
    __syncthreads();
}


__device__ __forceinline__ void store8(bf16_t* p, const f32x4 v0, const f32x4 v1) {
    u32x4 w; w.x = pg8::cvt_pk_bf16(v0[0], v0[1]); w.y = pg8::cvt_pk_bf16(v0[2], v0[3]); w.z = pg8::cvt_pk_bf16(v1[0], v1[1]); w.w = pg8::cvt_pk_bf16(v1[2], v1[3]);
    *(u32x4*)p = w;
}
__device__ __forceinline__ void load8(const bf16_t* p, f32x4& v0, f32x4& v1) {
    const u32x4 w = *(const u32x4*)p;
    v0 = (f32x4){bf2f(w.x & 0xffffu), bf2f(w.x >> 16), bf2f(w.y & 0xffffu), bf2f(w.y >> 16)};
    v1 = (f32x4){bf2f(w.z & 0xffffu), bf2f(w.z >> 16), bf2f(w.w & 0xffffu), bf2f(w.w >> 16)};
}
__device__ __forceinline__ f32x4 sigmoid4(const f32x4 v) { return (f32x4){sigmoid_f(v[0]), sigmoid_f(v[1]), sigmoid_f(v[2]), sigmoid_f(v[3])}; }

struct EpiInProj {
    static constexpr bool PERM = true;
    bf16_t *Q, *Kb, *V, *U, *GA, *GS; const float* bgate; bf16_t* VT; LAS unsigned char* tl; bf16_t* UG;
    __device__ __forceinline__ void operator()(const f32x4 (&acc)[2][2][4][2], const pg8::Unit& u, int wr, int wc, int fr, int fq) const {
        const int pn = u.pn, row0 = u.pm * 256 + wr * 64 + fr, colin = wc * 32 + 8 * fq;
        bf16_t* base; int ld, cb; float sc = 1.f; const bool gate = pn >= 8;
        if (pn < 8) { base = pn < 2 ? Q : (pn < 4 ? Kb : (pn < 6 ? V : U)); ld = 512; cb = (pn & 1) * 256; if (pn < 2) sc = QSCALE; }
        else { base = pn < 12 ? GA : GS; ld = 1024; cb = (pn & 3) * 256; }
#pragma unroll
        for (int bj = 0; bj < 2; ++bj) {
            f32x4 b0 = (f32x4){0.f, 0.f, 0.f, 0.f}, b1 = b0;
            if (gate) { const float* bp = bgate + (pn - 8) * 256 + bj * 128 + colin; b0 = *(const f32x4*)bp; b1 = *(const f32x4*)(bp + 4); }
#pragma unroll
            for (int ai = 0; ai < 2; ++ai)
#pragma unroll
                for (int m = 0; m < 4; ++m) {
                    f32x4 v0 = acc[ai][bj][m][0], v1 = acc[ai][bj][m][1];
                    if (gate) { v0 = sigmoid4(v0 + b0); v1 = sigmoid4(v1 + b1); } else { v0 = v0 * sc; v1 = v1 * sc; }
                    if (pn == 6 || pn == 7) {
                        const int row = row0 + ai * 128 + m * 16, b = row / SEQ, tt = row % SEQ, ucol = cb + bj * 128 + colin;
                        store8(UG + (((size_t)(b * NG + (ucol >> 4)) * SEQ + tt) << 4) + (ucol & 8), v0, v1);
                    } else
                    store8(base + (size_t)(row0 + ai * 128 + m * 16) * ld + cb + bj * 128 + colin, v0, v1);
                    if (pn == 4 || pn == 5) {
                        LAS bf16_t* pl = (LAS bf16_t*)(tl + (wr * 4 + wc) * 1024);
                        const int pos = (fr & 3) | ((fr & 4) << 1) | ((fr & 8) >> 1);
#pragma unroll
                        for (int j = 0; j < 4; ++j) { pl[(8 * fq + j) * 16 + pos] = (bf16_t)f2bf(v0[j]); pl[(8 * fq + 4 + j) * 16 + pos] = (bf16_t)f2bf(v1[j]); }
                        asm volatile("s_waitcnt lgkmcnt(0)" ::: "memory");
                        const int lane = fq * 16 + fr;
                        const u32x4 w = *(const LAS u32x4*)(pl + (lane >> 1) * 16 + 8 * (lane & 1));
                        asm volatile("s_waitcnt lgkmcnt(0)" ::: "memory");
                        const int trow = u.pm * 256 + wr * 64 + ai * 128 + m * 16, b = trow / SEQ, tt0 = trow % SEQ;
                        const int d = cb + bj * 128 + wc * 32 + (lane >> 1);
                        *(u32x4*)(VT + ((size_t)(b * NH) * HD + d) * SEQ + tt0 + 8 * (lane & 1)) = w;
                    }
                }
        }
    }
};
struct EpiGlu {
    static constexpr bool PERM = true;
    bf16_t* SGo;
    __device__ __forceinline__ void operator()(const f32x4 (&acc)[2][2][4][2], const pg8::Unit& u, int wr, int wc, int fr, int fq) const {
        const int row0 = u.pm * 256 + wr * 64 + fr, col = u.pn * 128 + wc * 32 + 8 * fq;
#pragma unroll
        for (int ai = 0; ai < 2; ++ai)
#pragma unroll
            for (int m = 0; m < 4; ++m)
                store8(SGo + (size_t)(row0 + ai * 128 + m * 16) * SW + col, acc[ai][0][m][0] * sigmoid4(acc[ai][1][m][0]), acc[ai][0][m][1] * sigmoid4(acc[ai][1][m][1]));
    }
};
struct EpiUp {
    static constexpr bool PERM = true;
    const bf16_t* gate; bf16_t* tmp; bf16_t* Y; bool second;
    __device__ __forceinline__ void operator()(const f32x4 (&acc)[2][2][4][2], const pg8::Unit& u, int wr, int wc, int fr, int fq) const {
        const int row0 = u.pm * 256 + wr * 64 + fr, col0 = u.pn * 256 + wc * 32 + 8 * fq;
#pragma unroll
        for (int ai = 0; ai < 2; ++ai)
#pragma unroll
            for (int m = 0; m < 4; ++m)
#pragma unroll
                for (int bj = 0; bj < 2; ++bj) {
                    const size_t off = (size_t)(row0 + ai * 128 + m * 16) * DM + col0 + bj * 128;
                    f32x4 g0, g1; load8(gate + off, g0, g1);
                    f32x4 v0 = g0 * acc[ai][bj][m][0], v1 = g1 * acc[ai][bj][m][1];
                    if (second) { f32x4 t0, t1; load8(tmp + off, t0, t1); store8(Y + off, v0 + t0, v1 + t1); }
                    else store8(tmp + off, v0, v1);
                }
    }
};
struct EpiWo {
    static constexpr bool PERM = false;
    const bf16_t* H0; float* R1;
    __device__ __forceinline__ void operator()(const f32x4 (&acc)[2][2][4][2], const pg8::Unit& u, int wr, int wc, int fr, int fq) const {
        const int row0 = u.pm * 256 + wr * 64 + fr, col0 = u.pn * 256 + wc * 32 + 4 * fq;
#pragma unroll
        for (int ai = 0; ai < 2; ++ai)
#pragma unroll
            for (int m = 0; m < 4; ++m)
#pragma unroll
                for (int bj = 0; bj < 2; ++bj)
#pragma unroll
                    for (int n = 0; n < 2; ++n) {
                        const size_t off = (size_t)(row0 + ai * 128 + m * 16) * DM + col0 + bj * 128 + n * 16;
                        const u32x2 w = *(const u32x2*)(H0 + off);
                        const f32x4 h = (f32x4){bf2f(w.x & 0xffffu), bf2f(w.x >> 16), bf2f(w.y & 0xffffu), bf2f(w.y >> 16)};
                        *(f32x4*)(R1 + off) = h * ALPHA + acc[ai][bj][m][n];
                    }
    }
};
struct EpiMoe1 {
    static constexpr bool PERM = true;
    const float* bgu; bf16_t* ACT;
    __device__ __forceinline__ void operator()(const f32x4 (&acc)[2][2][4][2], const pg8::Unit& u, int wr, int wc, int fr, int fq) const {
        const int row0 = u.pm * 256 + wr * 64 + fr, col = u.pn * 128 + wc * 32 + 8 * fq;
        const float* bp = bgu + (size_t)u.ex * 2 * DE + col;
        const f32x4 bg0 = *(const f32x4*)bp, bg1 = *(const f32x4*)(bp + 4), bl0 = *(const f32x4*)(bp + DE), bl1 = *(const f32x4*)(bp + DE + 4);
#pragma unroll
        for (int ai = 0; ai < 2; ++ai)
#pragma unroll
            for (int m = 0; m < 4; ++m) {
                f32x4 o[2];
#pragma unroll
                for (int n = 0; n < 2; ++n) {
                    const f32x4 gv = acc[ai][0][m][n] + (n ? bg1 : bg0), lv = acc[ai][1][m][n] + (n ? bl1 : bl0);
#pragma unroll
                    for (int j = 0; j < 4; ++j) { const float gg = fminf(gv[j], SWIGLU_LIMIT), ll = fminf(fmaxf(lv[j], -SWIGLU_LIMIT), SWIGLU_LIMIT); o[n][j] = gg * sigmoid_f(SWIGLU_ALPHA * gg) * (ll + 1.f); }
                }
                store8(ACT + (size_t)(row0 + ai * 128 + m * 16) * DE + col, o[0], o[1]);
            }
    }
};
struct EpiMoe2 {
    static constexpr bool PERM = true;
    const float* bd; bf16_t* OUTS;
    __device__ __forceinline__ void operator()(const f32x4 (&acc)[2][2][4][2], const pg8::Unit& u, int wr, int wc, int fr, int fq) const {
        const int row0 = u.pm * 256 + wr * 64 + fr, col0 = u.pn * 256 + wc * 32 + 8 * fq;
#pragma unroll
        for (int bj = 0; bj < 2; ++bj) {
            const float* bp = bd + (size_t)u.ex * DM + col0 + bj * 128;
            const f32x4 b0 = *(const f32x4*)bp, b1 = *(const f32x4*)(bp + 4);
#pragma unroll
            for (int ai = 0; ai < 2; ++ai)
#pragma unroll
                for (int m = 0; m < 4; ++m)
                    store8(OUTS + (size_t)(row0 + ai * 128 + m * 16) * DM + col0 + bj * 128, acc[ai][bj][m][0] + b0, acc[ai][bj][m][1] + b1);
        }
    }
};
struct MoeOrder {
    pg8::StaticOrder so; const LAS int* ps; const LAS unsigned* tokl; int bt_per_e;
    __device__ __forceinline__ bool next(int i, pg8::Unit& u) const {
        if (!so.next(i, u)) return false;
        int e = 0; const int r0 = u.pm * 256;
#pragma unroll 1
        for (int k = 1; k < NE; ++k) e += (ps[k] <= r0) ? 1 : 0;
        e = __builtin_amdgcn_readfirstlane(e);
        u.ex = e; u.bn = e * bt_per_e + u.pn; return true;
    }
    __device__ __forceinline__ unsigned rowoff(int ui, int r) const { return tokl[ui * 256 + r]; }
};
__device__ __forceinline__ void ph_ln_in(const Frame& F) {
    const float* x = F.in[I_X]; const f32x4* g4 = (const f32x4*)F.in[I_LNIG]; const f32x4* b4 = (const f32x4*)F.in[I_LNIB];
    bf16_t* H0 = (bf16_t*)(F.ws + WS_H0);
    for (int m = F.gw; m < T; m += F.NGW) {
        const f32x4* xr = (const f32x4*)(x + (size_t)m * DM) + F.lane;
        f32x4 v[4]; float s = 0.f;
#pragma unroll
        for (int j = 0; j < 4; ++j) { v[j] = xr[64 * j]; s += (v[j][0] + v[j][1]) + (v[j][2] + v[j][3]); }
        const float mean = wave_sum(s) * (1.f / DM); float s2 = 0.f;
#pragma unroll
        for (int j = 0; j < 4; ++j) { v[j] = v[j] - mean; s2 += (v[j][0] * v[j][0] + v[j][1] * v[j][1]) + (v[j][2] * v[j][2] + v[j][3] * v[j][3]); }
        const float rstd = 1.f / sqrtf(wave_sum(s2) * (1.f / DM) + LN_EPS);
        u32x2* o = (u32x2*)(H0 + (size_t)m * DM) + F.lane;
#pragma unroll
        for (int j = 0; j < 4; ++j) { const f32x4 y = v[j] * rstd * g4[F.lane + 64 * j] + b4[F.lane + 64 * j]; u32x2 w; w.x = pk2(y[0], y[1]); w.y = pk2(y[2], y[3]); o[64 * j] = w; }
    }
}

struct CfgInProj {
    const bf16_t* H0; const float* W; const float* bgate; bf16_t *Q, *Kb, *V, *U, *GA, *GS;
    __device__ __forceinline__ const bf16_t* arow(int row) const { return H0 + (size_t)row * DM; }
    __device__ __forceinline__ const float* bptr(int) const { return W; }
    __device__ __forceinline__ int ldb() const { return INW; }
    __device__ __forceinline__ int K() const { return DM; }
    __device__ __forceinline__ void one(int row, int col, float v) const {
        if (col < 512) Q[(size_t)row * AW + col] = (bf16_t)f2bf(v * QSCALE);
        else if (col < 1024) Kb[(size_t)row * AW + col - 512] = (bf16_t)f2bf(v);
        else if (col < 1536) V[(size_t)row * AW + col - 1024] = (bf16_t)f2bf(v);
        else if (col < 2048) U[(size_t)row * SW + col - 1536] = (bf16_t)f2bf(v);
        else if (col < 3072) GA[(size_t)row * DM + col - 2048] = (bf16_t)f2bf(sigmoid_f(v + bgate[col - 2048]));
        else GS[(size_t)row * DM + col - 3072] = (bf16_t)f2bf(sigmoid_f(v + bgate[col - 2048]));
    }
    __device__ __forceinline__ void epi(int, int row, int col0, float v0, float v1) const { one(row, col0, v0); one(row, col0 + 16, v1); }
};
__device__ __forceinline__ void ph_inproj(const Frame& F) {
    CfgInProj c{(const bf16_t*)(F.ws + WS_H0), F.in[I_WIN], F.in[I_BGATE], (bf16_t*)(F.ws + WS_Q), (bf16_t*)(F.ws + WS_K), (bf16_t*)(F.ws + WS_V), (bf16_t*)(F.ws + WS_U),
                (bf16_t*)(F.ws + WS_GA), (bf16_t*)(F.ws + WS_GS)};
    constexpr int NTM = T / 128, NTN = INW / 128;
    for (int t = blockIdx.x; t < NTM * NTN; t += F.G) gemm_simple_tile<16>(F, c, t / NTN, t % NTN);
}

__device__ __forceinline__ void ph_attn_simple(const Frame& F) {
    const bf16_t* Q = (const bf16_t*)(F.ws + WS_Q); const bf16_t* Kb = (const bf16_t*)(F.ws + WS_K); const bf16_t* V = (const bf16_t*)(F.ws + WS_V);
    bf16_t* AO = (bf16_t*)(F.ws + WS_AO); const float* relb = F.in[I_RELB];
    const int lane = F.lane;
    for (int it = F.gw; it < T * NH; it += F.NGW) {
        const int m = it / NH, h = it % NH, b = m / SEQ, t = m % SEQ, n = t / CHUNK;
        const float q = bf2f(Q[(size_t)m * AW + h * HD + lane]);
        const int k0 = (n - LEFT) * CHUNK < 0 ? 0 : (n - LEFT) * CHUNK, k1 = n * CHUNK + CHUNK;
        float mx = -1e30f, l = 0.f, o = 0.f;
        for (int kp = k0; kp < k1; ++kp) {
            const size_t kr = (size_t)(b * SEQ + kp) * AW + h * HD + lane;
            float s = wave_sum(q * bf2f(Kb[kr]));
            int dist = t - kp; dist = dist < -(CHUNK - 1) ? -(CHUNK - 1) : (dist > RELMAX ? RELMAX : dist);
            s += relb[h * RELSIZE + dist + (CHUNK - 1)] * LOG2E;
            const float mn = fmaxf(mx, s), a = __builtin_amdgcn_exp2f(mx - mn), pp = __builtin_amdgcn_exp2f(s - mn);
            l = l * a + pp; o = o * a + pp * bf2f(V[kr]); mx = mn;
        }
        AO[(size_t)m * AW + h * HD + lane] = (bf16_t)f2bf(o / l);
    }
}

__device__ __forceinline__ void ph_ssm_simple(const Frame& F) {
    const bf16_t* U = (const bf16_t*)(F.ws + WS_U); bf16_t* GY = (bf16_t*)(F.ws + WS_GY);
    const int lane = F.lane;
    for (int it = F.gw; it < BATCH * NG; it += F.NGW) {
        const int b = it / NG, g = it % NG;
        const double lre = (double)F.in[I_LAMRE][g * NP + lane], lim = (double)F.in[I_LAMIM][g * NP + lane];
        const double dt = (double)expf(F.in[I_LOGDT][g]);
        const double er = (double)expf((float)(lre * dt));
        double sn, cs; sincos_d(lim * dt, sn, cs);
        const double lbr_d = er * cs, lbi_d = er * sn;
        const double nr = lbr_d - 1.0, ni = lbi_d, den = lre * lre + lim * lim;
        const double cr = (nr * lre + ni * lim) / den, ci = (ni * lre - nr * lim) / den;
        const float lbr = (float)lbr_d, lbi = (float)lbi_d;
        float Bre[GSZ], Bim[GSZ], Cre[GSZ], Cim[GSZ];
#pragma unroll
        for (int c = 0; c < GSZ; ++c) {
            const double br = (double)F.in[I_BRE][(g * NP + lane) * GSZ + c], bi = (double)F.in[I_BIM][(g * NP + lane) * GSZ + c];
            Bre[c] = (float)(cr * br - ci * bi); Bim[c] = (float)(cr * bi + ci * br);
            Cre[c] = F.in[I_CRE][(g * GSZ + c) * NP + lane]; Cim[c] = F.in[I_CIM][(g * GSZ + c) * NP + lane];
        }
        const float dsk = F.in[I_SSMD][g * GSZ + (lane & 15)];
        float xr = 0.f, xi = 0.f;
        for (int t = 0; t < SEQ; ++t) {
            const bf16_t* up = U + (size_t)(b * SEQ + t) * SW + g * GSZ;
            const u32x4 u0 = *(const u32x4*)up, u1 = *(const u32x4*)(up + 8);
            float u[GSZ];
#pragma unroll
            for (int i = 0; i < 4; ++i) { u[2 * i] = bf2f(u0[i] & 0xffffu); u[2 * i + 1] = bf2f(u0[i] >> 16); u[8 + 2 * i] = bf2f(u1[i] & 0xffffu); u[8 + 2 * i + 1] = bf2f(u1[i] >> 16); }
            float br = 0.f, bi = 0.f;
#pragma unroll
            for (int c = 0; c < GSZ; ++c) { br += Bre[c] * u[c]; bi += Bim[c] * u[c]; }
            const float nxr = lbr * xr - lbi * xi + br, nxi = lbr * xi + lbi * xr + bi; xr = nxr; xi = nxi;
            float yv = 0.f, uv = 0.f;
#pragma unroll
            for (int c = 0; c < GSZ; ++c) { const float part = wave_sum(Cre[c] * xr - Cim[c] * xi); if ((lane & 15) == c) { yv = part; uv = u[c]; } }
            yv += dsk * uv;
            if (lane < GSZ) GY[(size_t)(b * SEQ + t) * SW + g * GSZ + lane] = (bf16_t)f2bf(gelu_tanh(yv));
        }
    }
}


typedef float f32x16 __attribute__((ext_vector_type(16)));
__device__ __forceinline__ void ph_attn_fast_b(const Frame& F, int bid) {
    const bf16_t* Q = (const bf16_t*)(F.ws + WS_Q); const bf16_t* Kb = (const bf16_t*)(F.ws + WS_K); const bf16_t* VT = (const bf16_t*)(F.ws + WS_VT);
    bf16_t* AO = (bf16_t*)(F.ws + WS_AO);
    LAS float* bl = (LAS float*)(F.lds + TOKL_OFF);
    for (int i = F.tid; i < NH * RELSIZE; i += 512) bl[i] = F.in[I_RELB][i] * LOG2E;
    const int lane = F.lane, r32 = lane & 31, hi = lane >> 5, hl = F.wave >> 1, qb = F.wave & 1;
    const int srow = (F.tid >> 3) & 63, sq = F.tid & 7;
    const int sdst = srow * 128 + ((sq ^ ((srow >> 1) & 7)) * 16);
    int koff[2][4], voff[2][4];
#pragma unroll
    for (int blk = 0; blk < 2; ++blk)
#pragma unroll
        for (int x = 0; x < 4; ++x) { const int row = blk * 32 + r32, q = 2 * x + hi; koff[blk][x] = row * 128 + ((q ^ ((row >> 1) & 7)) * 16); voff[blk][x] = koff[blk][x]; }
    for (int unit = bid; unit < BATCH * NCH * 2; unit += F.G) {
        const int bn = unit >> 1, b = bn / NCH, n = bn % NCH, hh = unit & 1;
        const int h = hh * 4 + hl;
        const size_t qtok = (size_t)b * SEQ + n * CHUNK + qb * 32 + r32;
        bf16x8 qf[4];
#pragma unroll
        for (int ds = 0; ds < 4; ++ds) qf[ds] = *(const bf16x8*)(Q + qtok * AW + h * HD + ds * 16 + hi * 8);
        f32x16 o[2];
#pragma unroll
        for (int r = 0; r < 16; ++r) { o[0][r] = 0.f; o[1][r] = 0.f; }
        float mrun = -1.0e30f, lrun = 0.f;
        const LAS char* blh = (const LAS char*)(bl + h * RELSIZE);
        const int qpos = qb * 32 + r32;
        const int c0 = (n < LEFT ? n : LEFT);
        const bf16_t* ksrc = Kb + ((size_t)b * SEQ + srow) * AW + (hh * 4) * HD + sq * 8;
        const bf16_t* vsrc = VT + ((size_t)(b * NH + hh * 4) * HD + srow) * SEQ + sq * 8;
        u32x4 st[8];
#define ATT_LOAD(kc_) do { _Pragma("unroll") for (int i = 0; i < 4; ++i) { st[i] = *(const u32x4*)(ksrc + (size_t)(kc_) * CHUNK * AW + i * HD); st[4 + i] = *(const u32x4*)(vsrc + (size_t)(kc_) * CHUNK + (size_t)i * HD * SEQ); } } while (0)
#define ATT_STORE(buf_) do { _Pragma("unroll") for (int i = 0; i < 4; ++i) { *(LAS u32x4*)(F.lds + (buf_) * 65536 + i * 16384 + sdst) = st[i]; *(LAS u32x4*)(F.lds + (buf_) * 65536 + i * 16384 + 8192 + sdst) = st[4 + i]; } } while (0)
        __syncthreads();
        ATT_LOAD(n - c0); ATT_STORE(0);
        __syncthreads();
        int buf = 0;
        for (int c = c0; c >= 0; --c, buf ^= 1) {
            const int kc = n - c;
            if (c > 0) ATT_LOAD(kc + 1);
            const LAS unsigned char* kt = F.lds + buf * 65536 + hl * 16384; const LAS unsigned char* vt = kt + 8192;
            f32x16 s[2];
#pragma unroll
            for (int kb = 0; kb < 2; ++kb) {
#pragma unroll
                for (int r = 0; r < 16; ++r) s[kb][r] = 0.f;
#pragma unroll
                for (int ds = 0; ds < 4; ++ds) { const bf16x8 kf = *(const LAS bf16x8*)(kt + koff[kb][ds]); s[kb] = __builtin_amdgcn_mfma_f32_32x32x16_bf16(kf, qf[ds], s[kb], 0, 0, 0); }
            }
            if (c >= 5) { const float bc = *(const LAS float*)(blh + 319 * 4);
#pragma unroll
                for (int r = 0; r < 16; ++r) { s[0][r] += bc; s[1][r] += bc; } }
            else { const int base4 = (qpos + 64 * c + 63 - 4 * hi) * 4;
#pragma unroll
                for (int kb = 0; kb < 2; ++kb)
#pragma unroll
                    for (int r = 0; r < 16; ++r) { int off = base4 - 4 * (kb * 32 + (r & 3) + 8 * (r >> 2)); off = off < 319 * 4 ? off : 319 * 4; s[kb][r] += *(const LAS float*)(blh + off); } }
            float tm = fmaxf(s[0][0], s[1][0]);
#pragma unroll
            for (int r = 1; r < 16; ++r) tm = fmaxf(tm, fmaxf(s[0][r], s[1][r]));
            tm = fmaxf(tm, __shfl_xor(tm, 32));
            if (__any(tm > mrun + 8.f)) { const float mn = fmaxf(mrun, tm), f = __builtin_amdgcn_exp2f(mrun - mn); lrun *= f; mrun = mn;
#pragma unroll
                for (int r = 0; r < 16; ++r) { o[0][r] *= f; o[1][r] *= f; } }
            float ls = 0.f;
#pragma unroll
            for (int kb = 0; kb < 2; ++kb)
#pragma unroll
                for (int r = 0; r < 16; ++r) { const float p = __builtin_amdgcn_exp2f(s[kb][r] - mrun); ls += p; s[kb][r] = p; }
            lrun += ls;
#pragma unroll
            for (int kb = 0; kb < 2; ++kb)
#pragma unroll
                for (int s2 = 0; s2 < 2; ++s2) {
                    u32x4 pw; pw.x = pg8::cvt_pk_bf16(s[kb][8 * s2 + 0], s[kb][8 * s2 + 1]); pw.y = pg8::cvt_pk_bf16(s[kb][8 * s2 + 2], s[kb][8 * s2 + 3]);
                    pw.z = pg8::cvt_pk_bf16(s[kb][8 * s2 + 4], s[kb][8 * s2 + 5]); pw.w = pg8::cvt_pk_bf16(s[kb][8 * s2 + 6], s[kb][8 * s2 + 7]);
                    const bf16x8 pf = __builtin_bit_cast(bf16x8, pw);
                    const bf16x8 v0 = *(const LAS bf16x8*)(vt + voff[0][2 * kb + s2]), v1 = *(const LAS bf16x8*)(vt + voff[1][2 * kb + s2]);
                    o[0] = __builtin_amdgcn_mfma_f32_32x32x16_bf16(v0, pf, o[0], 0, 0, 0);
                    o[1] = __builtin_amdgcn_mfma_f32_32x32x16_bf16(v1, pf, o[1], 0, 0, 0);
                }
            if (c > 0) ATT_STORE(buf ^ 1);
            __syncthreads();
        }
#undef ATT_LOAD
#undef ATT_STORE
        lrun += __shfl_xor(lrun, 32);
        const float inv = 1.f / lrun;
        bf16_t* op = AO + qtok * AW + h * HD + 4 * hi;
#pragma unroll
        for (int db = 0; db < 2; ++db)
#pragma unroll
            for (int g4 = 0; g4 < 4; ++g4) { u32x2 w; w.x = pg8::cvt_pk_bf16(o[db][4 * g4] * inv, o[db][4 * g4 + 1] * inv); w.y = pg8::cvt_pk_bf16(o[db][4 * g4 + 2] * inv, o[db][4 * g4 + 3] * inv);
                *(u32x2*)(op + db * 32 + 8 * g4) = w; }
    }
    __syncthreads();
}

typedef float f32x2 __attribute__((ext_vector_type(2)));
__device__ __forceinline__ f32x2 cmul(f32x2 a, f32x2 b) { return (f32x2){a.x * b.x - a.y * b.y, a.x * b.y + a.y * b.x}; }
__device__ __forceinline__ void ssm_coef(const Frame& F, int g, int p, double& lre, double& lim, double& dt, double& cr, double& ci) {
    lre = (double)F.in[I_LAMRE][g * NP + p]; lim = (double)F.in[I_LAMIM][g * NP + p]; dt = (double)expf(F.in[I_LOGDT][g]);
    const double y = lre * dt;
    double em = 1.0, term = 1.0;
#pragma unroll
    for (int k = 1; k <= 14; ++k) { term = term * y / (double)k; em += term; }
    double sn, cs; sincos_d(lim * dt, sn, cs);
    const double nr = em * cs - 1.0, ni = em * sn, den = lre * lre + lim * lim;
    cr = (nr * lre + ni * lim) / den; ci = (ni * lre - nr * lim) / den;
}
__device__ __forceinline__ f32x2 lam_pow(double lre, double lim, double dt, double k) {
    const float mag = expf((float)(lre * dt * k)); double sn, cs; sincos_d(lim * dt * k, sn, cs);
    return (f32x2){mag * (float)cs, mag * (float)sn};
}
__device__ __forceinline__ void ph_ssm_tables(const Frame& F) {
    f32x2* LP = (f32x2*)(F.ws + WS_LP); f32x2* LLP = (f32x2*)(F.ws + WS_LLP);
    bf16_t* WsT = (bf16_t*)(F.ws + WS_WST); bf16_t* KdT = (bf16_t*)(F.ws + WS_KDT); bf16_t* Cint = (bf16_t*)(F.ws + WS_CINT);
    const int gt = blockIdx.x * 512 + F.tid, NT = F.G * 512;
    for (int it = gt; it < NG * (65 + 128) * NP; it += NT) {
        const int p = it % NP, q = (it / NP) % (65 + 128), g = it / (NP * (65 + 128));
        const double lre = (double)F.in[I_LAMRE][g * NP + p], lim = (double)F.in[I_LAMIM][g * NP + p], dt = (double)expf(F.in[I_LOGDT][g]);
        if (q < 65) LP[(g * 65 + q) * NP + p] = lam_pow(lre, lim, dt, (double)q);
        else LLP[(g * 128 + (q - 65)) * NP + p] = lam_pow(lre, lim, dt, 64.0 * (double)(q - 65));
    }
    for (int it = gt; it < NG * GSZ * NP; it += NT) {
        const int p = it % NP, c = (it / NP) % GSZ, g = it / (NP * GSZ);
        ((unsigned*)Cint)[(g * GSZ + c) * NP + p] = pk2(F.in[I_CRE][(g * GSZ + c) * NP + p], -F.in[I_CIM][(g * GSZ + c) * NP + p]);
    }
    for (int it = gt; it < NG * NP * 64; it += NT) {
        const int j = it & 63, p = (it >> 6) % NP, g = it / (64 * NP);
        double lre, lim, dt, cr, ci; ssm_coef(F, g, p, lre, lim, dt, cr, ci);
        const f32x2 pw = lam_pow(lre, lim, dt, (double)(63 - j));
        const float crf = (float)cr, cif = (float)ci;
        bf16_t* o0 = WsT + ((size_t)(g * 128 + 2 * p) * 1024 + j * 16); bf16_t* o1 = o0 + 1024;
        const f32x4* br4 = (const f32x4*)(F.in[I_BRE] + (g * NP + p) * GSZ); const f32x4* bi4 = (const f32x4*)(F.in[I_BIM] + (g * NP + p) * GSZ);
#pragma unroll 1
        for (int c4 = 0; c4 < 4; ++c4) {
            const f32x4 br = br4[c4], bi = bi4[c4];
            float re[4], im[4];
#pragma unroll
            for (int k = 0; k < 4; ++k) { const f32x2 v = cmul(pw, (f32x2){crf * br[k] - cif * bi[k], crf * bi[k] + cif * br[k]}); re[k] = v.x; im[k] = v.y; }
            *(u32x2*)(o0 + c4 * 4) = (u32x2){pk2(re[0], re[1]), pk2(re[2], re[3])};
            *(u32x2*)(o1 + c4 * 4) = (u32x2){pk2(im[0], im[1]), pk2(im[2], im[3])};
        }
    }
    LAS f32x2* Ew = (LAS f32x2*)(F.lds + F.wave * 16384);
    for (int it = F.gw; it < NG * 64; it += F.NGW) {
        const int d = it & 63, g = it >> 6, p = F.lane;
        double lre, lim, dt, cr, ci; ssm_coef(F, g, p, lre, lim, dt, cr, ci);
        const f32x2 pw = lam_pow(lre, lim, dt, (double)d);
        { const float crf = (float)cr, cif = (float)ci;
#pragma unroll 4
          for (int c = 0; c < GSZ; ++c) {
            const float br = F.in[I_BRE][(g * NP + p) * GSZ + c], bi = F.in[I_BIM][(g * NP + p) * GSZ + c];
            Ew[p * GSZ + c] = cmul(pw, (f32x2){crf * br - cif * bi, crf * bi + cif * br});
          } }
        asm volatile("s_waitcnt lgkmcnt(0)" ::: "memory");
        const int c = F.lane >> 2, ci0 = (F.lane & 3) * 4;
        const float* cre = F.in[I_CRE] + (g * GSZ + c) * NP; const float* cim = F.in[I_CIM] + (g * GSZ + c) * NP;
        float acc[4] = {0.f, 0.f, 0.f, 0.f};
        for (int pp = 0; pp < NP; ++pp) {
            const float a = cre[pp], bq = cim[pp];
#pragma unroll
            for (int k = 0; k < 4; ++k) { const f32x2 e = Ew[pp * GSZ + ci0 + k]; acc[k] += a * e.x - bq * e.y; }
        }
        if (d == 0) {
#pragma unroll
            for (int k = 0; k < 4; ++k) if (ci0 + k == c) acc[k] += F.in[I_SSMD][g * GSZ + c];
        }
        *(u32x2*)(KdT + ((size_t)((g * 64 + d) * GSZ + c)) * GSZ + ci0) = (u32x2){pk2(acc[0], acc[1]), pk2(acc[2], acc[3])};
        asm volatile("s_waitcnt lgkmcnt(0)" ::: "memory");
    }
}
__device__ __forceinline__ void ph_ssm_xe(const Frame& F, int unit) {
    const int b = unit / (NG * 4), g = (unit >> 2) % NG, qtr = unit & 3, n0 = qtr * 32;
    const bf16_t* WsT = (const bf16_t*)(F.ws + WS_WST) + (size_t)g * 128 * 1024;
    const int lane = F.lane, w = F.wave, fr = lane & 15, fq = lane >> 4;
    const bf16_t* bp = WsT + (size_t)fr * 1024 + w * 128 + fq * 8;
    const bf16_t* ap = (const bf16_t*)(F.ws + WS_UG) + (((size_t)(b * NG + g) * SEQ + (size_t)(n0 + fr) * CHUNK + 8 * w + (fq >> 1)) << 4) + (fq & 1) * 8;
    bf16x8 af[4][2], bfr[4][8];
#pragma unroll
    for (int ksl = 0; ksl < 4; ++ksl) {
#pragma unroll
        for (int rb = 0; rb < 2; ++rb) af[ksl][rb] = *(const bf16x8*)(ap + (size_t)(rb * 16 * CHUNK + 2 * ksl) * 16);
#pragma unroll
        for (int cb = 0; cb < 8; ++cb) bfr[ksl][cb] = *(const bf16x8*)(bp + (size_t)cb * 16 * 1024 + ksl * 32);
    }
    f32x4 acc[2][8];
#pragma unroll
    for (int rb = 0; rb < 2; ++rb)
#pragma unroll
        for (int cb = 0; cb < 8; ++cb) acc[rb][cb] = (f32x4){0.f, 0.f, 0.f, 0.f};
#pragma unroll
    for (int ksl = 0; ksl < 4; ++ksl)
#pragma unroll
        for (int rb = 0; rb < 2; ++rb)
#pragma unroll
            for (int cb = 0; cb < 8; ++cb) acc[rb][cb] = __builtin_amdgcn_mfma_f32_16x16x32_bf16(af[ksl][rb], bfr[ksl][cb], acc[rb][cb], 0, 0, 0);
    LAS float* P = (LAS float*)F.lds;
    __syncthreads();
#pragma unroll
    for (int rb = 0; rb < 2; ++rb)
#pragma unroll
        for (int cb = 0; cb < 8; ++cb)
#pragma unroll
            for (int r = 0; r < 4; ++r) P[(w * 32 + rb * 16 + fq * 4 + r) * 128 + cb * 16 + fr] = acc[rb][cb][r];
    __syncthreads();
    float red[8];
#pragma unroll
    for (int i = 0; i < 8; ++i) { const int o = F.tid + 512 * i; float s = 0.f;
#pragma unroll
        for (int ww = 0; ww < 8; ++ww) s += P[ww * 4096 + o];
        red[i] = s; }
    __syncthreads();
#pragma unroll
    for (int i = 0; i < 8; ++i) P[F.tid + 512 * i] = red[i];
    __syncthreads();
    if (F.tid < NP) {
        const int p = F.tid;
        const f32x2 lamL = ((const f32x2*)(F.ws + WS_LP))[(g * 65 + 64) * NP + p];
        f32x2* XSL = (f32x2*)(F.ws + WS_XSL); f32x2* UEND = (f32x2*)(F.ws + WS_UEND);
        f32x2 s = (f32x2){0.f, 0.f};
        for (int i = 0; i < 32; ++i) {
            XSL[((size_t)(b * NCH + n0 + i) * NG + g) * NP + p] = s;
            const f32x2 xe = (f32x2){P[i * 128 + 2 * p], P[i * 128 + 2 * p + 1]};
            s = cmul(lamL, s) + xe;
        }
        UEND[((size_t)(b * 4 + qtr) * NG + g) * NP + p] = s;
    }
    __syncthreads();
}
__device__ __forceinline__ void ph_ssm_out(const Frame& F) {
    const bf16_t* U = (const bf16_t*)(F.ws + WS_U); bf16_t* GY = (bf16_t*)(F.ws + WS_GY);
    const f32x2* LP = (const f32x2*)(F.ws + WS_LP); const f32x2* LLP = (const f32x2*)(F.ws + WS_LLP);
    const bf16_t* KdT = (const bf16_t*)(F.ws + WS_KDT); const bf16_t* Cint = (const bf16_t*)(F.ws + WS_CINT);
    const f32x2* XSL = (const f32x2*)(F.ws + WS_XSL); const f32x2* UEND = (const f32x2*)(F.ws + WS_UEND);
    constexpr int USTR = 1040;
    LAS unsigned char* UL = F.lds; LAS f32x2* xsl = (LAS f32x2*)(F.lds + 64 * USTR) + F.wave * NP;
    const int lane = F.lane, w = F.wave, fr = lane & 15, fq = lane >> 4;
    for (int unit = blockIdx.x; unit < BATCH * NCH; unit += F.G) {
        const int b = unit / NCH, n = unit % NCH, qtr = n >> 5, ni = n & 31;
        __syncthreads();
        for (int idx = F.tid; idx < 64 * 64; idx += 512) { const int row = idx >> 6, c16 = idx & 63;
            *(LAS u32x4*)(UL + row * USTR + c16 * 16) = *(const u32x4*)(U + ((size_t)b * SEQ + n * CHUNK + row) * SW + c16 * 8); }
        __syncthreads();
#pragma unroll 1
        for (int gi = 0; gi < 4; ++gi) {
            const int g = gi * 8 + w;
            {
                f32x2 xs = XSL[((size_t)(b * NCH + n) * NG + g) * NP + lane];
                if (qtr > 0) { f32x2 carry = (f32x2){0.f, 0.f};
                    for (int q = 0; q < qtr; ++q) carry += cmul(LLP[(g * 128 + 32 * (qtr - 1 - q)) * NP + lane], UEND[((size_t)(b * 4 + q) * NG + g) * NP + lane]);
                    xs += cmul(LLP[(g * 128 + ni) * NP + lane], carry); }
                xsl[lane] = xs;
            }
            f32x4 acc[4];
#pragma unroll
            for (int rb = 0; rb < 4; ++rb) acc[rb] = (f32x4){0.f, 0.f, 0.f, 0.f};
#pragma unroll
            for (int ks = 0; ks < 4; ++ks) {
                const bf16x8 cf = *(const bf16x8*)(Cint + (size_t)(g * GSZ + fr) * 128 + ks * 32 + fq * 8);
                const LAS f32x4* xp = (const LAS f32x4*)(xsl + ks * 16 + 4 * fq);
                const f32x4 x01 = xp[0], x23 = xp[1];
#pragma unroll
                for (int rb = 0; rb < 4; ++rb) {
                    const f32x4* lp = (const f32x4*)(LP + (size_t)(g * 65 + rb * 16 + fr + 1) * NP + ks * 16 + 4 * fq);
                    const f32x4 l01 = lp[0], l23 = lp[1];
                    u32x4 zw;
                    zw.x = pg8::cvt_pk_bf16(l01[0] * x01[0] - l01[1] * x01[1], l01[0] * x01[1] + l01[1] * x01[0]);
                    zw.y = pg8::cvt_pk_bf16(l01[2] * x01[2] - l01[3] * x01[3], l01[2] * x01[3] + l01[3] * x01[2]);
                    zw.z = pg8::cvt_pk_bf16(l23[0] * x23[0] - l23[1] * x23[1], l23[0] * x23[1] + l23[1] * x23[0]);
                    zw.w = pg8::cvt_pk_bf16(l23[2] * x23[2] - l23[3] * x23[3], l23[2] * x23[3] + l23[3] * x23[2]);
                    acc[rb] = __builtin_amdgcn_mfma_f32_16x16x32_bf16(cf, __builtin_bit_cast(bf16x8, zw), acc[rb], 0, 0, 0);
                }
            }
#define SSM_LDKF(buf, kq_) do { _Pragma("unroll") for (int k8 = 0; k8 < 8; ++k8) kfb[buf][k8] = *(const bf16x8*)(KdT + ((size_t)((g * 64 + 2 * ((kq_) * 8 + k8) + (fq >> 1)) * GSZ + fr)) * GSZ + (fq & 1) * 8); } while (0)
            bf16x8 kfb[2][8];
            SSM_LDKF(0, 0);
            const LAS unsigned char* ub = UL + g * 32 + (fq & 1) * 16;
#pragma unroll
            for (int kq = 0; kq < 4; ++kq) {
                if (kq < 3) SSM_LDKF((kq + 1) & 1, kq + 1);
#pragma unroll
                for (int k8 = 0; k8 < 8; ++k8) {
                    const int ks = kq * 8 + k8;
                    const bf16x8 kf = kfb[kq & 1][k8];
#pragma unroll
                    for (int rb = kq; rb < 4; ++rb) {
                        const int src = rb * 16 + fr - 2 * ks - (fq >> 1);
                        bf16x8 af = *(const LAS bf16x8*)(ub + (src < 0 ? 0 : src) * USTR);
                        if (rb == kq) { if (src < 0) af = (bf16x8){0, 0, 0, 0, 0, 0, 0, 0}; }
                        acc[rb] = __builtin_amdgcn_mfma_f32_16x16x32_bf16(kf, af, acc[rb], 0, 0, 0);
                    }
                }
            }
#undef SSM_LDKF
#pragma unroll
            for (int rb = 0; rb < 4; ++rb) {
                u32x2 o; o.x = pg8::cvt_pk_bf16(gelu_tanh(acc[rb][0]), gelu_tanh(acc[rb][1])); o.y = pg8::cvt_pk_bf16(gelu_tanh(acc[rb][2]), gelu_tanh(acc[rb][3]));
                *(u32x2*)(GY + ((size_t)b * SEQ + n * CHUNK + rb * 16 + fr) * SW + g * GSZ + 4 * fq) = o;
            }
        }
    }
    __syncthreads();
}

__device__ __forceinline__ void ph_ssm_out2(const Frame& F) {
    const bf16_t* UG = (const bf16_t*)(F.ws + WS_UG); bf16_t* GY = (bf16_t*)(F.ws + WS_GY);
    const f32x2* LP = (const f32x2*)(F.ws + WS_LP); const f32x2* LLP = (const f32x2*)(F.ws + WS_LLP);
    const bf16_t* KdT = (const bf16_t*)(F.ws + WS_KDT); const bf16_t* Cint = (const bf16_t*)(F.ws + WS_CINT);
    const f32x2* XSL = (const f32x2*)(F.ws + WS_XSL); const f32x2* UEND = (const f32x2*)(F.ws + WS_UEND);
    constexpr int KDL = 0, LPL = 32768, LPS = 528, CIL = 66560, CIS = 272, WV = 71168, WVS = 2560;
    const int lane = F.lane, w = F.wave, fr = lane & 15, fq = lane >> 4;
    LAS unsigned char* usl = F.lds + WV + w * WVS; LAS f32x2* xsl = (LAS f32x2*)(usl + 2048);
    for (int vb = blockIdx.x; vb < 256; vb += F.G) {
        const int g = vb & 31, set = vb >> 5;
        __syncthreads();
#pragma unroll
        for (int i = 0; i < 4; ++i) { const int idx = F.tid + 512 * i;
            *(LAS u32x4*)(F.lds + KDL + idx * 16) = ((const u32x4*)(KdT + (size_t)g * 64 * 256))[idx];
            const int row = idx >> 5, pc = idx & 31;
            *(LAS u32x4*)(F.lds + LPL + row * LPS + pc * 16) = ((const u32x4*)(LP + (size_t)(g * 65 + row + 1) * NP))[pc]; }
        if (F.tid < 256) { const int row = F.tid >> 4, pc = F.tid & 15; *(LAS u32x4*)(F.lds + CIL + row * CIS + pc * 16) = ((const u32x4*)(Cint + (size_t)(g * GSZ + row) * 128))[pc]; }
        __syncthreads();
        const LAS unsigned char* kdl = F.lds + KDL + ((fq >> 1) * 16 + fr) * 32 + (fq & 1) * 16;
        bf16x8 kf[16];
#pragma unroll
        for (int ks = 0; ks < 16; ++ks) kf[ks] = *(const LAS bf16x8*)(kdl + ks * 1024);
        const int q0 = set * 32 + w * 4, b = q0 >> 7, nb = q0 & 127, qtr = nb >> 5;
        f32x2 carry = (f32x2){0.f, 0.f};
        for (int q = 0; q < qtr; ++q) carry += cmul(LLP[(g * 128 + 32 * (qtr - 1 - q)) * NP + lane], UEND[((size_t)(b * 4 + q) * NG + g) * NP + lane]);
        const u32x4* up = (const u32x4*)(UG + (((size_t)(b * NG + g) * SEQ + (size_t)nb * CHUNK) << 4)) + lane;
        u32x4 u0 = up[0], u1 = up[64];
        f32x2 xs0 = XSL[((size_t)(b * NCH + nb) * NG + g) * NP + lane]; f32x2 ll0 = LLP[(g * 128 + (nb & 31)) * NP + lane];
#pragma unroll 1
        for (int it = 0; it < 4; ++it) {
            const int n = nb + it;
            asm volatile("s_waitcnt lgkmcnt(0)" ::: "memory");
            *(LAS u32x4*)(usl + lane * 16) = u0; *(LAS u32x4*)(usl + 1024 + lane * 16) = u1;
            xsl[lane] = xs0 + cmul(ll0, carry);
            asm volatile("s_waitcnt lgkmcnt(0)" ::: "memory");
            if (it < 3) { u0 = up[(it + 1) * 128]; u1 = up[(it + 1) * 128 + 64];
                xs0 = XSL[((size_t)(b * NCH + n + 1) * NG + g) * NP + lane]; ll0 = LLP[(g * 128 + ((n + 1) & 31)) * NP + lane]; }
            f32x4 acc[4];
#pragma unroll
            for (int rb = 0; rb < 4; ++rb) acc[rb] = (f32x4){0.f, 0.f, 0.f, 0.f};
#pragma unroll
            for (int ks = 0; ks < 4; ++ks) {
                const LAS f32x4* xp = (const LAS f32x4*)(xsl + ks * 16 + 4 * fq);
                const f32x4 x01 = xp[0], x23 = xp[1];
                const bf16x8 cfk = *(const LAS bf16x8*)(F.lds + CIL + fr * CIS + ks * 64 + fq * 16);
#pragma unroll
                for (int rb = 0; rb < 4; ++rb) {
                    const LAS f32x4* lp = (const LAS f32x4*)(F.lds + LPL + (rb * 16 + fr) * LPS + (ks * 16 + 4 * fq) * 8);
                    const f32x4 l01 = lp[0], l23 = lp[1];
                    u32x4 zw;
                    zw.x = pg8::cvt_pk_bf16(l01[0] * x01[0] - l01[1] * x01[1], l01[0] * x01[1] + l01[1] * x01[0]);
                    zw.y = pg8::cvt_pk_bf16(l01[2] * x01[2] - l01[3] * x01[3], l01[2] * x01[3] + l01[3] * x01[2]);
                    zw.z = pg8::cvt_pk_bf16(l23[0] * x23[0] - l23[1] * x23[1], l23[0] * x23[1] + l23[1] * x23[0]);
                    zw.w = pg8::cvt_pk_bf16(l23[2] * x23[2] - l23[3] * x23[3], l23[2] * x23[3] + l23[3] * x23[2]);
                    acc[rb] = __builtin_amdgcn_mfma_f32_16x16x32_bf16(cfk, __builtin_bit_cast(bf16x8, zw), acc[rb], 0, 0, 0);
                }
            }
            const LAS unsigned char* ub = usl + (fq & 1) * 16;
#pragma unroll
            for (int m = 0; m < 32; ++m) {
                const int srcr = 48 + fr - 2 * m - (fq >> 1);
                bf16x8 af = *(const LAS bf16x8*)(ub + (srcr < 0 ? 0 : srcr) * 32);
                if (m >= 24) { if (srcr < 0) af = (bf16x8){0, 0, 0, 0, 0, 0, 0, 0}; }
#pragma unroll
                for (int rb = 0; rb < 4; ++rb) { const int ks = m - 8 * (3 - rb); if (ks >= 0) { const bf16x8 kk = ks < 16 ? kf[ks < 0 ? 0 : (ks & 15)] : *(const LAS bf16x8*)(kdl + ks * 1024); acc[rb] = __builtin_amdgcn_mfma_f32_16x16x32_bf16(kk, af, acc[rb], 0, 0, 0); } }
            }
#pragma unroll
            for (int rb = 0; rb < 4; ++rb) {
                u32x2 o; o.x = pg8::cvt_pk_bf16(gelu_tanh(acc[rb][0]), gelu_tanh(acc[rb][1])); o.y = pg8::cvt_pk_bf16(gelu_tanh(acc[rb][2]), gelu_tanh(acc[rb][3]));
                *(u32x2*)(GY + ((size_t)b * SEQ + n * CHUNK + rb * 16 + fr) * SW + g * GSZ + 4 * fq) = o;
            }
        }
    }
    __syncthreads();
}
struct CfgGlu {
    const bf16_t* GY; const float* W; bf16_t* SGo;
    __device__ __forceinline__ const bf16_t* arow(int row) const { return GY + (size_t)row * SW; }
    __device__ __forceinline__ const float* bptr(int) const { return W; }
    __device__ __forceinline__ int ldb() const { return 2 * SW; }
    __device__ __forceinline__ int K() const { return SW; }
    __device__ __forceinline__ void epi(int, int row, int col0, float v0, float v1) const { SGo[(size_t)row * SW + col0] = (bf16_t)f2bf(v0 * sigmoid_f(v1)); }
};
__device__ __forceinline__ void ph_glu(const Frame& F) {
    CfgGlu c{(const bf16_t*)(F.ws + WS_GY), F.in[I_WGLU], (bf16_t*)(F.ws + WS_SG)};
    constexpr int NTM = T / 128, NTN = SW / 64;
    for (int t = blockIdx.x; t < NTM * NTN; t += F.G) gemm_simple_tile<SW>(F, c, t / NTN, t % NTN);
}

struct CfgUp {
    const bf16_t* A; const float* W; const bf16_t* gate; float* tmp; bf16_t* Y; bool second;
    __device__ __forceinline__ const bf16_t* arow(int row) const { return A + (size_t)row * 512; }
    __device__ __forceinline__ const float* bptr(int) const { return W; }
    __device__ __forceinline__ int ldb() const { return DM; }
    __device__ __forceinline__ int K() const { return 512; }
    __device__ __forceinline__ void one(int row, int col, float v) const {
        const size_t i = (size_t)row * DM + col; const float gv = bf2f(gate[i]) * v;
        if (!second) tmp[i] = gv; else Y[i] = (bf16_t)f2bf(tmp[i] + gv);
    }
    __device__ __forceinline__ void epi(int, int row, int col0, float v0, float v1) const { one(row, col0, v0); one(row, col0 + 16, v1); }
};
__device__ __forceinline__ void ph_up(const Frame& F, bool second) {
    CfgUp c{(const bf16_t*)(F.ws + (second ? WS_SG : WS_AO)), F.in[second ? I_WUS : I_WUA], (const bf16_t*)(F.ws + (second ? WS_GS : WS_GA)), (float*)(F.ws + WS_R1), (bf16_t*)(F.ws + WS_Y), second};
    constexpr int NTM = T / 128, NTN = DM / 128;
    for (int t = blockIdx.x; t < NTM * NTN; t += F.G) gemm_simple_tile<16>(F, c, t / NTN, t % NTN);
}

struct CfgWo {
    const bf16_t* Y; const float* W; const bf16_t* H0; float* R1;
    __device__ __forceinline__ const bf16_t* arow(int row) const { return Y + (size_t)row * DM; }
    __device__ __forceinline__ const float* bptr(int) const { return W; }
    __device__ __forceinline__ int ldb() const { return DM; }
    __device__ __forceinline__ int K() const { return DM; }
    __device__ __forceinline__ void one(int row, int col, float v) const { const size_t i = (size_t)row * DM + col; R1[i] = ALPHA * bf2f(H0[i]) + v; }
    __device__ __forceinline__ void epi(int, int row, int col0, float v0, float v1) const { one(row, col0, v0); one(row, col0 + 16, v1); }
};
__device__ __forceinline__ void ph_wo(const Frame& F) {
    CfgWo c{(const bf16_t*)(F.ws + WS_Y), F.in[I_WO], (const bf16_t*)(F.ws + WS_H0), (float*)(F.ws + WS_R1)};
    constexpr int NTM = T / 128, NTN = DM / 128;
    for (int t = blockIdx.x; t < NTM * NTN; t += F.G) gemm_simple_tile<16>(F, c, t / NTN, t % NTN);
}

__device__ __forceinline__ void ph_ln1_router(const Frame& F, bool commit) {
    const float* R1 = (const float*)(F.ws + WS_R1); bf16_t* H1 = (bf16_t*)(F.ws + WS_H1);
    const f32x4* g4 = (const f32x4*)F.in[I_LN1G]; const f32x4* b4 = (const f32x4*)F.in[I_LN1B];
    const float* rw = F.in[I_RW]; const float* rb = F.in[I_RB];
    int* TOPI = (int*)(F.ws + WS_TOPI); float* TOPG = (float*)(F.ws + WS_TOPG); int* TOK = (int*)(F.ws + WS_TOK);
    const int lane = F.lane;
    for (int i = blockIdx.x * 512 + F.tid; i < NROWS; i += F.G * 512) TOK[i] = T;
    if (blockIdx.x == 0) { for (int i = F.tid; i < DM / 2; i += 512) ((unsigned*)(H1 + (size_t)T * DM))[i] = 0u; }
    for (int m = F.gw; m < T; m += F.NGW) {
        const f32x4* xr = (const f32x4*)(R1 + (size_t)m * DM) + lane;
        f32x4 v[4]; float s = 0.f;
#pragma unroll
        for (int j = 0; j < 4; ++j) { v[j] = xr[64 * j]; s += (v[j][0] + v[j][1]) + (v[j][2] + v[j][3]); }
        const float mean = wave_sum(s) * (1.f / DM); float s2 = 0.f;
#pragma unroll
        for (int j = 0; j < 4; ++j) { v[j] = v[j] - mean; s2 += (v[j][0] * v[j][0] + v[j][1] * v[j][1]) + (v[j][2] * v[j][2] + v[j][3] * v[j][3]); }
        const float rstd = 1.f / sqrtf(wave_sum(s2) * (1.f / DM) + LN_EPS);
        u32x2* o = (u32x2*)(H1 + (size_t)m * DM) + lane;
        float lg[NE];
#pragma unroll
        for (int e = 0; e < NE; ++e) lg[e] = 0.f;
#pragma unroll
        for (int j = 0; j < 4; ++j) {
            const f32x4 y = v[j] * rstd * g4[lane + 64 * j] + b4[lane + 64 * j];
            u32x2 w; w.x = pk2(y[0], y[1]); w.y = pk2(y[2], y[3]); o[64 * j] = w;
            const float* wj = rw + (size_t)(256 * j + 4 * lane) * NE;
            asm volatile("" : "+v"(wj));
#pragma unroll
            for (int i = 0; i < 4; ++i) {
                const f32x4* wr4 = (const f32x4*)(wj + i * NE);
#pragma unroll
                for (int q = 0; q < 8; ++q) { const f32x4 ww = wr4[q]; lg[4 * q] += y[i] * ww[0]; lg[4 * q + 1] += y[i] * ww[1]; lg[4 * q + 2] += y[i] * ww[2]; lg[4 * q + 3] += y[i] * ww[3]; }
                asm volatile("" ::: "memory");
            }
        }
        float r16[16], r8[8], r4[4], r2[2], r1;
        { const bool hb = (lane & 32) != 0;
#pragma unroll
          for (int i = 0; i < 16; ++i) { const float keep = hb ? lg[i + 16] : lg[i], send = hb ? lg[i] : lg[i + 16]; r16[i] = keep + __shfl_xor(send, 32); } }
        { const bool hb = (lane & 16) != 0;
#pragma unroll
          for (int i = 0; i < 8; ++i) { const float keep = hb ? r16[i + 8] : r16[i], send = hb ? r16[i] : r16[i + 8]; r8[i] = keep + __shfl_xor(send, 16); } }
        { const bool hb = (lane & 8) != 0;
#pragma unroll
          for (int i = 0; i < 4; ++i) { const float keep = hb ? r8[i + 4] : r8[i], send = hb ? r8[i] : r8[i + 4]; r4[i] = keep + __shfl_xor(send, 8); } }
        { const bool hb = (lane & 4) != 0;
#pragma unroll
          for (int i = 0; i < 2; ++i) { const float keep = hb ? r4[i + 2] : r4[i], send = hb ? r4[i] : r4[i + 2]; r2[i] = keep + __shfl_xor(send, 4); } }
        { const bool hb = (lane & 2) != 0; const float keep = hb ? r2[1] : r2[0], send = hb ? r2[0] : r2[1]; r1 = keep + __shfl_xor(send, 2); }
        r1 += __shfl_xor(r1, 1);
        const int mye = (lane >> 1) & 31;
        float myv = r1 + rb[mye];
        float tv[TOPK]; int ti[TOPK];
#pragma unroll
        for (int k = 0; k < TOPK; ++k) {
            float bv = myv; int bi = mye;
#pragma unroll
            for (int o = 1; o < 64; o <<= 1) { const float ov = __shfl_xor(bv, o); const int oi = __shfl_xor(bi, o); if (ov > bv || (ov == bv && oi < bi)) { bv = ov; bi = oi; } }
            tv[k] = bv; ti[k] = bi; if (mye == bi) myv = -3.0e38f;
        }
        const float e1 = __expf(tv[1] - tv[0]), e2 = __expf(tv[2] - tv[0]), e3 = __expf(tv[3] - tv[0]);
        const float inv = 1.f / (1.f + e1 + e2 + e3);
        if (lane == 0 && commit) {
            TOPI[m * 4 + 0] = ti[0]; TOPI[m * 4 + 1] = ti[1]; TOPI[m * 4 + 2] = ti[2]; TOPI[m * 4 + 3] = ti[3];
            TOPG[m * 4 + 0] = inv; TOPG[m * 4 + 1] = e1 * inv; TOPG[m * 4 + 2] = e2 * inv; TOPG[m * 4 + 3] = e3 * inv;
#pragma unroll
            for (int k = 0; k < TOPK; ++k) atomicAdd(F.ctl + CW_COUNTS + ti[k], 1u);
        }
    }
}


__device__ __forceinline__ void ph_router_tables(const Frame& F) {
    const float* g = F.in[I_LN1G]; const float* bb = F.in[I_LN1B]; const float* rw = F.in[I_RW]; const float* rb = F.in[I_RB];
    float* GWp = (float*)(F.ws + WS_GWP); float* RC = (float*)(F.ws + WS_RC);
    for (int idx = blockIdx.x * 512 + F.tid; idx < 128 * 2 * 32 * 4; idx += F.G * 512) {
        const int j = idx & 3, e = (idx >> 2) & 31, kpar = (idx >> 7) & 1, i = idx >> 8, k = 8 * i + 4 * kpar + j;
        GWp[idx] = g[k] * rw[k * NE + e];
    }
    if (blockIdx.x == (F.G > 1 ? 1 : 0) && F.tid < NE) {
        float cs = 0.f, bw = 0.f;
        for (int k = 0; k < DM; ++k) { const float w = rw[k * NE + F.tid]; cs += g[k] * w; bw += bb[k] * w; }
        RC[F.tid] = cs; RC[NE + F.tid] = bw + rb[F.tid];
    }
}
typedef float f32x16r __attribute__((ext_vector_type(16)));
__device__ __forceinline__ void ph_router(const Frame& F) {
    const float* R1 = (const float*)(F.ws + WS_R1); bf16_t* H1 = (bf16_t*)(F.ws + WS_H1);
    const f32x4* g4 = (const f32x4*)F.in[I_LN1G]; const f32x4* b4 = (const f32x4*)F.in[I_LN1B];
    const float* GWp = (const float*)(F.ws + WS_GWP); const float* RC = (const float*)(F.ws + WS_RC);
    int* TOPI = (int*)(F.ws + WS_TOPI); float* TOPG = (float*)(F.ws + WS_TOPG); int* TOK = (int*)(F.ws + WS_TOK);
    int* HIST = (int*)(F.ws + WS_HIST); int* LRANK = (int*)(F.ws + WS_LRANK);
    LAS float* part = (LAS float*)F.lds;
    LAS float* stats = (LAS float*)(F.lds + 32768);
    const int lane = F.lane, w = F.wave;
    for (int i = blockIdx.x * 512 + F.tid; i < NROWS; i += F.G * 512) TOK[i] = T;
    if (blockIdx.x == 0) { for (int i = F.tid; i < DM / 2; i += 512) ((unsigned*)(H1 + (size_t)T * DM))[i] = 0u; }
    for (int tile = blockIdx.x; tile < T / 64; tile += F.G) {
        __syncthreads();
#pragma unroll 1
        for (int rr = 0; rr < 8; ++rr) {
            const int m = tile * 64 + rr * 8 + w;
            const f32x4* xr = (const f32x4*)(R1 + (size_t)m * DM) + lane;
            f32x4 v[4]; float s = 0.f;
#pragma unroll
            for (int j = 0; j < 4; ++j) { v[j] = xr[64 * j]; s += (v[j][0] + v[j][1]) + (v[j][2] + v[j][3]); }
            const float mean = wave_sum(s) * (1.f / DM); float s2 = 0.f;
#pragma unroll
            for (int j = 0; j < 4; ++j) { v[j] = v[j] - mean; s2 += (v[j][0] * v[j][0] + v[j][1] * v[j][1]) + (v[j][2] * v[j][2] + v[j][3] * v[j][3]); }
            const float rstd = 1.f / sqrtf(wave_sum(s2) * (1.f / DM) + LN_EPS);
            u32x2* o = (u32x2*)(H1 + (size_t)m * DM) + lane;
#pragma unroll
            for (int j = 0; j < 4; ++j) { const f32x4 y = v[j] * rstd * g4[lane + 64 * j] + b4[lane + 64 * j]; u32x2 ww; ww.x = pk2(y[0], y[1]); ww.y = pk2(y[2], y[3]); o[64 * j] = ww; }
            if (lane == 0) { stats[(rr * 8 + w) * 2] = mean; stats[(rr * 8 + w) * 2 + 1] = rstd; }
        }
        {
            const int mblk = w & 1, kq = w >> 1, r32 = lane & 31, kpar = lane >> 5;
            const float* ap = GWp + (size_t)((kq * 32) * 2 + kpar) * 128 + r32 * 4;
            const float* bp = R1 + (size_t)(tile * 64 + mblk * 32 + r32) * DM + kq * 256 + 4 * kpar;
            f32x16r acc;
#pragma unroll
            for (int r = 0; r < 16; ++r) acc[r] = 0.f;
#pragma unroll 4
            for (int i = 0; i < 32; ++i) {
                const f32x4 a4 = *(const f32x4*)(ap + i * 256), b4v = *(const f32x4*)(bp + i * 8);
#pragma unroll
                for (int j = 0; j < 4; ++j) acc = __builtin_amdgcn_mfma_f32_32x32x2f32(a4[j], b4v[j], acc, 0, 0, 0);
            }
#pragma unroll
            for (int r = 0; r < 16; ++r) part[((mblk * 4 + kq) * 32 + (r & 3) + 8 * (r >> 2) + 4 * kpar) * 32 + r32] = acc[r];
        }
        __syncthreads();
        if (w == 0) {
            const int mblk = lane >> 5, tl = lane & 31, m = tile * 64 + lane;
            const float mean = stats[lane * 2], rstd = stats[lane * 2 + 1];
            float lg[NE];
#pragma unroll
            for (int e = 0; e < NE; ++e) {
                const float raw = (part[((mblk * 4 + 0) * 32 + e) * 32 + tl] + part[((mblk * 4 + 1) * 32 + e) * 32 + tl]) + (part[((mblk * 4 + 2) * 32 + e) * 32 + tl] + part[((mblk * 4 + 3) * 32 + e) * 32 + tl]);
                lg[e] = rstd * (raw - mean * RC[e]) + RC[NE + e];
            }
            float tv[TOPK]; int ti[TOPK];
#pragma unroll
            for (int k = 0; k < TOPK; ++k) {
                float bv = -3.0e38f; int bi = 0;
#pragma unroll
                for (int e = 0; e < NE; ++e) if (lg[e] > bv) { bv = lg[e]; bi = e; }
                tv[k] = bv; ti[k] = bi;
#pragma unroll
                for (int e = 0; e < NE; ++e) if (e == bi) lg[e] = -3.0e38f;
            }
            const float e1 = __expf(tv[1] - tv[0]), e2 = __expf(tv[2] - tv[0]), e3 = __expf(tv[3] - tv[0]);
            const float inv = 1.f / (1.f + e1 + e2 + e3);
            int lr[TOPK] = {0, 0, 0, 0}; int mycnt = 0;
            const unsigned long long lt = (lane == 0) ? 0ull : (~0ull >> (64 - lane));
#pragma unroll 1
            for (int e = 0; e < NE; ++e) {
                int c = 0;
#pragma unroll
                for (int k = 0; k < TOPK; ++k) { const unsigned long long mk = __ballot(ti[k] == e); if (ti[k] == e) lr[k] = c + __popcll(mk & lt); c += __popcll(mk); }
                if (lane == e) mycnt = c;
            }
            *(int4*)(TOPI + m * 4) = make_int4(ti[0], ti[1], ti[2], ti[3]);
            *(float4*)(TOPG + m * 4) = make_float4(inv, e1 * inv, e2 * inv, e3 * inv);
            *(int4*)(LRANK + m * 4) = make_int4(lr[0], lr[1], lr[2], lr[3]);
            if (lane < NE) HIST[tile * NE + lane] = mycnt;
        }
    }
    __syncthreads();
}
__device__ __forceinline__ void ph_dest2(const Frame& F) {
    const int* HIST = (const int*)(F.ws + WS_HIST); const int* LRANK = (const int*)(F.ws + WS_LRANK); const int* TOPI = (const int*)(F.ws + WS_TOPI);
    int* DEST = (int*)(F.ws + WS_DEST); int* TOK = (int*)(F.ws + WS_TOK);
    LAS int* sumL = (LAS int*)F.lds; LAS int* ownL = sumL + 512; LAS int* totL = ownL + 512; LAS int* preL = totL + 32; LAS int* psL = preL + 32;
    constexpr int NTILE = T / 64;
    for (int tile = blockIdx.x; tile < NTILE; tile += F.G) {
        __syncthreads();
        { const int e = F.tid & 31, pt = F.tid >> 5; int s = 0, own = 0;
#pragma unroll 4
          for (int i = 0; i < NTILE / 16; ++i) { const int tt = pt * (NTILE / 16) + i; const int h = HIST[tt * NE + e]; s += h; own += (tt < tile) ? h : 0; }
          sumL[pt * 32 + e] = s; ownL[pt * 32 + e] = own; }
        __syncthreads();
        if (F.tid < 32) { int t = 0, p = 0;
#pragma unroll
            for (int pt = 0; pt < 16; ++pt) { t += sumL[pt * 32 + F.tid]; p += ownL[pt * 32 + F.tid]; }
            totL[F.tid] = t; preL[F.tid] = p; if (tile == 0) F.ctl[CW_COUNTS + F.tid] = (unsigned)t; }
        __syncthreads();
        if (F.tid == 0) { int acc = 0; for (int e = 0; e < NE; ++e) { psL[e] = acc; acc += ((totL[e] + EB - 1) / EB) * EB; } }
        __syncthreads();
        if (F.tid < 256) { const int a = tile * 256 + F.tid, e = TOPI[a], d = psL[e] + preL[e] + LRANK[a]; DEST[a] = d; TOK[d] = a >> 2; }
    }
    __syncthreads();
}
__device__ __forceinline__ void load_pstart(const Frame& F) {
    LAS int* ps = (LAS int*)(F.lds + PS_OFF);
    __syncthreads();
    if (F.tid == 0) { int acc = 0; for (int e = 0; e < NE; ++e) { ps[e] = acc; const int c = (int)__hip_atomic_load(F.ctl + CW_COUNTS + e, __ATOMIC_RELAXED, __HIP_MEMORY_SCOPE_AGENT); acc += ((c + EB - 1) / EB) * EB; } ps[NE] = acc; }
    __syncthreads();
}
__device__ __forceinline__ void ph_dest(const Frame& F) {
    load_pstart(F);
    const LAS int* ps = (const LAS int*)(F.lds + PS_OFF);
    const int* TOPI = (const int*)(F.ws + WS_TOPI); int* DEST = (int*)(F.ws + WS_DEST); int* TOK = (int*)(F.ws + WS_TOK);
    for (int a = blockIdx.x * 512 + F.tid; a < NASSIGN; a += F.G * 512) {
        const int e = TOPI[a]; const int pos = (int)atomicAdd(F.ctl + CW_CURSOR + e, 1u); const int d = ps[e] + pos;
        TOK[d] = a >> 2; DEST[a] = d;
    }
}

struct CfgMoe1 {
    const bf16_t* H1; const int* TOK; const float* W; const float* bgu; bf16_t* ACT; const LAS int* ps;
    __device__ __forceinline__ int expert(int tm) const { const int r0 = tm * 128; int e = 0;
#pragma unroll 1
        for (int i = 1; i < NE; ++i) e += (ps[i] <= r0) ? 1 : 0; return e; }
    __device__ __forceinline__ const bf16_t* arow(int row) const { return H1 + (size_t)TOK[row] * DM; }
    __device__ __forceinline__ const float* bptr(int tm) const { return W + (size_t)expert(tm) * DM * 2 * DE; }
    __device__ __forceinline__ int ldb() const { return 2 * DE; }
    __device__ __forceinline__ int K() const { return DM; }
    __device__ __forceinline__ void epi(int tm, int row, int col0, float v0, float v1) const {
        const int e = expert(tm);
        float g = v0 + bgu[e * 2 * DE + col0], l = v1 + bgu[e * 2 * DE + DE + col0];
        g = fminf(g, SWIGLU_LIMIT); l = fminf(fmaxf(l, -SWIGLU_LIMIT), SWIGLU_LIMIT);
        ACT[(size_t)row * DE + col0] = (bf16_t)f2bf(g * sigmoid_f(SWIGLU_ALPHA * g) * (l + 1.f));
    }
};
__device__ __forceinline__ void ph_moe1(const Frame& F) {
    load_pstart(F);
    const LAS int* ps = (const LAS int*)(F.lds + PS_OFF);
    CfgMoe1 c{(const bf16_t*)(F.ws + WS_H1), (const int*)(F.ws + WS_TOK), F.in[I_WGU], F.in[I_BGU], (bf16_t*)(F.ws + WS_ACT), ps};
    const int ntm = ps[NE] / 128; constexpr int NTN = DE / 64;
    for (int t = blockIdx.x; t < ntm * NTN; t += F.G) gemm_simple_tile<DE>(F, c, t / NTN, t % NTN);
}
struct CfgMoe2 {
    const bf16_t* ACT; const float* W; const float* bd; bf16_t* OUTS; const LAS int* ps;
    __device__ __forceinline__ int expert(int tm) const { const int r0 = tm * 128; int e = 0;
#pragma unroll 1
        for (int i = 1; i < NE; ++i) e += (ps[i] <= r0) ? 1 : 0; return e; }
    __device__ __forceinline__ const bf16_t* arow(int row) const { return ACT + (size_t)row * DE; }
    __device__ __forceinline__ const float* bptr(int tm) const { return W + (size_t)expert(tm) * DE * DM; }
    __device__ __forceinline__ int ldb() const { return DM; }
    __device__ __forceinline__ int K() const { return DE; }
    __device__ __forceinline__ void epi(int tm, int row, int col0, float v0, float v1) const {
        const int e = expert(tm);
        OUTS[(size_t)row * DM + col0] = (bf16_t)f2bf(v0 + bd[e * DM + col0]);
        OUTS[(size_t)row * DM + col0 + 16] = (bf16_t)f2bf(v1 + bd[e * DM + col0 + 16]);
    }
};
__device__ __forceinline__ void ph_moe2(const Frame& F) {
    load_pstart(F);
    const LAS int* ps = (const LAS int*)(F.lds + PS_OFF);
    CfgMoe2 c{(const bf16_t*)(F.ws + WS_ACT), F.in[I_WD], F.in[I_BD], (bf16_t*)(F.ws + WS_OUTS), ps};
    const int ntm = ps[NE] / 128; constexpr int NTN = DM / 128;
    for (int t = blockIdx.x; t < ntm * NTN; t += F.G) gemm_simple_tile<16>(F, c, t / NTN, t % NTN);
}


__device__ __forceinline__ void p0_transpose_item(const float* W, int K, int N, bf16_t* WT, bool paired, LAS float* scr, int item, int lane) {
    const int nblk = N / 32, kb = item / nblk, nb = item % nblk, k0 = 64 * kb, n0 = 32 * nb;
    int drow = n0;
    if (paired) { const int half = N >> 1, j = n0 % half; drow = (j >> 7) * 256 + (n0 / half) * 128 + (j & 127); }
#pragma unroll 8
    for (int i = 0; i < 32; ++i) { const int kk = 2 * i + (lane >> 5); scr[kk * 33 + (lane & 31)] = W[(size_t)(k0 + kk) * N + n0 + (lane & 31)]; }
    asm volatile("s_waitcnt lgkmcnt(0)" ::: "memory");
    const int c = lane & 7;
#pragma unroll
    for (int j = 0; j < 4; ++j) { const int n = (lane >> 3) + 8 * j; const LAS float* s = scr + (8 * c) * 33 + n;
        u32x4 o; o.x = pk2(s[0 * 33], s[1 * 33]); o.y = pk2(s[2 * 33], s[3 * 33]); o.z = pk2(s[4 * 33], s[5 * 33]); o.w = pk2(s[6 * 33], s[7 * 33]);
        *(u32x4*)(WT + (size_t)(drow + n) * K + k0 + 8 * c) = o; }
    asm volatile("s_waitcnt lgkmcnt(0)" ::: "memory");
}
__device__ __forceinline__ void ph_convert(const Frame& F) {
    LAS float* scr = (LAS float*)(F.lds + F.wave * 16384);
    constexpr int I_IN = (DM / 64) * (INW / 32), I_GLU = (SW / 64) * (2 * SW / 32), I_UP = (512 / 64) * (DM / 32), I_O = (DM / 64) * (DM / 32);
    constexpr int I_GU1 = (DM / 64) * (2 * DE / 32), I_D1 = (DE / 64) * (DM / 32);
    constexpr int NITEMS = I_IN + I_GLU + 2 * I_UP + I_O + NE * I_GU1 + NE * I_D1;
    for (int it = F.gw; it < NITEMS; it += F.NGW) {
        int r = it;
        if (r < NE * I_GU1) { const int e = r / I_GU1; p0_transpose_item(F.in[I_WGU] + (size_t)e * DM * 2 * DE, DM, 2 * DE, (bf16_t*)(F.ws + WS_WGU) + (size_t)e * 2 * DE * DM, true, scr, r % I_GU1, F.lane); continue; } r -= NE * I_GU1;
        if (r < NE * I_D1) { const int e = r / I_D1; p0_transpose_item(F.in[I_WD] + (size_t)e * DE * DM, DE, DM, (bf16_t*)(F.ws + WS_WD) + (size_t)e * DM * DE, false, scr, r % I_D1, F.lane); continue; } r -= NE * I_D1;
        if (r < I_IN) { p0_transpose_item(F.in[I_WIN], DM, INW, (bf16_t*)(F.ws + WS_WIN), false, scr, r, F.lane); continue; } r -= I_IN;
        if (r < I_GLU) { p0_transpose_item(F.in[I_WGLU], SW, 2 * SW, (bf16_t*)(F.ws + WS_WGLU), true, scr, r, F.lane); continue; } r -= I_GLU;
        if (r < I_UP) { p0_transpose_item(F.in[I_WUA], 512, DM, (bf16_t*)(F.ws + WS_WUA), false, scr, r, F.lane); continue; } r -= I_UP;
        if (r < I_UP) { p0_transpose_item(F.in[I_WUS], 512, DM, (bf16_t*)(F.ws + WS_WUS), false, scr, r, F.lane); continue; } r -= I_UP;
        p0_transpose_item(F.in[I_WO], DM, DM, (bf16_t*)(F.ws + WS_WO), false, scr, r, F.lane);
    }
    __syncthreads();
}

__device__ __forceinline__ void ph_inproj_fast(const Frame& F) {
    pg8::Gemm g{(const bf16_t*)(F.ws + WS_H0), (const bf16_t*)(F.ws + WS_WIN), DM};
    pg8::StaticOrder S; S.init(T / 256, INW / 256, F.G, (int)blockIdx.x);
    EpiInProj E{(bf16_t*)(F.ws + WS_Q), (bf16_t*)(F.ws + WS_K), (bf16_t*)(F.ws + WS_V), (bf16_t*)(F.ws + WS_U), (bf16_t*)(F.ws + WS_GA), (bf16_t*)(F.ws + WS_GS), F.in[I_BGATE], (bf16_t*)(F.ws + WS_VT), F.lds + TOKL_OFF, (bf16_t*)(F.ws + WS_UG)};
    pg8::gemm_phase<EpiInProj, pg8::StaticOrder, false>(F.lds, g, S, E);
}
__device__ __forceinline__ void ph_glu_fast(const Frame& F) {
    pg8::Gemm g{(const bf16_t*)(F.ws + WS_GY), (const bf16_t*)(F.ws + WS_WGLU), SW};
    pg8::StaticOrder S; S.init(T / 256, 2 * SW / 256, F.G, (int)blockIdx.x);
    EpiGlu E{(bf16_t*)(F.ws + WS_SG)};
    pg8::gemm_phase<EpiGlu, pg8::StaticOrder, false>(F.lds, g, S, E);
}
__device__ __forceinline__ void ph_up_fast(const Frame& F, bool second) {
    pg8::Gemm g{(const bf16_t*)(F.ws + (second ? WS_SG : WS_AO)), (const bf16_t*)(F.ws + (second ? WS_WUS : WS_WUA)), 512};
    pg8::StaticOrder S; S.init(T / 256, DM / 256, F.G, (int)blockIdx.x);
    EpiUp E{(const bf16_t*)(F.ws + (second ? WS_GS : WS_GA)), (bf16_t*)(F.ws + WS_TMPB), (bf16_t*)(F.ws + WS_Y), second};
    pg8::gemm_phase<EpiUp, pg8::StaticOrder, false>(F.lds, g, S, E);
}
__device__ __forceinline__ void ph_wo_fast(const Frame& F) {
    pg8::Gemm g{(const bf16_t*)(F.ws + WS_Y), (const bf16_t*)(F.ws + WS_WO), DM};
    pg8::StaticOrder S; S.init(T / 256, DM / 256, F.G, (int)blockIdx.x);
    EpiWo E{(const bf16_t*)(F.ws + WS_H0), (float*)(F.ws + WS_R1)};
    pg8::gemm_phase<EpiWo, pg8::StaticOrder, false>(F.lds, g, S, E);
}
__device__ __forceinline__ void ph_moe1_fast(const Frame& F) {
    load_pstart(F);
    const LAS int* ps = (const LAS int*)(F.lds + PS_OFF); LAS unsigned* tokl = (LAS unsigned*)(F.lds + TOKL_OFF);
    MoeOrder S; S.so.init(__builtin_amdgcn_readfirstlane(ps[NE]) / 256, 2 * DE / 256, F.G, (int)blockIdx.x); S.ps = ps; S.tokl = tokl; S.bt_per_e = 2 * DE / 256;
    const int* TOK = (const int*)(F.ws + WS_TOK);
    pg8::Unit u;
    for (int i = 0; i < TOKL_UNITS; ++i) { if (!S.next(i, u)) break; if (F.tid < 256) tokl[i * 256 + F.tid] = (unsigned)TOK[u.pm * 256 + F.tid] * (unsigned)(DM * 2); }
    __syncthreads();
    pg8::Gemm g{(const bf16_t*)(F.ws + WS_H1), (const bf16_t*)(F.ws + WS_WGU), DM};
    EpiMoe1 E{F.in[I_BGU], (bf16_t*)(F.ws + WS_ACT)};
    pg8::gemm_phase<EpiMoe1, MoeOrder, true>(F.lds, g, S, E);
}
__device__ __forceinline__ void ph_moe2_fast(const Frame& F) {
    load_pstart(F);
    const LAS int* ps = (const LAS int*)(F.lds + PS_OFF);
    MoeOrder S; S.so.init(__builtin_amdgcn_readfirstlane(ps[NE]) / 256, DM / 256, F.G, (int)blockIdx.x); S.ps = ps; S.tokl = nullptr; S.bt_per_e = DM / 256;
    pg8::Gemm g{(const bf16_t*)(F.ws + WS_ACT), (const bf16_t*)(F.ws + WS_WD), DE};
    EpiMoe2 E{F.in[I_BD], (bf16_t*)(F.ws + WS_OUTS)};
    pg8::gemm_phase<EpiMoe2, MoeOrder, false>(F.lds, g, S, E);
}
__device__ __forceinline__ void ph_combine(const Frame& F) {
    const bf16_t* H1 = (const bf16_t*)(F.ws + WS_H1); const bf16_t* OUTS = (const bf16_t*)(F.ws + WS_OUTS);
    const int* DEST = (const int*)(F.ws + WS_DEST); const float* TOPG = (const float*)(F.ws + WS_TOPG);
    const int lane = F.lane;
    f32x4 gg[4], bb[4];
#pragma unroll
    for (int j = 0; j < 4; ++j) { gg[j] = ((const f32x4*)F.in[I_LN2G])[lane * 4 + j]; bb[j] = ((const f32x4*)F.in[I_LN2B])[lane * 4 + j]; }
    constexpr int TPW = 8;
    for (int m0 = F.gw * TPW; m0 < T; m0 += F.NGW * TPW) {
        int dsel = 0; float gsel = 0.f;
        if (lane < TPW * TOPK) { dsel = DEST[m0 * TOPK + lane]; gsel = TOPG[m0 * TOPK + lane]; }
        u32x4 rw[2][5][2];
#define CMB_LOAD(buf, i_) do { const int mi_ = m0 + (i_); \
            const u32x4* hp_ = (const u32x4*)(H1 + (size_t)mi_ * DM) + lane * 2; rw[buf][0][0] = hp_[0]; rw[buf][0][1] = hp_[1]; \
            _Pragma("unroll") for (int k = 0; k < TOPK; ++k) { const int d_ = __shfl(dsel, (i_) * TOPK + k); const u32x4* op_ = (const u32x4*)(OUTS + (size_t)d_ * DM) + lane * 2; rw[buf][1 + k][0] = op_[0]; rw[buf][1 + k][1] = op_[1]; } } while (0)
        CMB_LOAD(0, 0);
#pragma unroll
        for (int i = 0; i < TPW; ++i) {
            if (i + 1 < TPW) CMB_LOAD((i + 1) & 1, i + 1);
            float v[16];
#pragma unroll
            for (int q = 0; q < 2; ++q)
#pragma unroll
                for (int e = 0; e < 4; ++e) { const unsigned wv = rw[i & 1][0][q][e]; v[q * 8 + 2 * e] = bf2f(wv & 0xffffu) * ALPHA; v[q * 8 + 2 * e + 1] = bf2f(wv >> 16) * ALPHA; }
#pragma unroll
            for (int k = 0; k < TOPK; ++k) { const float gk = __shfl(gsel, i * TOPK + k);
#pragma unroll
                for (int q = 0; q < 2; ++q)
#pragma unroll
                    for (int e = 0; e < 4; ++e) { const unsigned wv = rw[i & 1][1 + k][q][e]; v[q * 8 + 2 * e] += bf2f(wv & 0xffffu) * gk; v[q * 8 + 2 * e + 1] += bf2f(wv >> 16) * gk; } }
            float s = 0.f;
#pragma unroll
            for (int j = 0; j < 16; ++j) s += v[j];
            const float mean = wave_sum(s) * (1.f / DM); float s2 = 0.f;
#pragma unroll
            for (int j = 0; j < 16; ++j) { v[j] -= mean; s2 += v[j] * v[j]; }
            const float rstd = 1.f / sqrtf(wave_sum(s2) * (1.f / DM) + LN_EPS);
            f32x4* o = (f32x4*)(F.out + (size_t)(m0 + i) * DM) + lane * 4;
#pragma unroll
            for (int j = 0; j < 4; ++j) o[j] = (f32x4){v[4 * j], v[4 * j + 1], v[4 * j + 2], v[4 * j + 3]} * rstd * gg[j] + bb[j];
        }
#undef CMB_LOAD
    }
}


constexpr int N_PHASES = 13;

__global__ void __launch_bounds__(NWAVES * 64, 2) mega_fwd(Args args) {
    extern __shared__ __attribute__((aligned(16))) unsigned char lds[];
    Frame F;
    F.lds = (LAS unsigned char*)lds;
    F.tid = threadIdx.x; F.lane = F.tid & 63; F.wave = __builtin_amdgcn_readfirstlane(F.tid >> 6);
    F.G = gridDim.x; F.gw = blockIdx.x * NWAVES + F.wave; F.NGW = F.G * NWAVES;
    F.in = args.in; F.out = args.out; F.ws = args.ws; F.ctl = (unsigned*)(args.ws + WS_CTL);
    volatile LAS unsigned* MISC = (volatile LAS unsigned*)(F.lds + MISC_OFF);
    for (int u = F.tid; u < 64; u += NWAVES * 64) MISC[u] = 0u;
    __syncthreads();
    const int lo = args.ph_lo, hi = args.ph_hi;
    XcdBarrier bar; bar.bar = F.ctl + CW_BAR; bar.x = 0; bar.st = nullptr;
    if (hi - lo > 1) bar = xcd_barrier_post(F.ctl + CW_BAR, MISC + 8);
#define IN(k) (lo <= (k) && (k) < hi)
#define SEAM(k) do { if (IN(k) && IN((k) + 1)) xcd_barrier(bar); } while (0)
#define PHASE(k, ...) if (IN(k)) { for (int rep_ = 0; rep_ < ((k) == REPEAT_PHASE ? REPEAT_N : 1); ++rep_) { if (rep_) xcd_barrier(bar); __VA_ARGS__ } } SEAM(k);
    PHASE(0, ph_ln_in(F); ph_convert(F); ph_ssm_tables(F); ph_router_tables(F);)
    PHASE(1, ph_inproj_fast(F);)
    PHASE(2, for (int u = blockIdx.x; u < BATCH * NG * 4; u += F.G) ph_ssm_xe(F, u); ph_attn_fast_b(F, blockIdx.x);)
    PHASE(3, ph_ssm_out2(F);)
    PHASE(4, ph_glu_fast(F);)
    PHASE(5, ph_up_fast(F, false); asm volatile("s_waitcnt vmcnt(0)" ::: "memory"); __syncthreads(); ph_up_fast(F, true);)
    PHASE(7, ph_wo_fast(F);)
    PHASE(8, ph_router(F);)
    PHASE(9, ph_dest2(F);)
    PHASE(10, ph_moe1_fast(F);)
    PHASE(11, ph_moe2_fast(F);)
    PHASE(12, ph_combine(F);)
#undef PHASE
#undef IN
#undef SEAM
}

extern "C" void kernel_launch(void* const* d_in, const int* in_sizes, int n_in, void* d_out, int out_size, void* d_ws, size_t ws_size, hipStream_t stream) {
    static int grid = 0;
    if (grid == 0) {
        if (n_in != 28 || out_size != T * DM || ws_size < WS_END) { fprintf(stderr, "kernel_launch: unexpected shapes (n_in %d out %d ws %zu)\n", n_in, out_size, ws_size); grid = -1; return; }
        int dev = 0, cus = 0;
        if (hipGetDevice(&dev) != hipSuccess || hipDeviceGetAttribute(&cus, hipDeviceAttributeMultiprocessorCount, dev) != hipSuccess) { grid = -1; return; }
        if (hipFuncSetAttribute((const void*)mega_fwd, hipFuncAttributeMaxDynamicSharedMemorySize, LDS_BYTES) != hipSuccess) { fprintf(stderr, "kernel_launch: hipFuncSetAttribute failed\n"); grid = -1; return; }
        grid = cus;
    }
    if (grid < 0) return;
    (void)hipMemsetAsync((char*)d_ws + WS_CTL, 0, CTL_ZERO_BYTES, stream);
    Args a{};
    for (int i = 0; i < 28; ++i) a.in[i] = (const float*)d_in[i];
    a.out = (float*)d_out; a.ws = (unsigned char*)d_ws;
#if MK_ONE_LAUNCH
    a.ph_lo = 0; a.ph_hi = N_PHASES;
    hipLaunchKernelGGL(mega_fwd, dim3(grid), dim3(NWAVES * 64), LDS_BYTES, stream, a);
#else
    for (int p = 0; p < N_PHASES; ++p) { a.ph_lo = p; a.ph_hi = p + 1; hipLaunchKernelGGL(mega_fwd, dim3(grid), dim3(NWAVES * 64), LDS_BYTES, stream, a); }
#endif
}
```

```cpp
#include <hip/hip_runtime.h>
#include <cstdio>
#include <cstdint>

#ifndef FAST_INPROJ
#define FAST_INPROJ 1
#endif
#ifndef FAST_MID
#define FAST_MID 1
#endif
#ifndef FAST_MOE1
#define FAST_MOE1 1
#endif
#ifndef PROBE_TS
#define PROBE_TS (-1)
#endif
#ifndef PROBE_SCALE
#define PROBE_SCALE 4.0e-6f
#endif
#ifndef REPEAT_PHASE
#define REPEAT_PHASE (-1)
#endif
#ifndef REPEAT_N
#define REPEAT_N 3
#endif
#ifndef FAST_SSM
#define FAST_SSM 1
#endif
#ifndef FAST_ATTN
#define FAST_ATTN 1
#endif
#ifndef FAST_MOE2
#define FAST_MOE2 1
#endif
#define FAST_ANY (FAST_INPROJ || FAST_MID || FAST_MOE1 || FAST_MOE2)
#ifndef MK_ONE_LAUNCH
#define MK_ONE_LAUNCH 1
#endif

#define GAS __attribute__((address_space(1)))
#define LAS __attribute__((address_space(3)))
typedef unsigned short bf16_t;
typedef short bf16x8 __attribute__((ext_vector_type(8)));
typedef float f32x4 __attribute__((ext_vector_type(4)));
typedef unsigned u32x4 __attribute__((ext_vector_type(4)));
typedef unsigned u32x2 __attribute__((ext_vector_type(2)));

constexpr int BATCH = 2, SEQ = 8192, T = BATCH * SEQ, DM = 1024;
constexpr int CHUNK = 64, LEFT = 8, NCH = SEQ / CHUNK;
constexpr int NH = 8, HD = 64, AW = 512, RELMAX = 256, RELSIZE = 320;
constexpr int SW = 512, GSZ = 16, NG = 32, NP = 64;
constexpr int INW = 4096;
constexpr int NE = 32, TOPK = 4, DE = 1024, EB = 256;
constexpr int NASSIGN = T * TOPK;
constexpr int NROWS = NASSIGN + NE * EB;
constexpr float LN_EPS = 1e-5f;
constexpr float ALPHA = 1.189207115002721f;
constexpr float SWIGLU_LIMIT = 7.0f, SWIGLU_ALPHA = 1.702f;
constexpr int NWAVES = 8;
constexpr float LOG2E = 1.4426950408889634f, QSCALE = 0.125f * LOG2E;
constexpr int LDS_BYTES = 147456;
constexpr int CTL_LDS = 133120;
constexpr int MISC_OFF = CTL_LDS + 320, PS_OFF = CTL_LDS + 1024, TOKL_OFF = CTL_LDS + 2048, TOKL_UNITS = 10;

constexpr size_t MiB = 1u << 20;
constexpr size_t WS_CTL = 0, CTL_ZERO_BYTES = 1 * MiB;
constexpr size_t WS_H0 = 1 * MiB;
constexpr size_t WS_Q = 33 * MiB;
constexpr size_t WS_K = 49 * MiB;
constexpr size_t WS_V = 65 * MiB;
constexpr size_t WS_U = 81 * MiB;
constexpr size_t WS_GA = 97 * MiB;
constexpr size_t WS_GS = 129 * MiB;
constexpr size_t WS_AO = 161 * MiB;
constexpr size_t WS_GY = 177 * MiB;
constexpr size_t WS_SG = 193 * MiB;
constexpr size_t WS_Y = 209 * MiB;
constexpr size_t WS_R1 = 241 * MiB;
constexpr size_t WS_H1 = 305 * MiB;
constexpr size_t WS_TOPI = 338 * MiB;
constexpr size_t WS_TOPG = 339 * MiB;
constexpr size_t WS_DEST = 340 * MiB;
constexpr size_t WS_TOK = 341 * MiB;
constexpr size_t WS_ACT = 342 * MiB;
constexpr size_t WS_OUTS = 486 * MiB;
constexpr size_t WS_WIN = 630 * MiB;
constexpr size_t WS_WGLU = 638 * MiB;
constexpr size_t WS_WUA = 639 * MiB;
constexpr size_t WS_WUS = 640 * MiB;
constexpr size_t WS_WO = 641 * MiB;
constexpr size_t WS_WGU = 643 * MiB;
constexpr size_t WS_WD = 771 * MiB;
constexpr size_t WS_TMPB = WS_R1;
constexpr size_t WS_VT = 835 * MiB;
constexpr size_t WS_LP = 851 * MiB;
constexpr size_t WS_LLP = 853 * MiB;
constexpr size_t WS_WST = 855 * MiB;
constexpr size_t WS_KDT = 863 * MiB;
constexpr size_t WS_CINT = 864 * MiB;
constexpr size_t WS_XSL = 865 * MiB;
constexpr size_t WS_UEND = 869 * MiB;
constexpr size_t WS_GWP = 870 * MiB;
constexpr size_t WS_RC = 871 * MiB;
constexpr size_t WS_HIST = 872 * MiB;
constexpr size_t WS_LRANK = 873 * MiB;
constexpr size_t WS_UG = 874 * MiB;
constexpr size_t WS_END = 890 * MiB;
constexpr int CW_COUNTS = 64, CW_CURSOR = 128;
constexpr int CW_BAR = 4096;

__device__ __forceinline__ unsigned f2bf(float f) { unsigned u = __float_as_uint(f); return (u + 0x7fffu + ((u >> 16) & 1u)) >> 16; }
__device__ __forceinline__ float bf2f(unsigned h) { return __uint_as_float(h << 16); }
__device__ __forceinline__ unsigned pk2(float lo, float hi) { return f2bf(lo) | (f2bf(hi) << 16); }
__device__ __forceinline__ float wave_sum(float v) {
#pragma unroll
    for (int o = 1; o < 64; o <<= 1) v += __shfl_xor(v, o);
    return v;
}
__device__ __forceinline__ float sigmoid_f(float x) { return __builtin_amdgcn_rcpf(1.f + __builtin_amdgcn_exp2f(-1.4426950408889634f * x)); }
__device__ __forceinline__ float gelu_tanh(float x) { const float z = 0.7978845608028654f * (x + 0.044715f * x * x * x); return x * sigmoid_f(2.f * z); }

__device__ __forceinline__ void sincos_d(double x, double& s, double& c) {
    const double kd = rint(x * 0.63661977236758134308);
    const int k = (int)kd;
    double r = fma(-kd, 1.57079632679489655800e+00, x);
    r = fma(-kd, 6.12323399573676603587e-17, r);
    const double r2 = r * r;
    double sp = -1.0 / 1307674368000.0;
    sp = sp * r2 + 1.0 / 6227020800.0; sp = sp * r2 - 1.0 / 39916800.0; sp = sp * r2 + 1.0 / 362880.0; sp = sp * r2 - 1.0 / 5040.0; sp = sp * r2 + 1.0 / 120.0; sp = sp * r2 - 1.0 / 6.0;
    sp = r + r * r2 * sp;
    double cp = -1.0 / 87178291200.0;
    cp = cp * r2 + 1.0 / 479001600.0; cp = cp * r2 - 1.0 / 3628800.0; cp = cp * r2 + 1.0 / 40320.0; cp = cp * r2 - 1.0 / 720.0; cp = cp * r2 + 1.0 / 24.0; cp = cp * r2 - 0.5;
    cp = 1.0 + r2 * cp;
    const int q = k & 3;
    s = (q == 0) ? sp : (q == 1) ? cp : (q == 2) ? -sp : -cp;
    c = (q == 0) ? cp : (q == 1) ? -sp : (q == 2) ? -cp : sp;
}

#define XB_TMO      128
#define XB_XCNT(j)  (256  + 64 * (j))
#define XB_XSUB(j)  (1280 + 64 * (j))
#define XB_XGEN(j)  (2304 + 64 * (j))
#define XB_TOP      3328
#define XB_TOPGEN   3392
#define XCD_BAR_WORDS 3456
#define XB_SPIN_CAP (1u << 22)
__device__ __forceinline__ unsigned xb_ld(unsigned* p)              { return __hip_atomic_load(p, __ATOMIC_RELAXED, __HIP_MEMORY_SCOPE_AGENT); }
__device__ __forceinline__ unsigned xb_add(unsigned* p, unsigned v) { return __hip_atomic_fetch_add(p, v, __ATOMIC_RELAXED, __HIP_MEMORY_SCOPE_AGENT); }
__device__ __forceinline__ unsigned xb_xcc_id() { return (unsigned)__builtin_amdgcn_s_getreg((3 << 11) | 20) & 0xFu; }
#define XB_SPIN(cond, bar) do { unsigned _sp = 0; while (cond) { __builtin_amdgcn_s_sleep(1); \
    if ((++_sp & 255u) == 0u) { if (xb_ld(&(bar)[XB_TMO])) break; if (_sp > XB_SPIN_CAP) { atomicAdd(&(bar)[XB_TMO], 1u); break; } } } } while (0)
struct XcdBarrier { unsigned* bar; unsigned x; volatile LAS unsigned* st; };
__device__ __forceinline__ XcdBarrier xcd_barrier_post(unsigned* bar, volatile LAS unsigned* st) {
    XcdBarrier b; b.bar = bar; b.x = xb_xcc_id(); b.st = st;
    if (threadIdx.x == 0) (void)xb_add(&bar[XB_XCNT(b.x)], 1u);
    return b;
}
__device__ __forceinline__ void xcd_barrier_complete(unsigned* bar, unsigned x, unsigned& nloc, unsigned& nx) {
    const unsigned G = gridDim.x * gridDim.y * gridDim.z;
    unsigned sum, cnt, mine, sp = 0u;
    for (;;) {
        sum = 0u; cnt = 0u; mine = 0u;
#pragma unroll
        for (unsigned j = 0; j < 16; ++j) { const unsigned c = xb_ld(&bar[XB_XCNT(j)]); sum += c; cnt += (c > 0u) ? 1u : 0u; mine = (j == x) ? c : mine; }
        if (sum == G) break;
        __builtin_amdgcn_s_sleep(1);
        if ((++sp & 255u) == 0u) { if (xb_ld(&bar[XB_TMO])) break; if (sp > XB_SPIN_CAP) { atomicAdd(&bar[XB_TMO], 1u); break; } }
    }
    nloc = mine > 0u ? mine : 1u; nx = cnt > 0u ? cnt : 1u;
}
__device__ __forceinline__ void xcd_barrier(const XcdBarrier& b) {
    asm volatile("s_waitcnt vmcnt(0)" ::: "memory");
    __syncthreads();
    if (threadIdx.x == 0) {
        unsigned* bar = b.bar;
        __builtin_amdgcn_s_waitcnt(0);
        unsigned nloc = b.st[0], nx = b.st[1];
        if (nloc == 0u) { xcd_barrier_complete(bar, b.x, nloc, nx); b.st[0] = nloc; b.st[1] = nx; }
        const unsigned old = xb_add(&bar[XB_XSUB(b.x)], 1u);
        const unsigned gen = old / nloc;
        if (old + 1u == (gen + 1u) * nloc) {
            __builtin_amdgcn_fence(__ATOMIC_RELEASE, "agent");
            asm volatile("s_waitcnt vmcnt(0)" ::: "memory");
            const unsigned og = xb_add(&bar[XB_TOP], 1u);
            const unsigned tg = og / nx;
            if (og + 1u == (tg + 1u) * nx) xb_add(&bar[XB_TOPGEN], 1u);
            else XB_SPIN(xb_ld(&bar[XB_TOPGEN]) == tg, bar);
            __builtin_amdgcn_fence(__ATOMIC_ACQUIRE, "agent");
            xb_add(&bar[XB_XGEN(b.x)], 1u);
            asm volatile("s_waitcnt vmcnt(0)" ::: "memory");
        } else {
            XB_SPIN(xb_ld(&bar[XB_XGEN(b.x)]) == gen, bar);
            __builtin_amdgcn_fence(__ATOMIC_ACQUIRE, "agent");
            asm volatile("s_waitcnt vmcnt(0)" ::: "memory");
        }
    }
    __syncthreads();
}


namespace pg8 {
#define PG8_LAS __attribute__((address_space(3)))
constexpr int BM = 256, BK = 64, HALF = 128, HTB = HALF * BK * 2, STAGE_BYTES = 8 * HTB, NXCD = 8, WGM = 8;
__host__ __device__ __forceinline__ int lds_byte(int r, int c) { const int st = (r >> 4) * 2 + (c >> 5), rr = r & 15, cc = c & 31, ob = rr * 64 + cc * 2; return st * 1024 + (ob ^ (((ob >> 9) & 1) << 5)); }
__host__ __device__ __forceinline__ void stage_rc(int b, int& R, int& C) { const int st = b / 1024, sb = b % 1024, swz = sb ^ (((sb >> 9) & 1) << 5); R = (st >> 1) * 16 + swz / 64; C = (st & 1) * 32 + (swz % 64) / 2; }
__host__ __device__ __forceinline__ int perm32(int rho) { const int n = rho >> 4, i = rho & 15; return 8 * (i >> 2) + 4 * n + (i & 3); }
struct Unit { int pm, pn, bn, ex; };
struct Gemm { const bf16_t* A; const bf16_t* Bt; int K; };
struct StaticOrder {
    int nM, nN, nwg, G, c;
    __device__ void init(int nM_, int nN_, int G_, int c_) { nM = nM_; nN = nN_; nwg = nM * nN; G = G_; c = c_; }
    __device__ bool next(int i, Unit& u) const {
        const long L = (long)i * G + c; if (L >= nwg) return false;
        int wgid = (int)L; { const int q = nwg / NXCD, r = nwg % NXCD, xcd = wgid % NXCD, off = wgid / NXCD; wgid = (xcd < r ? xcd * (q + 1) : r * (q + 1) + (xcd - r) * q) + off; }
        const int nig = WGM * nN, gid = wgid / nig, fm = gid * WGM, gsz = (nM - fm) < WGM ? (nM - fm) : WGM;
        u.pm = fm + ((wgid % nig) % gsz); u.pn = (wgid % nig) / gsz; u.bn = u.pn; u.ex = 0; return true;
    }
    __device__ __forceinline__ unsigned rowoff(int, int) const { return 0u; }
};
typedef float f32x2_t __attribute__((ext_vector_type(2))); typedef __bf16 bf16x2_t __attribute__((ext_vector_type(2)));
__device__ __forceinline__ unsigned cvt_pk_bf16(float lo, float hi) { const f32x2_t v = {lo, hi}; const bf16x2_t b = __builtin_convertvector(v, bf16x2_t); return __builtin_bit_cast(unsigned, b); }

template <class Epi, class Sched, bool GATHER>
__device__ __forceinline__ void gemm_phase(PG8_LAS unsigned char* lds, const Gemm g, const Sched& S, const Epi& E) {
    const int tid = threadIdx.x, wid = __builtin_amdgcn_readfirstlane(tid >> 6), lane = tid & 63, wr = wid >> 2, wc = wid & 3, fr = lane & 15, fq = lane >> 4;
    const int K = g.K, nt = K / BK;
    unsigned voffA0[2], voffA1[2], voffB[2];
#pragma unroll
    for (int i = 0; i < 2; ++i) { int R, C; stage_rc(tid * 16 + i * 8192, R, C); const int Rb = Epi::PERM ? ((R & ~31) + perm32(R & 31)) : R;
        voffA0[i] = (unsigned)(R * K + C) * 2u; voffA1[i] = voffA0[i] + (unsigned)(HALF * K * 2); voffB[i] = (unsigned)(Rb * K + C) * 2u; }
    const size_t kstep = (size_t)(BK * 2);
    const size_t hstep = (size_t)HALF * K * 2;
    const size_t tstep = 2 * hstep;
    const unsigned ldsw = (unsigned)wid * 1024u;
    const int aoff = lds_byte(wr * 64 + fr, fq * 8), boff = lds_byte(wc * 32 + fr, fq * 8);
#define PG8_SA(b, h) (((b) * 2 + (h)) * HTB)
#define PG8_SB(b, h) ((4 + (b) * 2 + (h)) * HTB)
#define PG8_STAGE(bufoff, gbase, voff) do { _Pragma("unroll") for (int _i = 0; _i < 2; ++_i) \
        __builtin_amdgcn_global_load_lds((const unsigned*)((const char*)(gbase) + (voff)[_i]), (PG8_LAS unsigned*)(lds + (bufoff) + ldsw + _i * 8192), 16, 0, 0); } while (0)
#define PG8_LDA(dst, b, h) do { _Pragma("unroll") for (int m = 0; m < 4; ++m) _Pragma("unroll") for (int k = 0; k < 2; ++k) dst[m][k] = *(const PG8_LAS bf16x8*)(lds + PG8_SA(b, h) + aoff + m * 2048 + k * 1024); } while (0)
#define PG8_LDB(dst, b, h) do { _Pragma("unroll") for (int n = 0; n < 2; ++n) _Pragma("unroll") for (int k = 0; k < 2; ++k) dst[n][k] = *(const PG8_LAS bf16x8*)(lds + PG8_SB(b, h) + boff + n * 2048 + k * 1024); } while (0)
#define PG8_MMA(ai, bj, At, Bt) do { __builtin_amdgcn_s_setprio(1); _Pragma("unroll") for (int m = 0; m < 4; ++m) _Pragma("unroll") for (int n = 0; n < 2; ++n) _Pragma("unroll") for (int k = 0; k < 2; ++k) \
        acc[ai][bj][m][n] = __builtin_amdgcn_mfma_f32_16x16x32_bf16(Bt[n][k], At[m][k], acc[ai][bj][m][n], 0, 0, 0); __builtin_amdgcn_s_setprio(0); } while (0)
#define PG8_WAIT_V(n) asm volatile("s_waitcnt vmcnt(" #n ")" ::: "memory")
#define PG8_WAIT_L(n) asm volatile("s_waitcnt lgkmcnt(" #n ")" ::: "memory")
#define PG8_BAR __builtin_amdgcn_s_barrier()
#define PG8_SCHED __builtin_amdgcn_sched_barrier(0)
#define PG8_GOFF(ui_) do { if constexpr (GATHER) { _Pragma("unroll") for (int _i = 0; _i < 2; ++_i) { int R_, C_; stage_rc(tid * 16 + _i * 8192, R_, C_); \
        voffA0[_i] = S.rowoff((ui_), R_) + (unsigned)(C_ * 2); voffA1[_i] = S.rowoff((ui_), HALF + R_) + (unsigned)(C_ * 2); } } } while (0)
    Unit cur, nxt; int ui = 0;
    if (!S.next(0, cur)) return;
    f32x4 acc[2][2][4][2];
#pragma unroll
    for (int a = 0; a < 2; ++a)
#pragma unroll
        for (int b = 0; b < 2; ++b)
#pragma unroll
            for (int m = 0; m < 4; ++m)
#pragma unroll
                for (int n = 0; n < 2; ++n) acc[a][b][m][n] = (f32x4){0.f, 0.f, 0.f, 0.f};
    bf16x8 At[4][2], B0[2][2], B1[2][2];
    PG8_GOFF(0);
    const char* cA = GATHER ? (const char*)g.A : (const char*)g.A + (size_t)cur.pm * tstep; const char* cB = (const char*)g.Bt + (size_t)cur.bn * tstep;
    PG8_STAGE(PG8_SB(0, 0), cB, voffB); PG8_STAGE(PG8_SB(0, 1), cB + hstep, voffB); PG8_STAGE(PG8_SA(0, 0), cA, voffA0); PG8_STAGE(PG8_SA(0, 1), cA, voffA1);
    if (wr == 1) PG8_BAR;
    PG8_WAIT_V(2); PG8_BAR;
    PG8_STAGE(PG8_SB(1, 0), cB + kstep, voffB); PG8_STAGE(PG8_SA(1, 0), cA + kstep, voffA0); PG8_STAGE(PG8_SB(1, 1), cB + hstep + kstep, voffB);
    PG8_WAIT_V(6); PG8_BAR;
    for (;;) {
        const bool has_next = S.next(ui + 1, nxt);
        const char* nA = GATHER ? (const char*)g.A : (has_next ? (const char*)g.A + (size_t)nxt.pm * tstep : cA);
        const char* nB = has_next ? (const char*)g.Bt + (size_t)nxt.bn * tstep : cB;
        for (int t = 0; t < nt; t += 2) {
            const bool last = (t == nt - 2);
            const char* a1 = cA + (size_t)(t + 1) * kstep;
            const char* a2 = last ? nA : cA + (size_t)(t + 2) * kstep; const char* b2 = last ? nB : cB + (size_t)(t + 2) * kstep;
            const char* a3 = a2 + kstep; const char* b3 = b2 + kstep;
            PG8_LDB(B0, 0, 0); PG8_LDB(B1, 0, 1); PG8_SCHED; PG8_LDA(At, 0, 0); PG8_STAGE(PG8_SA(1, 1), a1, voffA1);
            if (GATHER && last && has_next) { PG8_GOFF(ui + 1); }
            PG8_WAIT_V(8); PG8_WAIT_L(0); PG8_BAR; PG8_MMA(0, 0, At, B0); PG8_MMA(0, 1, At, B1); PG8_BAR; PG8_SCHED;
            PG8_LDA(At, 0, 1); PG8_STAGE(PG8_SB(0, 0), b2, voffB); PG8_STAGE(PG8_SB(0, 1), b2 + hstep, voffB); PG8_STAGE(PG8_SA(0, 0), a2, voffA0);
            PG8_WAIT_V(8); PG8_WAIT_L(0); PG8_BAR; PG8_MMA(1, 0, At, B0); PG8_MMA(1, 1, At, B1); PG8_BAR; PG8_SCHED;
            PG8_LDB(B0, 1, 0); PG8_LDB(B1, 1, 1); PG8_SCHED; PG8_LDA(At, 1, 0); PG8_STAGE(PG8_SA(0, 1), a2, voffA1);
            PG8_WAIT_V(8); PG8_WAIT_L(0); PG8_BAR; PG8_MMA(0, 0, At, B0); PG8_MMA(0, 1, At, B1); PG8_BAR; PG8_SCHED;
            PG8_LDA(At, 1, 1); PG8_STAGE(PG8_SB(1, 0), b3, voffB); PG8_STAGE(PG8_SB(1, 1), b3 + hstep, voffB); PG8_STAGE(PG8_SA(1, 0), a3, voffA0);
            PG8_WAIT_V(8); PG8_WAIT_L(0); PG8_BAR; PG8_MMA(1, 0, At, B0); PG8_MMA(1, 1, At, B1); PG8_BAR; PG8_SCHED;
        }
        if (wr == 0) PG8_BAR;
        E(acc, cur, wr, wc, fr, fq);
        if (!has_next) break;
#pragma unroll
        for (int a = 0; a < 2; ++a)
#pragma unroll
            for (int b = 0; b < 2; ++b)
#pragma unroll
                for (int m = 0; m < 4; ++m)
#pragma unroll
                    for (int n = 0; n < 2; ++n) acc[a][b][m][n] = (f32x4){0.f, 0.f, 0.f, 0.f};
        cur = nxt; cA = nA; cB = nB; ++ui;
        if (wr == 1) PG8_BAR;
    }
    PG8_WAIT_V(0);
    PG8_BAR;
#undef PG8_SA
#undef PG8_SB
#undef PG8_STAGE
#undef PG8_LDA
#undef PG8_LDB
#undef PG8_MMA
#undef PG8_WAIT_V
#undef PG8_WAIT_L
#undef PG8_BAR
#undef PG8_SCHED
#undef PG8_GOFF
}
}

struct Args {
    const float* in[28];
    float* out; unsigned char* ws;
    int ph_lo, ph_hi;
};
enum { I_X = 0, I_LNIG, I_LNIB, I_WIN, I_BGATE, I_RELB, I_LAMRE, I_LAMIM, I_LOGDT, I_BRE, I_BIM, I_CRE, I_CIM, I_SSMD, I_WGLU, I_WUA, I_WUS, I_WO,
       I_LN1G, I_LN1B, I_RW, I_RB, I_WGU, I_BGU, I_WD, I_BD, I_LN2G, I_LN2B };

struct Frame {
    LAS unsigned char* lds;
    int tid, lane, wave, G, gw, NGW;
    const float* const* in;
    float* out; unsigned char* ws;
    unsigned* ctl;
};

template <int PS> __device__ __forceinline__ int colbase(int tn, int wc) { return PS == 16 ? tn * 128 + wc * 32 : tn * 64 + wc * 16; }

template <int PS, class Cfg>
__device__ __forceinline__ void gemm_simple_tile(const Frame& F, const Cfg& c, int tm, int tn) {
    LAS bf16_t* As = (LAS bf16_t*)F.lds;
    LAS bf16_t* Bs = As + 128 * 40;
    const int tid = F.tid, lane = F.lane, w = F.wave, wr = w >> 2, wc = w & 3;
    f32x4 acc[4][2];
#pragma unroll
    for (int m = 0; m < 4; ++m)
#pragma unroll
        for (int n = 0; n < 2; ++n) acc[m][n] = (f32x4){0.f, 0.f, 0.f, 0.f};
    const int ar = tid >> 2, ak = (tid & 3) * 8;
    const bf16_t* ap = c.arow(tm * 128 + ar) + ak;
    const int bk = tid >> 4, bc = (tid & 15) * 8;
    const int pc = colbase<PS>(tn, bc >> 5) + ((bc >> 4) & 1) * PS + (bc & 15);
    const int ldb = c.ldb();
    const float* bp = c.bptr(tm) + (size_t)bk * ldb + pc;
    const int K = c.K();
    for (int k0 = 0; k0 < K; k0 += 32) {
        const u32x4 av = *(const u32x4*)(ap + k0);
        const f32x4 b0 = *(const f32x4*)(bp + (size_t)k0 * ldb), b1 = *(const f32x4*)(bp + (size_t)k0 * ldb + 4);
        __syncthreads();
        *(LAS u32x4*)(As + ar * 40 + ak) = av;
        Bs[(bc + 0) * 40 + bk] = (bf16_t)f2bf(b0[0]); Bs[(bc + 1) * 40 + bk] = (bf16_t)f2bf(b0[1]);
        Bs[(bc + 2) * 40 + bk] = (bf16_t)f2bf(b0[2]); Bs[(bc + 3) * 40 + bk] = (bf16_t)f2bf(b0[3]);
        Bs[(bc + 4) * 40 + bk] = (bf16_t)f2bf(b1[0]); Bs[(bc + 5) * 40 + bk] = (bf16_t)f2bf(b1[1]);
        Bs[(bc + 6) * 40 + bk] = (bf16_t)f2bf(b1[2]); Bs[(bc + 7) * 40 + bk] = (bf16_t)f2bf(b1[3]);
        __syncthreads();
        bf16x8 a[4], b[2];
#pragma unroll
        for (int m = 0; m < 4; ++m) a[m] = *(const LAS bf16x8*)(As + (wr * 64 + m * 16 + (lane & 15)) * 40 + (lane >> 4) * 8);
#pragma unroll
        for (int n = 0; n < 2; ++n) b[n] = *(const LAS bf16x8*)(Bs + (wc * 32 + n * 16 + (lane & 15)) * 40 + (lane >> 4) * 8);
#pragma unroll
        for (int m = 0; m < 4; ++m)
#pragma unroll
            for (int n = 0; n < 2; ++n) acc[m][n] = __builtin_amdgcn_mfma_f32_16x16x32_bf16(a[m], b[n], acc[m][n], 0, 0, 0);
    }
    const int col0 = colbase<PS>(tn, wc) + (lane & 15);
#pragma unroll
    for (int m = 0; m < 4; ++m)
#pragma unroll
        for (int r = 0; r < 4; ++r) {
            const int row = tm * 128 + wr * 64 + m * 16 + (lane >> 4) * 4 + r;
            c.epi(tm, row, col0, acc[m][0][r], acc[m][1][r]);
        }
    __syncthreads();
}


__device__ __forceinline__ void store8(bf16_t* p, const f32x4 v0, const f32x4 v1) {
    u32x4 w; w.x = pg8::cvt_pk_bf16(v0[0], v0[1]); w.y = pg8::cvt_pk_bf16(v0[2], v0[3]); w.z = pg8::cvt_pk_bf16(v1[0], v1[1]); w.w = pg8::cvt_pk_bf16(v1[2], v1[3]);
    *(u32x4*)p = w;
}
__device__ __forceinline__ void load8(const bf16_t* p, f32x4& v0, f32x4& v1) {
    const u32x4 w = *(const u32x4*)p;
    v0 = (f32x4){bf2f(w.x & 0xffffu), bf2f(w.x >> 16), bf2f(w.y & 0xffffu), bf2f(w.y >> 16)};
    v1 = (f32x4){bf2f(w.z & 0xffffu), bf2f(w.z >> 16), bf2f(w.w & 0xffffu), bf2f(w.w >> 16)};
}
__device__ __forceinline__ f32x4 sigmoid4(const f32x4 v) { return (f32x4){sigmoid_f(v[0]), sigmoid_f(v[1]), sigmoid_f(v[2]), sigmoid_f(v[3])}; }

struct EpiInProj {
    static constexpr bool PERM = true;
    bf16_t *Q, *Kb, *V, *U, *GA, *GS; const float* bgate; bf16_t* VT; LAS unsigned char* tl; bf16_t* UG;
    __device__ __forceinline__ void operator()(const f32x4 (&acc)[2][2][4][2], const pg8::Unit& u, int wr, int wc, int fr, int fq) const {
        const int pn = u.pn, row0 = u.pm * 256 + wr * 64 + fr, colin = wc * 32 + 8 * fq;
        bf16_t* base; int ld, cb; float sc = 1.f; const bool gate = pn >= 8;
        if (pn < 8) { base = pn < 2 ? Q : (pn < 4 ? Kb : (pn < 6 ? V : U)); ld = 512; cb = (pn & 1) * 256; if (pn < 2) sc = QSCALE; }
        else { base = pn < 12 ? GA : GS; ld = 1024; cb = (pn & 3) * 256; }
#pragma unroll
        for (int bj = 0; bj < 2; ++bj) {
            f32x4 b0 = (f32x4){0.f, 0.f, 0.f, 0.f}, b1 = b0;
            if (gate) { const float* bp = bgate + (pn - 8) * 256 + bj * 128 + colin; b0 = *(const f32x4*)bp; b1 = *(const f32x4*)(bp + 4); }
#pragma unroll
            for (int ai = 0; ai < 2; ++ai)
#pragma unroll
                for (int m = 0; m < 4; ++m) {
                    f32x4 v0 = acc[ai][bj][m][0], v1 = acc[ai][bj][m][1];
                    if (gate) { v0 = sigmoid4(v0 + b0); v1 = sigmoid4(v1 + b1); } else { v0 = v0 * sc; v1 = v1 * sc; }
                    if (pn == 6 || pn == 7) {
                        const int row = row0 + ai * 128 + m * 16, b = row / SEQ, tt = row % SEQ, ucol = cb + bj * 128 + colin;
                        store8(UG + (((size_t)(b * NG + (ucol >> 4)) * SEQ + tt) << 4) + (ucol & 8), v0, v1);
                    } else
                    store8(base + (size_t)(row0 + ai * 128 + m * 16) * ld + cb + bj * 128 + colin, v0, v1);
                    if (pn == 4 || pn == 5) {
                        LAS bf16_t* pl = (LAS bf16_t*)(tl + (wr * 4 + wc) * 1024);
                        const int pos = (fr & 3) | ((fr & 4) << 1) | ((fr & 8) >> 1);
#pragma unroll
                        for (int j = 0; j < 4; ++j) { pl[(8 * fq + j) * 16 + pos] = (bf16_t)f2bf(v0[j]); pl[(8 * fq + 4 + j) * 16 + pos] = (bf16_t)f2bf(v1[j]); }
                        asm volatile("s_waitcnt lgkmcnt(0)" ::: "memory");
                        const int lane = fq * 16 + fr;
                        const u32x4 w = *(const LAS u32x4*)(pl + (lane >> 1) * 16 + 8 * (lane & 1));
                        asm volatile("s_waitcnt lgkmcnt(0)" ::: "memory");
                        const int trow = u.pm * 256 + wr * 64 + ai * 128 + m * 16, b = trow / SEQ, tt0 = trow % SEQ;
                        const int d = cb + bj * 128 + wc * 32 + (lane >> 1);
                        *(u32x4*)(VT + ((size_t)(b * NH) * HD + d) * SEQ + tt0 + 8 * (lane & 1)) = w;
                    }
                }
        }
    }
};
struct EpiGlu {
    static constexpr bool PERM = true;
    bf16_t* SGo;
    __device__ __forceinline__ void operator()(const f32x4 (&acc)[2][2][4][2], const pg8::Unit& u, int wr, int wc, int fr, int fq) const {
        const int row0 = u.pm * 256 + wr * 64 + fr, col = u.pn * 128 + wc * 32 + 8 * fq;
#pragma unroll
        for (int ai = 0; ai < 2; ++ai)
#pragma unroll
            for (int m = 0; m < 4; ++m)
                store8(SGo + (size_t)(row0 + ai * 128 + m * 16) * SW + col, acc[ai][0][m][0] * sigmoid4(acc[ai][1][m][0]), acc[ai][0][m][1] * sigmoid4(acc[ai][1][m][1]));
    }
};
struct EpiUp {
    static constexpr bool PERM = true;
    const bf16_t* gate; bf16_t* tmp; bf16_t* Y; bool second;
    __device__ __forceinline__ void operator()(const f32x4 (&acc)[2][2][4][2], const pg8::Unit& u, int wr, int wc, int fr, int fq) const {
        const int row0 = u.pm * 256 + wr * 64 + fr, col0 = u.pn * 256 + wc * 32 + 8 * fq;
#pragma unroll
        for (int ai = 0; ai < 2; ++ai)
#pragma unroll
            for (int m = 0; m < 4; ++m)
#pragma unroll
                for (int bj = 0; bj < 2; ++bj) {
                    const size_t off = (size_t)(row0 + ai * 128 + m * 16) * DM + col0 + bj * 128;
                    f32x4 g0, g1; load8(gate + off, g0, g1);
                    f32x4 v0 = g0 * acc[ai][bj][m][0], v1 = g1 * acc[ai][bj][m][1];
                    if (second) { f32x4 t0, t1; load8(tmp + off, t0, t1); store8(Y + off, v0 + t0, v1 + t1); }
                    else store8(tmp + off, v0, v1);
                }
    }
};
struct EpiWo {
    static constexpr bool PERM = false;
    const bf16_t* H0; float* R1;
    __device__ __forceinline__ void operator()(const f32x4 (&acc)[2][2][4][2], const pg8::Unit& u, int wr, int wc, int fr, int fq) const {
        const int row0 = u.pm * 256 + wr * 64 + fr, col0 = u.pn * 256 + wc * 32 + 4 * fq;
#pragma unroll
        for (int ai = 0; ai < 2; ++ai)
#pragma unroll
            for (int m = 0; m < 4; ++m)
#pragma unroll
                for (int bj = 0; bj < 2; ++bj)
#pragma unroll
                    for (int n = 0; n < 2; ++n) {
                        const size_t off = (size_t)(row0 + ai * 128 + m * 16) * DM + col0 + bj * 128 + n * 16;
                        const u32x2 w = *(const u32x2*)(H0 + off);
                        const f32x4 h = (f32x4){bf2f(w.x & 0xffffu), bf2f(w.x >> 16), bf2f(w.y & 0xffffu), bf2f(w.y >> 16)};
                        *(f32x4*)(R1 + off) = h * ALPHA + acc[ai][bj][m][n];
                    }
    }
};
struct EpiMoe1 {
    static constexpr bool PERM = true;
    const float* bgu; bf16_t* ACT;
    __device__ __forceinline__ void operator()(const f32x4 (&acc)[2][2][4][2], const pg8::Unit& u, int wr, int wc, int fr, int fq) const {
        const int row0 = u.pm * 256 + wr * 64 + fr, col = u.pn * 128 + wc * 32 + 8 * fq;
        const float* bp = bgu + (size_t)u.ex * 2 * DE + col;
        const f32x4 bg0 = *(const f32x4*)bp, bg1 = *(const f32x4*)(bp + 4), bl0 = *(const f32x4*)(bp + DE), bl1 = *(const f32x4*)(bp + DE + 4);
#pragma unroll
        for (int ai = 0; ai < 2; ++ai)
#pragma unroll
            for (int m = 0; m < 4; ++m) {
                f32x4 o[2];
#pragma unroll
                for (int n = 0; n < 2; ++n) {
                    const f32x4 gv = acc[ai][0][m][n] + (n ? bg1 : bg0), lv = acc[ai][1][m][n] + (n ? bl1 : bl0);
#pragma unroll
                    for (int j = 0; j < 4; ++j) { const float gg = fminf(gv[j], SWIGLU_LIMIT), ll = fminf(fmaxf(lv[j], -SWIGLU_LIMIT), SWIGLU_LIMIT); o[n][j] = gg * sigmoid_f(SWIGLU_ALPHA * gg) * (ll + 1.f); }
                }
                store8(ACT + (size_t)(row0 + ai * 128 + m * 16) * DE + col, o[0], o[1]);
            }
    }
};
struct EpiMoe2 {
    static constexpr bool PERM = true;
    const float* bd; bf16_t* OUTS;
    __device__ __forceinline__ void operator()(const f32x4 (&acc)[2][2][4][2], const pg8::Unit& u, int wr, int wc, int fr, int fq) const {
        const int row0 = u.pm * 256 + wr * 64 + fr, col0 = u.pn * 256 + wc * 32 + 8 * fq;
#pragma unroll
        for (int bj = 0; bj < 2; ++bj) {
            const float* bp = bd + (size_t)u.ex * DM + col0 + bj * 128;
            const f32x4 b0 = *(const f32x4*)bp, b1 = *(const f32x4*)(bp + 4);
#pragma unroll
            for (int ai = 0; ai < 2; ++ai)
#pragma unroll
                for (int m = 0; m < 4; ++m)
                    store8(OUTS + (size_t)(row0 + ai * 128 + m * 16) * DM + col0 + bj * 128, acc[ai][bj][m][0] + b0, acc[ai][bj][m][1] + b1);
        }
    }
};
struct MoeOrder {
    pg8::StaticOrder so; const LAS int* ps; const LAS unsigned* tokl; int bt_per_e;
    __device__ __forceinline__ bool next(int i, pg8::Unit& u) const {
        if (!so.next(i, u)) return false;
        int e = 0; const int r0 = u.pm * 256;
#pragma unroll 1
        for (int k = 1; k < NE; ++k) e += (ps[k] <= r0) ? 1 : 0;
        e = __builtin_amdgcn_readfirstlane(e);
        u.ex = e; u.bn = e * bt_per_e + u.pn; return true;
    }
    __device__ __forceinline__ unsigned rowoff(int ui, int r) const { return tokl[ui * 256 + r]; }
};
__device__ __forceinline__ void ph_ln_in(const Frame& F) {
    const float* x = F.in[I_X]; const f32x4* g4 = (const f32x4*)F.in[I_LNIG]; const f32x4* b4 = (const f32x4*)F.in[I_LNIB];
    bf16_t* H0 = (bf16_t*)(F.ws + WS_H0);
    for (int m = F.gw; m < T; m += F.NGW) {
        const f32x4* xr = (const f32x4*)(x + (size_t)m * DM) + F.lane;
        f32x4 v[4]; float s = 0.f;
#pragma unroll
        for (int j = 0; j < 4; ++j) { v[j] = xr[64 * j]; s += (v[j][0] + v[j][1]) + (v[j][2] + v[j][3]); }
        const float mean = wave_sum(s) * (1.f / DM); float s2 = 0.f;
#pragma unroll
        for (int j = 0; j < 4; ++j) { v[j] = v[j] - mean; s2 += (v[j][0] * v[j][0] + v[j][1] * v[j][1]) + (v[j][2] * v[j][2] + v[j][3] * v[j][3]); }
        const float rstd = 1.f / sqrtf(wave_sum(s2) * (1.f / DM) + LN_EPS);
        u32x2* o = (u32x2*)(H0 + (size_t)m * DM) + F.lane;
#pragma unroll
        for (int j = 0; j < 4; ++j) { const f32x4 y = v[j] * rstd * g4[F.lane + 64 * j] + b4[F.lane + 64 * j]; u32x2 w; w.x = pk2(y[0], y[1]); w.y = pk2(y[2], y[3]); o[64 * j] = w; }
    }
}

struct CfgInProj {
    const bf16_t* H0; const float* W; const float* bgate; bf16_t *Q, *Kb, *V, *U, *GA, *GS;
    __device__ __forceinline__ const bf16_t* arow(int row) const { return H0 + (size_t)row * DM; }
    __device__ __forceinline__ const float* bptr(int) const { return W; }
    __device__ __forceinline__ int ldb() const { return INW; }
    __device__ __forceinline__ int K() const { return DM; }
    __device__ __forceinline__ void one(int row, int col, float v) const {
        if (col < 512) Q[(size_t)row * AW + col] = (bf16_t)f2bf(v * QSCALE);
        else if (col < 1024) Kb[(size_t)row * AW + col - 512] = (bf16_t)f2bf(v);
        else if (col < 1536) V[(size_t)row * AW + col - 1024] = (bf16_t)f2bf(v);
        else if (col < 2048) U[(size_t)row * SW + col - 1536] = (bf16_t)f2bf(v);
        else if (col < 3072) GA[(size_t)row * DM + col - 2048] = (bf16_t)f2bf(sigmoid_f(v + bgate[col - 2048]));
        else GS[(size_t)row * DM + col - 3072] = (bf16_t)f2bf(sigmoid_f(v + bgate[col - 2048]));
    }
    __device__ __forceinline__ void epi(int, int row, int col0, float v0, float v1) const { one(row, col0, v0); one(row, col0 + 16, v1); }
};
__device__ __forceinline__ void ph_inproj(const Frame& F) {
    CfgInProj c{(const bf16_t*)(F.ws + WS_H0), F.in[I_WIN], F.in[I_BGATE], (bf16_t*)(F.ws + WS_Q), (bf16_t*)(F.ws + WS_K), (bf16_t*)(F.ws + WS_V), (bf16_t*)(F.ws + WS_U),
                (bf16_t*)(F.ws + WS_GA), (bf16_t*)(F.ws + WS_GS)};
    constexpr int NTM = T / 128, NTN = INW / 128;
    for (int t = blockIdx.x; t < NTM * NTN; t += F.G) gemm_simple_tile<16>(F, c, t / NTN, t % NTN);
}

__device__ __forceinline__ void ph_attn_simple(const Frame& F) {
    const bf16_t* Q = (const bf16_t*)(F.ws + WS_Q); const bf16_t* Kb = (const bf16_t*)(F.ws + WS_K); const bf16_t* V = (const bf16_t*)(F.ws + WS_V);
    bf16_t* AO = (bf16_t*)(F.ws + WS_AO); const float* relb = F.in[I_RELB];
    const int lane = F.lane;
    for (int it = F.gw; it < T * NH; it += F.NGW) {
        const int m = it / NH, h = it % NH, b = m / SEQ, t = m % SEQ, n = t / CHUNK;
        const float q = bf2f(Q[(size_t)m * AW + h * HD + lane]);
        const int k0 = (n - LEFT) * CHUNK < 0 ? 0 : (n - LEFT) * CHUNK, k1 = n * CHUNK + CHUNK;
        float mx = -1e30f, l = 0.f, o = 0.f;
        for (int kp = k0; kp < k1; ++kp) {
            const size_t kr = (size_t)(b * SEQ + kp) * AW + h * HD + lane;
            float s = wave_sum(q * bf2f(Kb[kr]));
            int dist = t - kp; dist = dist < -(CHUNK - 1) ? -(CHUNK - 1) : (dist > RELMAX ? RELMAX : dist);
            s += relb[h * RELSIZE + dist + (CHUNK - 1)] * LOG2E;
            const float mn = fmaxf(mx, s), a = __builtin_amdgcn_exp2f(mx - mn), pp = __builtin_amdgcn_exp2f(s - mn);
            l = l * a + pp; o = o * a + pp * bf2f(V[kr]); mx = mn;
        }
        AO[(size_t)m * AW + h * HD + lane] = (bf16_t)f2bf(o / l);
    }
}

__device__ __forceinline__ void ph_ssm_simple(const Frame& F) {
    const bf16_t* U = (const bf16_t*)(F.ws + WS_U); bf16_t* GY = (bf16_t*)(F.ws + WS_GY);
    const int lane = F.lane;
    for (int it = F.gw; it < BATCH * NG; it += F.NGW) {
        const int b = it / NG, g = it % NG;
        const double lre = (double)F.in[I_LAMRE][g * NP + lane], lim = (double)F.in[I_LAMIM][g * NP + lane];
        const double dt = (double)expf(F.in[I_LOGDT][g]);
        const double er = (double)expf((float)(lre * dt));
        double sn, cs; sincos_d(lim * dt, sn, cs);
        const double lbr_d = er * cs, lbi_d = er * sn;
        const double nr = lbr_d - 1.0, ni = lbi_d, den = lre * lre + lim * lim;
        const double cr = (nr * lre + ni * lim) / den, ci = (ni * lre - nr * lim) / den;
        const float lbr = (float)lbr_d, lbi = (float)lbi_d;
        float Bre[GSZ], Bim[GSZ], Cre[GSZ], Cim[GSZ];
#pragma unroll
        for (int c = 0; c < GSZ; ++c) {
            const double br = (double)F.in[I_BRE][(g * NP + lane) * GSZ + c], bi = (double)F.in[I_BIM][(g * NP + lane) * GSZ + c];
            Bre[c] = (float)(cr * br - ci * bi); Bim[c] = (float)(cr * bi + ci * br);
            Cre[c] = F.in[I_CRE][(g * GSZ + c) * NP + lane]; Cim[c] = F.in[I_CIM][(g * GSZ + c) * NP + lane];
        }
        const float dsk = F.in[I_SSMD][g * GSZ + (lane & 15)];
        float xr = 0.f, xi = 0.f;
        for (int t = 0; t < SEQ; ++t) {
            const bf16_t* up = U + (size_t)(b * SEQ + t) * SW + g * GSZ;
            const u32x4 u0 = *(const u32x4*)up, u1 = *(const u32x4*)(up + 8);
            float u[GSZ];
#pragma unroll
            for (int i = 0; i < 4; ++i) { u[2 * i] = bf2f(u0[i] & 0xffffu); u[2 * i + 1] = bf2f(u0[i] >> 16); u[8 + 2 * i] = bf2f(u1[i] & 0xffffu); u[8 + 2 * i + 1] = bf2f(u1[i] >> 16); }
            float br = 0.f, bi = 0.f;
#pragma unroll
            for (int c = 0; c < GSZ; ++c) { br += Bre[c] * u[c]; bi += Bim[c] * u[c]; }
            const float nxr = lbr * xr - lbi * xi + br, nxi = lbr * xi + lbi * xr + bi; xr = nxr; xi = nxi;
            float yv = 0.f, uv = 0.f;
#pragma unroll
            for (int c = 0; c < GSZ; ++c) { const float part = wave_sum(Cre[c] * xr - Cim[c] * xi); if ((lane & 15) == c) { yv = part; uv = u[c]; } }
            yv += dsk * uv;
            if (lane < GSZ) GY[(size_t)(b * SEQ + t) * SW + g * GSZ + lane] = (bf16_t)f2bf(gelu_tanh(yv));
        }
    }
}


typedef float f32x16 __attribute__((ext_vector_type(16)));
__device__ __forceinline__ void ph_attn_fast_b(const Frame& F, int bid) {
    const bf16_t* Q = (const bf16_t*)(F.ws + WS_Q); const bf16_t* Kb = (const bf16_t*)(F.ws + WS_K); const bf16_t* VT = (const bf16_t*)(F.ws + WS_VT);
    bf16_t* AO = (bf16_t*)(F.ws + WS_AO);
    LAS float* bl = (LAS float*)(F.lds + TOKL_OFF);
    for (int i = F.tid; i < NH * RELSIZE; i += 512) bl[i] = F.in[I_RELB][i] * LOG2E;
    const int lane = F.lane, r32 = lane & 31, hi = lane >> 5, hl = F.wave >> 1, qb = F.wave & 1;
    const int srow = (F.tid >> 3) & 63, sq = F.tid & 7;
    const int sdst = srow * 128 + ((sq ^ ((srow >> 1) & 7)) * 16);
    int koff[2][4], voff[2][4];
#pragma unroll
    for (int blk = 0; blk < 2; ++blk)
#pragma unroll
        for (int x = 0; x < 4; ++x) { const int row = blk * 32 + r32, q = 2 * x + hi; koff[blk][x] = row * 128 + ((q ^ ((row >> 1) & 7)) * 16); voff[blk][x] = koff[blk][x]; }
    for (int unit = bid; unit < BATCH * NCH * 2; unit += F.G) {
        const int bn = unit >> 1, b = bn / NCH, n = bn % NCH, hh = unit & 1;
        const int h = hh * 4 + hl;
        const size_t qtok = (size_t)b * SEQ + n * CHUNK + qb * 32 + r32;
        bf16x8 qf[4];
#pragma unroll
        for (int ds = 0; ds < 4; ++ds) qf[ds] = *(const bf16x8*)(Q + qtok * AW + h * HD + ds * 16 + hi * 8);
        f32x16 o[2];
#pragma unroll
        for (int r = 0; r < 16; ++r) { o[0][r] = 0.f; o[1][r] = 0.f; }
        float mrun = -1.0e30f, lrun = 0.f;
        const LAS char* blh = (const LAS char*)(bl + h * RELSIZE);
        const int qpos = qb * 32 + r32;
        const int c0 = (n < LEFT ? n : LEFT);
        const bf16_t* ksrc = Kb + ((size_t)b * SEQ + srow) * AW + (hh * 4) * HD + sq * 8;
        const bf16_t* vsrc = VT + ((size_t)(b * NH + hh * 4) * HD + srow) * SEQ + sq * 8;
        u32x4 st[8];
#define ATT_LOAD(kc_) do { _Pragma("unroll") for (int i = 0; i < 4; ++i) { st[i] = *(const u32x4*)(ksrc + (size_t)(kc_) * CHUNK * AW + i * HD); st[4 + i] = *(const u32x4*)(vsrc + (size_t)(kc_) * CHUNK + (size_t)i * HD * SEQ); } } while (0)
#define ATT_STORE(buf_) do { _Pragma("unroll") for (int i = 0; i < 4; ++i) { *(LAS u32x4*)(F.lds + (buf_) * 65536 + i * 16384 + sdst) = st[i]; *(LAS u32x4*)(F.lds + (buf_) * 65536 + i * 16384 + 8192 + sdst) = st[4 + i]; } } while (0)
        __syncthreads();
        ATT_LOAD(n - c0); ATT_STORE(0);
        __syncthreads();
        int buf = 0;
        for (int c = c0; c >= 0; --c, buf ^= 1) {
            const int kc = n - c;
            if (c > 0) ATT_LOAD(kc + 1);
            const LAS unsigned char* kt = F.lds + buf * 65536 + hl * 16384; const LAS unsigned char* vt = kt + 8192;
            f32x16 s[2];
#pragma unroll
            for (int kb = 0; kb < 2; ++kb) {
#pragma unroll
                for (int r = 0; r < 16; ++r) s[kb][r] = 0.f;
#pragma unroll
                for (int ds = 0; ds < 4; ++ds) { const bf16x8 kf = *(const LAS bf16x8*)(kt + koff[kb][ds]); s[kb] = __builtin_amdgcn_mfma_f32_32x32x16_bf16(kf, qf[ds], s[kb], 0, 0, 0); }
            }
            if (c >= 5) { const float bc = *(const LAS float*)(blh + 319 * 4);
#pragma unroll
                for (int r = 0; r < 16; ++r) { s[0][r] += bc; s[1][r] += bc; } }
            else { const int base4 = (qpos + 64 * c + 63 - 4 * hi) * 4;
#pragma unroll
                for (int kb = 0; kb < 2; ++kb)
#pragma unroll
                    for (int r = 0; r < 16; ++r) { int off = base4 - 4 * (kb * 32 + (r & 3) + 8 * (r >> 2)); off = off < 319 * 4 ? off : 319 * 4; s[kb][r] += *(const LAS float*)(blh + off); } }
            float tm = fmaxf(s[0][0], s[1][0]);
#pragma unroll
            for (int r = 1; r < 16; ++r) tm = fmaxf(tm, fmaxf(s[0][r], s[1][r]));
            tm = fmaxf(tm, __shfl_xor(tm, 32));
            if (__any(tm > mrun + 8.f)) { const float mn = fmaxf(mrun, tm), f = __builtin_amdgcn_exp2f(mrun - mn); lrun *= f; mrun = mn;
#pragma unroll
                for (int r = 0; r < 16; ++r) { o[0][r] *= f; o[1][r] *= f; } }
            float ls = 0.f;
#pragma unroll
            for (int kb = 0; kb < 2; ++kb)
#pragma unroll
                for (int r = 0; r < 16; ++r) { const float p = __builtin_amdgcn_exp2f(s[kb][r] - mrun); ls += p; s[kb][r] = p; }
            lrun += ls;
#pragma unroll
            for (int kb = 0; kb < 2; ++kb)
#pragma unroll
                for (int s2 = 0; s2 < 2; ++s2) {
                    u32x4 pw; pw.x = pg8::cvt_pk_bf16(s[kb][8 * s2 + 0], s[kb][8 * s2 + 1]); pw.y = pg8::cvt_pk_bf16(s[kb][8 * s2 + 2], s[kb][8 * s2 + 3]);
                    pw.z = pg8::cvt_pk_bf16(s[kb][8 * s2 + 4], s[kb][8 * s2 + 5]); pw.w = pg8::cvt_pk_bf16(s[kb][8 * s2 + 6], s[kb][8 * s2 + 7]);
                    const bf16x8 pf = __builtin_bit_cast(bf16x8, pw);
                    const bf16x8 v0 = *(const LAS bf16x8*)(vt + voff[0][2 * kb + s2]), v1 = *(const LAS bf16x8*)(vt + voff[1][2 * kb + s2]);
                    o[0] = __builtin_amdgcn_mfma_f32_32x32x16_bf16(v0, pf, o[0], 0, 0, 0);
                    o[1] = __builtin_amdgcn_mfma_f32_32x32x16_bf16(v1, pf, o[1], 0, 0, 0);
                }
            if (c > 0) ATT_STORE(buf ^ 1);
            __syncthreads();
        }
#undef ATT_LOAD
#undef ATT_STORE
        lrun += __shfl_xor(lrun, 32);
        const float inv = 1.f / lrun;
        bf16_t* op = AO + qtok * AW + h * HD + 4 * hi;
#pragma unroll
        for (int db = 0; db < 2; ++db)
#pragma unroll
            for (int g4 = 0; g4 < 4; ++g4) { u32x2 w; w.x = pg8::cvt_pk_bf16(o[db][4 * g4] * inv, o[db][4 * g4 + 1] * inv); w.y = pg8::cvt_pk_bf16(o[db][4 * g4 + 2] * inv, o[db][4 * g4 + 3] * inv);
                *(u32x2*)(op + db * 32 + 8 * g4) = w; }
    }
    __syncthreads();
}

typedef float f32x2 __attribute__((ext_vector_type(2)));
__device__ __forceinline__ f32x2 cmul(f32x2 a, f32x2 b) { return (f32x2){a.x * b.x - a.y * b.y, a.x * b.y + a.y * b.x}; }
__device__ __forceinline__ void ssm_coef(const Frame& F, int g, int p, double& lre, double& lim, double& dt, double& cr, double& ci) {
    lre = (double)F.in[I_LAMRE][g * NP + p]; lim = (double)F.in[I_LAMIM][g * NP + p]; dt = (double)expf(F.in[I_LOGDT][g]);
    const double y = lre * dt;
    double em = 1.0, term = 1.0;
#pragma unroll
    for (int k = 1; k <= 14; ++k) { term = term * y / (double)k; em += term; }
    double sn, cs; sincos_d(lim * dt, sn, cs);
    const double nr = em * cs - 1.0, ni = em * sn, den = lre * lre + lim * lim;
    cr = (nr * lre + ni * lim) / den; ci = (ni * lre - nr * lim) / den;
}
__device__ __forceinline__ f32x2 lam_pow(double lre, double lim, double dt, double k) {
    const float mag = expf((float)(lre * dt * k)); double sn, cs; sincos_d(lim * dt * k, sn, cs);
    return (f32x2){mag * (float)cs, mag * (float)sn};
}
__device__ __forceinline__ void ph_ssm_tables(const Frame& F) {
    f32x2* LP = (f32x2*)(F.ws + WS_LP); f32x2* LLP = (f32x2*)(F.ws + WS_LLP);
    bf16_t* WsT = (bf16_t*)(F.ws + WS_WST); bf16_t* KdT = (bf16_t*)(F.ws + WS_KDT); bf16_t* Cint = (bf16_t*)(F.ws + WS_CINT);
    const int gt = blockIdx.x * 512 + F.tid, NT = F.G * 512;
    for (int it = gt; it < NG * (65 + 128) * NP; it += NT) {
        const int p = it % NP, q = (it / NP) % (65 + 128), g = it / (NP * (65 + 128));
        const double lre = (double)F.in[I_LAMRE][g * NP + p], lim = (double)F.in[I_LAMIM][g * NP + p], dt = (double)expf(F.in[I_LOGDT][g]);
        if (q < 65) LP[(g * 65 + q) * NP + p] = lam_pow(lre, lim, dt, (double)q);
        else LLP[(g * 128 + (q - 65)) * NP + p] = lam_pow(lre, lim, dt, 64.0 * (double)(q - 65));
    }
    for (int it = gt; it < NG * GSZ * NP; it += NT) {
        const int p = it % NP, c = (it / NP) % GSZ, g = it / (NP * GSZ);
        ((unsigned*)Cint)[(g * GSZ + c) * NP + p] = pk2(F.in[I_CRE][(g * GSZ + c) * NP + p], -F.in[I_CIM][(g * GSZ + c) * NP + p]);
    }
    for (int it = gt; it < NG * NP * 64; it += NT) {
        const int j = it & 63, p = (it >> 6) % NP, g = it / (64 * NP);
        double lre, lim, dt, cr, ci; ssm_coef(F, g, p, lre, lim, dt, cr, ci);
        const f32x2 pw = lam_pow(lre, lim, dt, (double)(63 - j));
        const float crf = (float)cr, cif = (float)ci;
        bf16_t* o0 = WsT + ((size_t)(g * 128 + 2 * p) * 1024 + j * 16); bf16_t* o1 = o0 + 1024;
        const f32x4* br4 = (const f32x4*)(F.in[I_BRE] + (g * NP + p) * GSZ); const f32x4* bi4 = (const f32x4*)(F.in[I_BIM] + (g * NP + p) * GSZ);
#pragma unroll 1
        for (int c4 = 0; c4 < 4; ++c4) {
            const f32x4 br = br4[c4], bi = bi4[c4];
            float re[4], im[4];
#pragma unroll
            for (int k = 0; k < 4; ++k) { const f32x2 v = cmul(pw, (f32x2){crf * br[k] - cif * bi[k], crf * bi[k] + cif * br[k]}); re[k] = v.x; im[k] = v.y; }
            *(u32x2*)(o0 + c4 * 4) = (u32x2){pk2(re[0], re[1]), pk2(re[2], re[3])};
            *(u32x2*)(o1 + c4 * 4) = (u32x2){pk2(im[0], im[1]), pk2(im[2], im[3])};
        }
    }
    LAS f32x2* Ew = (LAS f32x2*)(F.lds + F.wave * 16384);
    for (int it = F.gw; it < NG * 64; it += F.NGW) {
        const int d = it & 63, g = it >> 6, p = F.lane;
        double lre, lim, dt, cr, ci; ssm_coef(F, g, p, lre, lim, dt, cr, ci);
        const f32x2 pw = lam_pow(lre, lim, dt, (double)d);
        { const float crf = (float)cr, cif = (float)ci;
#pragma unroll 4
          for (int c = 0; c < GSZ; ++c) {
            const float br = F.in[I_BRE][(g * NP + p) * GSZ + c], bi = F.in[I_BIM][(g * NP + p) * GSZ + c];
            Ew[p * GSZ + c] = cmul(pw, (f32x2){crf * br - cif * bi, crf * bi + cif * br});
          } }
        asm volatile("s_waitcnt lgkmcnt(0)" ::: "memory");
        const int c = F.lane >> 2, ci0 = (F.lane & 3) * 4;
        const float* cre = F.in[I_CRE] + (g * GSZ + c) * NP; const float* cim = F.in[I_CIM] + (g * GSZ + c) * NP;
        float acc[4] = {0.f, 0.f, 0.f, 0.f};
        for (int pp = 0; pp < NP; ++pp) {
            const float a = cre[pp], bq = cim[pp];
#pragma unroll
            for (int k = 0; k < 4; ++k) { const f32x2 e = Ew[pp * GSZ + ci0 + k]; acc[k] += a * e.x - bq * e.y; }
        }
        if (d == 0) {
#pragma unroll
            for (int k = 0; k < 4; ++k) if (ci0 + k == c) acc[k] += F.in[I_SSMD][g * GSZ + c];
        }
        *(u32x2*)(KdT + ((size_t)((g * 64 + d) * GSZ + c)) * GSZ + ci0) = (u32x2){pk2(acc[0], acc[1]), pk2(acc[2], acc[3])};
        asm volatile("s_waitcnt lgkmcnt(0)" ::: "memory");
    }
}
__device__ __forceinline__ void ph_ssm_xe(const Frame& F, int unit) {
    const int b = unit / (NG * 4), g = (unit >> 2) % NG, qtr = unit & 3, n0 = qtr * 32;
    const bf16_t* WsT = (const bf16_t*)(F.ws + WS_WST) + (size_t)g * 128 * 1024;
    const int lane = F.lane, w = F.wave, fr = lane & 15, fq = lane >> 4;
    const bf16_t* bp = WsT + (size_t)fr * 1024 + w * 128 + fq * 8;
    const bf16_t* ap = (const bf16_t*)(F.ws + WS_UG) + (((size_t)(b * NG + g) * SEQ + (size_t)(n0 + fr) * CHUNK + 8 * w + (fq >> 1)) << 4) + (fq & 1) * 8;
    bf16x8 af[4][2], bfr[4][8];
#pragma unroll
    for (int ksl = 0; ksl < 4; ++ksl) {
#pragma unroll
        for (int rb = 0; rb < 2; ++rb) af[ksl][rb] = *(const bf16x8*)(ap + (size_t)(rb * 16 * CHUNK + 2 * ksl) * 16);
#pragma unroll
        for (int cb = 0; cb < 8; ++cb) bfr[ksl][cb] = *(const bf16x8*)(bp + (size_t)cb * 16 * 1024 + ksl * 32);
    }
    f32x4 acc[2][8];
#pragma unroll
    for (int rb = 0; rb < 2; ++rb)
#pragma unroll
        for (int cb = 0; cb < 8; ++cb) acc[rb][cb] = (f32x4){0.f, 0.f, 0.f, 0.f};
#pragma unroll
    for (int ksl = 0; ksl < 4; ++ksl)
#pragma unroll
        for (int rb = 0; rb < 2; ++rb)
#pragma unroll
            for (int cb = 0; cb < 8; ++cb) acc[rb][cb] = __builtin_amdgcn_mfma_f32_16x16x32_bf16(af[ksl][rb], bfr[ksl][cb], acc[rb][cb], 0, 0, 0);
    LAS float* P = (LAS float*)F.lds;
    __syncthreads();
#pragma unroll
    for (int rb = 0; rb < 2; ++rb)
#pragma unroll
        for (int cb = 0; cb < 8; ++cb)
#pragma unroll
            for (int r = 0; r < 4; ++r) P[(w * 32 + rb * 16 + fq * 4 + r) * 128 + cb * 16 + fr] = acc[rb][cb][r];
    __syncthreads();
    float red[8];
#pragma unroll
    for (int i = 0; i < 8; ++i) { const int o = F.tid + 512 * i; float s = 0.f;
#pragma unroll
        for (int ww = 0; ww < 8; ++ww) s += P[ww * 4096 + o];
        red[i] = s; }
    __syncthreads();
#pragma unroll
    for (int i = 0; i < 8; ++i) P[F.tid + 512 * i] = red[i];
    __syncthreads();
    if (F.tid < NP) {
        const int p = F.tid;
        const f32x2 lamL = ((const f32x2*)(F.ws + WS_LP))[(g * 65 + 64) * NP + p];
        f32x2* XSL = (f32x2*)(F.ws + WS_XSL); f32x2* UEND = (f32x2*)(F.ws + WS_UEND);
        f32x2 s = (f32x2){0.f, 0.f};
        for (int i = 0; i < 32; ++i) {
            XSL[((size_t)(b * NCH + n0 + i) * NG + g) * NP + p] = s;
            const f32x2 xe = (f32x2){P[i * 128 + 2 * p], P[i * 128 + 2 * p + 1]};
            s = cmul(lamL, s) + xe;
        }
        UEND[((size_t)(b * 4 + qtr) * NG + g) * NP + p] = s;
    }
    __syncthreads();
}
__device__ __forceinline__ void ph_ssm_out(const Frame& F) {
    const bf16_t* U = (const bf16_t*)(F.ws + WS_U); bf16_t* GY = (bf16_t*)(F.ws + WS_GY);
    const f32x2* LP = (const f32x2*)(F.ws + WS_LP); const f32x2* LLP = (const f32x2*)(F.ws + WS_LLP);
    const bf16_t* KdT = (const bf16_t*)(F.ws + WS_KDT); const bf16_t* Cint = (const bf16_t*)(F.ws + WS_CINT);
    const f32x2* XSL = (const f32x2*)(F.ws + WS_XSL); const f32x2* UEND = (const f32x2*)(F.ws + WS_UEND);
    constexpr int USTR = 1040;
    LAS unsigned char* UL = F.lds; LAS f32x2* xsl = (LAS f32x2*)(F.lds + 64 * USTR) + F.wave * NP;
    const int lane = F.lane, w = F.wave, fr = lane & 15, fq = lane >> 4;
    for (int unit = blockIdx.x; unit < BATCH * NCH; unit += F.G) {
        const int b = unit / NCH, n = unit % NCH, qtr = n >> 5, ni = n & 31;
        __syncthreads();
        for (int idx = F.tid; idx < 64 * 64; idx += 512) { const int row = idx >> 6, c16 = idx & 63;
            *(LAS u32x4*)(UL + row * USTR + c16 * 16) = *(const u32x4*)(U + ((size_t)b * SEQ + n * CHUNK + row) * SW + c16 * 8); }
        __syncthreads();
#pragma unroll 1
        for (int gi = 0; gi < 4; ++gi) {
            const int g = gi * 8 + w;
            {
                f32x2 xs = XSL[((size_t)(b * NCH + n) * NG + g) * NP + lane];
                if (qtr > 0) { f32x2 carry = (f32x2){0.f, 0.f};
                    for (int q = 0; q < qtr; ++q) carry += cmul(LLP[(g * 128 + 32 * (qtr - 1 - q)) * NP + lane], UEND[((size_t)(b * 4 + q) * NG + g) * NP + lane]);
                    xs += cmul(LLP[(g * 128 + ni) * NP + lane], carry); }
                xsl[lane] = xs;
            }
            f32x4 acc[4];
#pragma unroll
            for (int rb = 0; rb < 4; ++rb) acc[rb] = (f32x4){0.f, 0.f, 0.f, 0.f};
#pragma unroll
            for (int ks = 0; ks < 4; ++ks) {
                const bf16x8 cf = *(const bf16x8*)(Cint + (size_t)(g * GSZ + fr) * 128 + ks * 32 + fq * 8);
                const LAS f32x4* xp = (const LAS f32x4*)(xsl + ks * 16 + 4 * fq);
                const f32x4 x01 = xp[0], x23 = xp[1];
#pragma unroll
                for (int rb = 0; rb < 4; ++rb) {
                    const f32x4* lp = (const f32x4*)(LP + (size_t)(g * 65 + rb * 16 + fr + 1) * NP + ks * 16 + 4 * fq);
                    const f32x4 l01 = lp[0], l23 = lp[1];
                    u32x4 zw;
                    zw.x = pg8::cvt_pk_bf16(l01[0] * x01[0] - l01[1] * x01[1], l01[0] * x01[1] + l01[1] * x01[0]);
                    zw.y = pg8::cvt_pk_bf16(l01[2] * x01[2] - l01[3] * x01[3], l01[2] * x01[3] + l01[3] * x01[2]);
                    zw.z = pg8::cvt_pk_bf16(l23[0] * x23[0] - l23[1] * x23[1], l23[0] * x23[1] + l23[1] * x23[0]);
                    zw.w = pg8::cvt_pk_bf16(l23[2] * x23[2] - l23[3] * x23[3], l23[2] * x23[3] + l23[3] * x23[2]);
                    acc[rb] = __builtin_amdgcn_mfma_f32_16x16x32_bf16(cf, __builtin_bit_cast(bf16x8, zw), acc[rb], 0, 0, 0);
                }
            }
#define SSM_LDKF(buf, kq_) do { _Pragma("unroll") for (int k8 = 0; k8 < 8; ++k8) kfb[buf][k8] = *(const bf16x8*)(KdT + ((size_t)((g * 64 + 2 * ((kq_) * 8 + k8) + (fq >> 1)) * GSZ + fr)) * GSZ + (fq & 1) * 8); } while (0)
            bf16x8 kfb[2][8];
            SSM_LDKF(0, 0);
            const LAS unsigned char* ub = UL + g * 32 + (fq & 1) * 16;
#pragma unroll
            for (int kq = 0; kq < 4; ++kq) {
                if (kq < 3) SSM_LDKF((kq + 1) & 1, kq + 1);
#pragma unroll
                for (int k8 = 0; k8 < 8; ++k8) {
                    const int ks = kq * 8 + k8;
                    const bf16x8 kf = kfb[kq & 1][k8];
#pragma unroll
                    for (int rb = kq; rb < 4; ++rb) {
                        const int src = rb * 16 + fr - 2 * ks - (fq >> 1);
                        bf16x8 af = *(const LAS bf16x8*)(ub + (src < 0 ? 0 : src) * USTR);
                        if (rb == kq) { if (src < 0) af = (bf16x8){0, 0, 0, 0, 0, 0, 0, 0}; }
                        acc[rb] = __builtin_amdgcn_mfma_f32_16x16x32_bf16(kf, af, acc[rb], 0, 0, 0);
                    }
                }
            }
#undef SSM_LDKF
#pragma unroll
            for (int rb = 0; rb < 4; ++rb) {
                u32x2 o; o.x = pg8::cvt_pk_bf16(gelu_tanh(acc[rb][0]), gelu_tanh(acc[rb][1])); o.y = pg8::cvt_pk_bf16(gelu_tanh(acc[rb][2]), gelu_tanh(acc[rb][3]));
                *(u32x2*)(GY + ((size_t)b * SEQ + n * CHUNK + rb * 16 + fr) * SW + g * GSZ + 4 * fq) = o;
            }
        }
    }
    __syncthreads();
}

__device__ __forceinline__ void ph_ssm_out2(const Frame& F) {
    const bf16_t* UG = (const bf16_t*)(F.ws + WS_UG); bf16_t* GY = (bf16_t*)(F.ws + WS_GY);
    const f32x2* LP = (const f32x2*)(F.ws + WS_LP); const f32x2* LLP = (const f32x2*)(F.ws + WS_LLP);
    const bf16_t* KdT = (const bf16_t*)(F.ws + WS_KDT); const bf16_t* Cint = (const bf16_t*)(F.ws + WS_CINT);
    const f32x2* XSL = (const f32x2*)(F.ws + WS_XSL); const f32x2* UEND = (const f32x2*)(F.ws + WS_UEND);
    constexpr int KDL = 0, LPL = 32768, LPS = 528, CIL = 66560, CIS = 272, WV = 71168, WVS = 2560;
    const int lane = F.lane, w = F.wave, fr = lane & 15, fq = lane >> 4;
    LAS unsigned char* usl = F.lds + WV + w * WVS; LAS f32x2* xsl = (LAS f32x2*)(usl + 2048);
    for (int vb = blockIdx.x; vb < 256; vb += F.G) {
        const int g = vb & 31, set = vb >> 5;
        __syncthreads();
#pragma unroll
        for (int i = 0; i < 4; ++i) { const int idx = F.tid + 512 * i;
            *(LAS u32x4*)(F.lds + KDL + idx * 16) = ((const u32x4*)(KdT + (size_t)g * 64 * 256))[idx];
            const int row = idx >> 5, pc = idx & 31;
            *(LAS u32x4*)(F.lds + LPL + row * LPS + pc * 16) = ((const u32x4*)(LP + (size_t)(g * 65 + row + 1) * NP))[pc]; }
        if (F.tid < 256) { const int row = F.tid >> 4, pc = F.tid & 15; *(LAS u32x4*)(F.lds + CIL + row * CIS + pc * 16) = ((const u32x4*)(Cint + (size_t)(g * GSZ + row) * 128))[pc]; }
        __syncthreads();
        const LAS unsigned char* kdl = F.lds + KDL + ((fq >> 1) * 16 + fr) * 32 + (fq & 1) * 16;
        bf16x8 kf[16];
#pragma unroll
        for (int ks = 0; ks < 16; ++ks) kf[ks] = *(const LAS bf16x8*)(kdl + ks * 1024);
        const int q0 = set * 32 + w * 4, b = q0 >> 7, nb = q0 & 127, qtr = nb >> 5;
        f32x2 carry = (f32x2){0.f, 0.f};
        for (int q = 0; q < qtr; ++q) carry += cmul(LLP[(g * 128 + 32 * (qtr - 1 - q)) * NP + lane], UEND[((size_t)(b * 4 + q) * NG + g) * NP + lane]);
        const u32x4* up = (const u32x4*)(UG + (((size_t)(b * NG + g) * SEQ + (size_t)nb * CHUNK) << 4)) + lane;
        u32x4 u0 = up[0], u1 = up[64];
        f32x2 xs0 = XSL[((size_t)(b * NCH + nb) * NG + g) * NP + lane]; f32x2 ll0 = LLP[(g * 128 + (nb & 31)) * NP + lane];
#pragma unroll 1
        for (int it = 0; it < 4; ++it) {
            const int n = nb + it;
            asm volatile("s_waitcnt lgkmcnt(0)" ::: "memory");
            *(LAS u32x4*)(usl + lane * 16) = u0; *(LAS u32x4*)(usl + 1024 + lane * 16) = u1;
            xsl[lane] = xs0 + cmul(ll0, carry);
            asm volatile("s_waitcnt lgkmcnt(0)" ::: "memory");
            if (it < 3) { u0 = up[(it + 1) * 128]; u1 = up[(it + 1) * 128 + 64];
                xs0 = XSL[((size_t)(b * NCH + n + 1) * NG + g) * NP + lane]; ll0 = LLP[(g * 128 + ((n + 1) & 31)) * NP + lane]; }
            f32x4 acc[4];
#pragma unroll
            for (int rb = 0; rb < 4; ++rb) acc[rb] = (f32x4){0.f, 0.f, 0.f, 0.f};
#pragma unroll
            for (int ks = 0; ks < 4; ++ks) {
                const LAS f32x4* xp = (const LAS f32x4*)(xsl + ks * 16 + 4 * fq);
                const f32x4 x01 = xp[0], x23 = xp[1];
                const bf16x8 cfk = *(const LAS bf16x8*)(F.lds + CIL + fr * CIS + ks * 64 + fq * 16);
#pragma unroll
                for (int rb = 0; rb < 4; ++rb) {
                    const LAS f32x4* lp = (const LAS f32x4*)(F.lds + LPL + (rb * 16 + fr) * LPS + (ks * 16 + 4 * fq) * 8);
                    const f32x4 l01 = lp[0], l23 = lp[1];
                    u32x4 zw;
                    zw.x = pg8::cvt_pk_bf16(l01[0] * x01[0] - l01[1] * x01[1], l01[0] * x01[1] + l01[1] * x01[0]);
                    zw.y = pg8::cvt_pk_bf16(l01[2] * x01[2] - l01[3] * x01[3], l01[2] * x01[3] + l01[3] * x01[2]);
                    zw.z = pg8::cvt_pk_bf16(l23[0] * x23[0] - l23[1] * x23[1], l23[0] * x23[1] + l23[1] * x23[0]);
                    zw.w = pg8::cvt_pk_bf16(l23[2] * x23[2] - l23[3] * x23[3], l23[2] * x23[3] + l23[3] * x23[2]);
                    acc[rb] = __builtin_amdgcn_mfma_f32_16x16x32_bf16(cfk, __builtin_bit_cast(bf16x8, zw), acc[rb], 0, 0, 0);
                }
            }
            const LAS unsigned char* ub = usl + (fq & 1) * 16;
#pragma unroll
            for (int m = 0; m < 32; ++m) {
                const int srcr = 48 + fr - 2 * m - (fq >> 1);
                bf16x8 af = *(const LAS bf16x8*)(ub + (srcr < 0 ? 0 : srcr) * 32);
                if (m >= 24) { if (srcr < 0) af = (bf16x8){0, 0, 0, 0, 0, 0, 0, 0}; }
#pragma unroll
                for (int rb = 0; rb < 4; ++rb) { const int ks = m - 8 * (3 - rb); if (ks >= 0) { const bf16x8 kk = ks < 16 ? kf[ks < 0 ? 0 : (ks & 15)] : *(const LAS bf16x8*)(kdl + ks * 1024); acc[rb] = __builtin_amdgcn_mfma_f32_16x16x32_bf16(kk, af, acc[rb], 0, 0, 0); } }
            }
#pragma unroll
            for (int rb = 0; rb < 4; ++rb) {
                u32x2 o; o.x = pg8::cvt_pk_bf16(gelu_tanh(acc[rb][0]), gelu_tanh(acc[rb][1])); o.y = pg8::cvt_pk_bf16(gelu_tanh(acc[rb][2]), gelu_tanh(acc[rb][3]));
                *(u32x2*)(GY + ((size_t)b * SEQ + n * CHUNK + rb * 16 + fr) * SW + g * GSZ + 4 * fq) = o;
            }
        }
    }
    __syncthreads();
}
struct CfgGlu {
    const bf16_t* GY; const float* W; bf16_t* SGo;
    __device__ __forceinline__ const bf16_t* arow(int row) const { return GY + (size_t)row * SW; }
    __device__ __forceinline__ const float* bptr(int) const { return W; }
    __device__ __forceinline__ int ldb() const { return 2 * SW; }
    __device__ __forceinline__ int K() const { return SW; }
    __device__ __forceinline__ void epi(int, int row, int col0, float v0, float v1) const { SGo[(size_t)row * SW + col0] = (bf16_t)f2bf(v0 * sigmoid_f(v1)); }
};
__device__ __forceinline__ void ph_glu(const Frame& F) {
    CfgGlu c{(const bf16_t*)(F.ws + WS_GY), F.in[I_WGLU], (bf16_t*)(F.ws + WS_SG)};
    constexpr int NTM = T / 128, NTN = SW / 64;
    for (int t = blockIdx.x; t < NTM * NTN; t += F.G) gemm_simple_tile<SW>(F, c, t / NTN, t % NTN);
}

struct CfgUp {
    const bf16_t* A; const float* W; const bf16_t* gate; float* tmp; bf16_t* Y; bool second;
    __device__ __forceinline__ const bf16_t* arow(int row) const { return A + (size_t)row * 512; }
    __device__ __forceinline__ const float* bptr(int) const { return W; }
    __device__ __forceinline__ int ldb() const { return DM; }
    __device__ __forceinline__ int K() const { return 512; }
    __device__ __forceinline__ void one(int row, int col, float v) const {
        const size_t i = (size_t)row * DM + col; const float gv = bf2f(gate[i]) * v;
        if (!second) tmp[i] = gv; else Y[i] = (bf16_t)f2bf(tmp[i] + gv);
    }
    __device__ __forceinline__ void epi(int, int row, int col0, float v0, float v1) const { one(row, col0, v0); one(row, col0 + 16, v1); }
};
__device__ __forceinline__ void ph_up(const Frame& F, bool second) {
    CfgUp c{(const bf16_t*)(F.ws + (second ? WS_SG : WS_AO)), F.in[second ? I_WUS : I_WUA], (const bf16_t*)(F.ws + (second ? WS_GS : WS_GA)), (float*)(F.ws + WS_R1), (bf16_t*)(F.ws + WS_Y), second};
    constexpr int NTM = T / 128, NTN = DM / 128;
    for (int t = blockIdx.x; t < NTM * NTN; t += F.G) gemm_simple_tile<16>(F, c, t / NTN, t % NTN);
}

struct CfgWo {
    const bf16_t* Y; const float* W; const bf16_t* H0; float* R1;
    __device__ __forceinline__ const bf16_t* arow(int row) const { return Y + (size_t)row * DM; }
    __device__ __forceinline__ const float* bptr(int) const { return W; }
    __device__ __forceinline__ int ldb() const { return DM; }
    __device__ __forceinline__ int K() const { return DM; }
    __device__ __forceinline__ void one(int row, int col, float v) const { const size_t i = (size_t)row * DM + col; R1[i] = ALPHA * bf2f(H0[i]) + v; }
    __device__ __forceinline__ void epi(int, int row, int col0, float v0, float v1) const { one(row, col0, v0); one(row, col0 + 16, v1); }
};
__device__ __forceinline__ void ph_wo(const Frame& F) {
    CfgWo c{(const bf16_t*)(F.ws + WS_Y), F.in[I_WO], (const bf16_t*)(F.ws + WS_H0), (float*)(F.ws + WS_R1)};
    constexpr int NTM = T / 128, NTN = DM / 128;
    for (int t = blockIdx.x; t < NTM * NTN; t += F.G) gemm_simple_tile<16>(F, c, t / NTN, t % NTN);
}

__device__ __forceinline__ void ph_ln1_router(const Frame& F, bool commit) {
    const float* R1 = (const float*)(F.ws + WS_R1); bf16_t* H1 = (bf16_t*)(F.ws + WS_H1);
    const f32x4* g4 = (const f32x4*)F.in[I_LN1G]; const f32x4* b4 = (const f32x4*)F.in[I_LN1B];
    const float* rw = F.in[I_RW]; const float* rb = F.in[I_RB];
    int* TOPI = (int*)(F.ws + WS_TOPI); float* TOPG = (float*)(F.ws + WS_TOPG); int* TOK = (int*)(F.ws + WS_TOK);
    const int lane = F.lane;
    for (int i = blockIdx.x * 512 + F.tid; i < NROWS; i += F.G * 512) TOK[i] = T;
    if (blockIdx.x == 0) { for (int i = F.tid; i < DM / 2; i += 512) ((unsigned*)(H1 + (size_t)T * DM))[i] = 0u; }
    for (int m = F.gw; m < T; m += F.NGW) {
        const f32x4* xr = (const f32x4*)(R1 + (size_t)m * DM) + lane;
        f32x4 v[4]; float s = 0.f;
#pragma unroll
        for (int j = 0; j < 4; ++j) { v[j] = xr[64 * j]; s += (v[j][0] + v[j][1]) + (v[j][2] + v[j][3]); }
        const float mean = wave_sum(s) * (1.f / DM); float s2 = 0.f;
#pragma unroll
        for (int j = 0; j < 4; ++j) { v[j] = v[j] - mean; s2 += (v[j][0] * v[j][0] + v[j][1] * v[j][1]) + (v[j][2] * v[j][2] + v[j][3] * v[j][3]); }
        const float rstd = 1.f / sqrtf(wave_sum(s2) * (1.f / DM) + LN_EPS);
        u32x2* o = (u32x2*)(H1 + (size_t)m * DM) + lane;
        float lg[NE];
#pragma unroll
        for (int e = 0; e < NE; ++e) lg[e] = 0.f;
#pragma unroll
        for (int j = 0; j < 4; ++j) {
            const f32x4 y = v[j] * rstd * g4[lane + 64 * j] + b4[lane + 64 * j];
            u32x2 w; w.x = pk2(y[0], y[1]); w.y = pk2(y[2], y[3]); o[64 * j] = w;
            const float* wj = rw + (size_t)(256 * j + 4 * lane) * NE;
            asm volatile("" : "+v"(wj));
#pragma unroll
            for (int i = 0; i < 4; ++i) {
                const f32x4* wr4 = (const f32x4*)(wj + i * NE);
#pragma unroll
                for (int q = 0; q < 8; ++q) { const f32x4 ww = wr4[q]; lg[4 * q] += y[i] * ww[0]; lg[4 * q + 1] += y[i] * ww[1]; lg[4 * q + 2] += y[i] * ww[2]; lg[4 * q + 3] += y[i] * ww[3]; }
                asm volatile("" ::: "memory");
            }
        }
        float r16[16], r8[8], r4[4], r2[2], r1;
        { const bool hb = (lane & 32) != 0;
#pragma unroll
          for (int i = 0; i < 16; ++i) { const float keep = hb ? lg[i + 16] : lg[i], send = hb ? lg[i] : lg[i + 16]; r16[i] = keep + __shfl_xor(send, 32); } }
        { const bool hb = (lane & 16) != 0;
#pragma unroll
          for (int i = 0; i < 8; ++i) { const float keep = hb ? r16[i + 8] : r16[i], send = hb ? r16[i] : r16[i + 8]; r8[i] = keep + __shfl_xor(send, 16); } }
        { const bool hb = (lane & 8) != 0;
#pragma unroll
          for (int i = 0; i < 4; ++i) { const float keep = hb ? r8[i + 4] : r8[i], send = hb ? r8[i] : r8[i + 4]; r4[i] = keep + __shfl_xor(send, 8); } }
        { const bool hb = (lane & 4) != 0;
#pragma unroll
          for (int i = 0; i < 2; ++i) { const float keep = hb ? r4[i + 2] : r4[i], send = hb ? r4[i] : r4[i + 2]; r2[i] = keep + __shfl_xor(send, 4); } }
        { const bool hb = (lane & 2) != 0; const float keep = hb ? r2[1] : r2[0], send = hb ? r2[0] : r2[1]; r1 = keep + __shfl_xor(send, 2); }
        r1 += __shfl_xor(r1, 1);
        const int mye = (lane >> 1) & 31;
        float myv = r1 + rb[mye];
        float tv[TOPK]; int ti[TOPK];
#pragma unroll
        for (int k = 0; k < TOPK; ++k) {
            float bv = myv; int bi = mye;
#pragma unroll
            for (int o = 1; o < 64; o <<= 1) { const float ov = __shfl_xor(bv, o); const int oi = __shfl_xor(bi, o); if (ov > bv || (ov == bv && oi < bi)) { bv = ov; bi = oi; } }
            tv[k] = bv; ti[k] = bi; if (mye == bi) myv = -3.0e38f;
        }
        const float e1 = __expf(tv[1] - tv[0]), e2 = __expf(tv[2] - tv[0]), e3 = __expf(tv[3] - tv[0]);
        const float inv = 1.f / (1.f + e1 + e2 + e3);
        if (lane == 0 && commit) {
            TOPI[m * 4 + 0] = ti[0]; TOPI[m * 4 + 1] = ti[1]; TOPI[m * 4 + 2] = ti[2]; TOPI[m * 4 + 3] = ti[3];
            TOPG[m * 4 + 0] = inv; TOPG[m * 4 + 1] = e1 * inv; TOPG[m * 4 + 2] = e2 * inv; TOPG[m * 4 + 3] = e3 * inv;
#pragma unroll
            for (int k = 0; k < TOPK; ++k) atomicAdd(F.ctl + CW_COUNTS + ti[k], 1u);
        }
    }
}


__device__ __forceinline__ void ph_router_tables(const Frame& F) {
    const float* g = F.in[I_LN1G]; const float* bb = F.in[I_LN1B]; const float* rw = F.in[I_RW]; const float* rb = F.in[I_RB];
    float* GWp = (float*)(F.ws + WS_GWP); float* RC = (float*)(F.ws + WS_RC);
    for (int idx = blockIdx.x * 512 + F.tid; idx < 128 * 2 * 32 * 4; idx += F.G * 512) {
        const int j = idx & 3, e = (idx >> 2) & 31, kpar = (idx >> 7) & 1, i = idx >> 8, k = 8 * i + 4 * kpar + j;
        GWp[idx] = g[k] * rw[k * NE + e];
    }
    if (blockIdx.x == (F.G > 1 ? 1 : 0)) {
        LAS float* red = (LAS float*)F.lds;
        const int e = F.tid & 31, pt = F.tid >> 5;
        float cs = 0.f, bw = 0.f;
#pragma unroll 8
        for (int i = 0; i < 64; ++i) { const int k = pt * 64 + i; const float w = rw[k * NE + e]; cs += g[k] * w; bw += bb[k] * w; }
        __syncthreads();
        red[F.tid] = cs; red[512 + F.tid] = bw;
        __syncthreads();
        if (F.tid < NE) { float a = 0.f, c = 0.f;
#pragma unroll
            for (int p = 0; p < 16; ++p) { a += red[p * 32 + F.tid]; c += red[512 + p * 32 + F.tid]; }
            RC[F.tid] = a; RC[NE + F.tid] = c + rb[F.tid]; }
        __syncthreads();
    }
}
typedef float f32x16r __attribute__((ext_vector_type(16)));
__device__ __forceinline__ void ph_router(const Frame& F) {
    const float* R1 = (const float*)(F.ws + WS_R1); bf16_t* H1 = (bf16_t*)(F.ws + WS_H1);
    const f32x4* g4 = (const f32x4*)F.in[I_LN1G]; const f32x4* b4 = (const f32x4*)F.in[I_LN1B];
    const float* GWp = (const float*)(F.ws + WS_GWP); const float* RC = (const float*)(F.ws + WS_RC);
    int* TOPI = (int*)(F.ws + WS_TOPI); float* TOPG = (float*)(F.ws + WS_TOPG); int* TOK = (int*)(F.ws + WS_TOK);
    int* HIST = (int*)(F.ws + WS_HIST); int* LRANK = (int*)(F.ws + WS_LRANK);
    LAS float* part = (LAS float*)F.lds;
    LAS float* stats = (LAS float*)(F.lds + 32768);
    const int lane = F.lane, w = F.wave;
    for (int i = blockIdx.x * 512 + F.tid; i < NROWS; i += F.G * 512) TOK[i] = T;
    if (blockIdx.x == 0) { for (int i = F.tid; i < DM / 2; i += 512) ((unsigned*)(H1 + (size_t)T * DM))[i] = 0u; }
    for (int tile = blockIdx.x; tile < T / 64; tile += F.G) {
        __syncthreads();
#pragma unroll 1
        for (int rr = 0; rr < 8; ++rr) {
            const int m = tile * 64 + rr * 8 + w;
            const f32x4* xr = (const f32x4*)(R1 + (size_t)m * DM) + lane;
            f32x4 v[4]; float s = 0.f;
#pragma unroll
            for (int j = 0; j < 4; ++j) { v[j] = xr[64 * j]; s += (v[j][0] + v[j][1]) + (v[j][2] + v[j][3]); }
            const float mean = wave_sum(s) * (1.f / DM); float s2 = 0.f;
#pragma unroll
            for (int j = 0; j < 4; ++j) { v[j] = v[j] - mean; s2 += (v[j][0] * v[j][0] + v[j][1] * v[j][1]) + (v[j][2] * v[j][2] + v[j][3] * v[j][3]); }
            const float rstd = 1.f / sqrtf(wave_sum(s2) * (1.f / DM) + LN_EPS);
            u32x2* o = (u32x2*)(H1 + (size_t)m * DM) + lane;
#pragma unroll
            for (int j = 0; j < 4; ++j) { const f32x4 y = v[j] * rstd * g4[lane + 64 * j] + b4[lane + 64 * j]; u32x2 ww; ww.x = pk2(y[0], y[1]); ww.y = pk2(y[2], y[3]); o[64 * j] = ww; }
            if (lane == 0) { stats[(rr * 8 + w) * 2] = mean; stats[(rr * 8 + w) * 2 + 1] = rstd; }
        }
        {
            const int mblk = w & 1, kq = w >> 1, r32 = lane & 31, kpar = lane >> 5;
            const float* ap = GWp + (size_t)((kq * 32) * 2 + kpar) * 128 + r32 * 4;
            const float* bp = R1 + (size_t)(tile * 64 + mblk * 32 + r32) * DM + kq * 256 + 4 * kpar;
            f32x16r acc;
#pragma unroll
            for (int r = 0; r < 16; ++r) acc[r] = 0.f;
#pragma unroll 4
            for (int i = 0; i < 32; ++i) {
                const f32x4 a4 = *(const f32x4*)(ap + i * 256), b4v = *(const f32x4*)(bp + i * 8);
#pragma unroll
                for (int j = 0; j < 4; ++j) acc = __builtin_amdgcn_mfma_f32_32x32x2f32(a4[j], b4v[j], acc, 0, 0, 0);
            }
#pragma unroll
            for (int r = 0; r < 16; ++r) part[((mblk * 4 + kq) * 32 + (r & 3) + 8 * (r >> 2) + 4 * kpar) * 32 + r32] = acc[r];
        }
        __syncthreads();
        if (w == 0) {
            const int mblk = lane >> 5, tl = lane & 31, m = tile * 64 + lane;
            const float mean = stats[lane * 2], rstd = stats[lane * 2 + 1];
            float lg[NE];
#pragma unroll
            for (int e = 0; e < NE; ++e) {
                const float raw = (part[((mblk * 4 + 0) * 32 + e) * 32 + tl] + part[((mblk * 4 + 1) * 32 + e) * 32 + tl]) + (part[((mblk * 4 + 2) * 32 + e) * 32 + tl] + part[((mblk * 4 + 3) * 32 + e) * 32 + tl]);
                lg[e] = rstd * (raw - mean * RC[e]) + RC[NE + e];
            }
            float tv[TOPK]; int ti[TOPK];
#pragma unroll
            for (int k = 0; k < TOPK; ++k) {
                float bv = -3.0e38f; int bi = 0;
#pragma unroll
                for (int e = 0; e < NE; ++e) if (lg[e] > bv) { bv = lg[e]; bi = e; }
                tv[k] = bv; ti[k] = bi;
#pragma unroll
                for (int e = 0; e < NE; ++e) if (e == bi) lg[e] = -3.0e38f;
            }
            const float e1 = __expf(tv[1] - tv[0]), e2 = __expf(tv[2] - tv[0]), e3 = __expf(tv[3] - tv[0]);
            const float inv = 1.f / (1.f + e1 + e2 + e3);
            int lr[TOPK] = {0, 0, 0, 0}; int mycnt = 0;
            const unsigned long long lt = (lane == 0) ? 0ull : (~0ull >> (64 - lane));
#pragma unroll 1
            for (int e = 0; e < NE; ++e) {
                int c = 0;
#pragma unroll
                for (int k = 0; k < TOPK; ++k) { const unsigned long long mk = __ballot(ti[k] == e); if (ti[k] == e) lr[k] = c + __popcll(mk & lt); c += __popcll(mk); }
                if (lane == e) mycnt = c;
            }
            *(int4*)(TOPI + m * 4) = make_int4(ti[0], ti[1], ti[2], ti[3]);
            *(float4*)(TOPG + m * 4) = make_float4(inv, e1 * inv, e2 * inv, e3 * inv);
            *(int4*)(LRANK + m * 4) = make_int4(lr[0], lr[1], lr[2], lr[3]);
            if (lane < NE) HIST[tile * NE + lane] = mycnt;
        }
    }
    __syncthreads();
}
__device__ __forceinline__ void ph_dest2(const Frame& F) {
    const int* HIST = (const int*)(F.ws + WS_HIST); const int* LRANK = (const int*)(F.ws + WS_LRANK); const int* TOPI = (const int*)(F.ws + WS_TOPI);
    int* DEST = (int*)(F.ws + WS_DEST); int* TOK = (int*)(F.ws + WS_TOK);
    LAS int* sumL = (LAS int*)F.lds; LAS int* ownL = sumL + 512; LAS int* totL = ownL + 512; LAS int* preL = totL + 32; LAS int* psL = preL + 32;
    constexpr int NTILE = T / 64;
    for (int tile = blockIdx.x; tile < NTILE; tile += F.G) {
        __syncthreads();
        { const int e = F.tid & 31, pt = F.tid >> 5; int s = 0, own = 0;
#pragma unroll 4
          for (int i = 0; i < NTILE / 16; ++i) { const int tt = pt * (NTILE / 16) + i; const int h = HIST[tt * NE + e]; s += h; own += (tt < tile) ? h : 0; }
          sumL[pt * 32 + e] = s; ownL[pt * 32 + e] = own; }
        __syncthreads();
        if (F.tid < 32) { int t = 0, p = 0;
#pragma unroll
            for (int pt = 0; pt < 16; ++pt) { t += sumL[pt * 32 + F.tid]; p += ownL[pt * 32 + F.tid]; }
            totL[F.tid] = t; preL[F.tid] = p; if (tile == 0) F.ctl[CW_COUNTS + F.tid] = (unsigned)t; }
        __syncthreads();
        if (F.tid == 0) { int acc = 0; for (int e = 0; e < NE; ++e) { psL[e] = acc; acc += ((totL[e] + EB - 1) / EB) * EB; } }
        __syncthreads();
        if (F.tid < 256) { const int a = tile * 256 + F.tid, e = TOPI[a], d = psL[e] + preL[e] + LRANK[a]; DEST[a] = d; TOK[d] = a >> 2; }
    }
    __syncthreads();
}
__device__ __forceinline__ void load_pstart(const Frame& F) {
    LAS int* ps = (LAS int*)(F.lds + PS_OFF);
    __syncthreads();
    if (F.tid == 0) { int acc = 0; for (int e = 0; e < NE; ++e) { ps[e] = acc; const int c = (int)__hip_atomic_load(F.ctl + CW_COUNTS + e, __ATOMIC_RELAXED, __HIP_MEMORY_SCOPE_AGENT); acc += ((c + EB - 1) / EB) * EB; } ps[NE] = acc; }
    __syncthreads();
}
__device__ __forceinline__ void ph_dest(const Frame& F) {
    load_pstart(F);
    const LAS int* ps = (const LAS int*)(F.lds + PS_OFF);
    const int* TOPI = (const int*)(F.ws + WS_TOPI); int* DEST = (int*)(F.ws + WS_DEST); int* TOK = (int*)(F.ws + WS_TOK);
    for (int a = blockIdx.x * 512 + F.tid; a < NASSIGN; a += F.G * 512) {
        const int e = TOPI[a]; const int pos = (int)atomicAdd(F.ctl + CW_CURSOR + e, 1u); const int d = ps[e] + pos;
        TOK[d] = a >> 2; DEST[a] = d;
    }
}

struct CfgMoe1 {
    const bf16_t* H1; const int* TOK; const float* W; const float* bgu; bf16_t* ACT; const LAS int* ps;
    __device__ __forceinline__ int expert(int tm) const { const int r0 = tm * 128; int e = 0;
#pragma unroll 1
        for (int i = 1; i < NE; ++i) e += (ps[i] <= r0) ? 1 : 0; return e; }
    __device__ __forceinline__ const bf16_t* arow(int row) const { return H1 + (size_t)TOK[row] * DM; }
    __device__ __forceinline__ const float* bptr(int tm) const { return W + (size_t)expert(tm) * DM * 2 * DE; }
    __device__ __forceinline__ int ldb() const { return 2 * DE; }
    __device__ __forceinline__ int K() const { return DM; }
    __device__ __forceinline__ void epi(int tm, int row, int col0, float v0, float v1) const {
        const int e = expert(tm);
        float g = v0 + bgu[e * 2 * DE + col0], l = v1 + bgu[e * 2 * DE + DE + col0];
        g = fminf(g, SWIGLU_LIMIT); l = fminf(fmaxf(l, -SWIGLU_LIMIT), SWIGLU_LIMIT);
        ACT[(size_t)row * DE + col0] = (bf16_t)f2bf(g * sigmoid_f(SWIGLU_ALPHA * g) * (l + 1.f));
    }
};
__device__ __forceinline__ void ph_moe1(const Frame& F) {
    load_pstart(F);
    const LAS int* ps = (const LAS int*)(F.lds + PS_OFF);
    CfgMoe1 c{(const bf16_t*)(F.ws + WS_H1), (const int*)(F.ws + WS_TOK), F.in[I_WGU], F.in[I_BGU], (bf16_t*)(F.ws + WS_ACT), ps};
    const int ntm = ps[NE] / 128; constexpr int NTN = DE / 64;
    for (int t = blockIdx.x; t < ntm * NTN; t += F.G) gemm_simple_tile<DE>(F, c, t / NTN, t % NTN);
}
struct CfgMoe2 {
    const bf16_t* ACT; const float* W; const float* bd; bf16_t* OUTS; const LAS int* ps;
    __device__ __forceinline__ int expert(int tm) const { const int r0 = tm * 128; int e = 0;
#pragma unroll 1
        for (int i = 1; i < NE; ++i) e += (ps[i] <= r0) ? 1 : 0; return e; }
    __device__ __forceinline__ const bf16_t* arow(int row) const { return ACT + (size_t)row * DE; }
    __device__ __forceinline__ const float* bptr(int tm) const { return W + (size_t)expert(tm) * DE * DM; }
    __device__ __forceinline__ int ldb() const { return DM; }
    __device__ __forceinline__ int K() const { return DE; }
    __device__ __forceinline__ void epi(int tm, int row, int col0, float v0, float v1) const {
        const int e = expert(tm);
        OUTS[(size_t)row * DM + col0] = (bf16_t)f2bf(v0 + bd[e * DM + col0]);
        OUTS[(size_t)row * DM + col0 + 16] = (bf16_t)f2bf(v1 + bd[e * DM + col0 + 16]);
    }
};
__device__ __forceinline__ void ph_moe2(const Frame& F) {
    load_pstart(F);
    const LAS int* ps = (const LAS int*)(F.lds + PS_OFF);
    CfgMoe2 c{(const bf16_t*)(F.ws + WS_ACT), F.in[I_WD], F.in[I_BD], (bf16_t*)(F.ws + WS_OUTS), ps};
    const int ntm = ps[NE] / 128; constexpr int NTN = DM / 128;
    for (int t = blockIdx.x; t < ntm * NTN; t += F.G) gemm_simple_tile<16>(F, c, t / NTN, t % NTN);
}


__device__ __forceinline__ void p0_transpose_item(const float* W, int K, int N, bf16_t* WT, bool paired, LAS float* scr, int item, int lane) {
    const int kblk = K / 64, nb = item / kblk, kb = item % kblk, k0 = 64 * kb, n0 = 64 * nb;
    int drow = n0;
    if (paired) { const int half = N >> 1, j = n0 % half; drow = (j >> 7) * 256 + (n0 / half) * 128 + (j & 127); }
    const float* wp = W + (size_t)(k0 + (lane >> 4)) * N + n0 + 4 * (lane & 15);
    LAS float* sp = scr + (lane >> 4) * 65 + 4 * (lane & 15);
#pragma unroll 8
    for (int i = 0; i < 16; ++i) { const f32x4 v = *(const f32x4*)(wp + (size_t)(4 * i) * N); sp[(4 * i) * 65] = v[0]; sp[(4 * i) * 65 + 1] = v[1]; sp[(4 * i) * 65 + 2] = v[2]; sp[(4 * i) * 65 + 3] = v[3]; }
    asm volatile("s_waitcnt lgkmcnt(0)" ::: "memory");
    const int c = lane & 7;
#pragma unroll
    for (int j = 0; j < 8; ++j) { const int n = (lane >> 3) + 8 * j; const LAS float* s = scr + (8 * c) * 65 + n;
        u32x4 o; o.x = pk2(s[0 * 65], s[1 * 65]); o.y = pk2(s[2 * 65], s[3 * 65]); o.z = pk2(s[4 * 65], s[5 * 65]); o.w = pk2(s[6 * 65], s[7 * 65]);
        *(u32x4*)(WT + (size_t)(drow + n) * K + k0 + 8 * c) = o; }
    asm volatile("s_waitcnt lgkmcnt(0)" ::: "memory");
}
__device__ __forceinline__ void ph_convert(const Frame& F) {
    LAS float* scr = (LAS float*)(F.lds + F.wave * 16640);
    constexpr int I_IN = (DM / 64) * (INW / 64), I_GLU = (SW / 64) * (2 * SW / 64), I_UP = (512 / 64) * (DM / 64), I_O = (DM / 64) * (DM / 64);
    constexpr int I_GU1 = (DM / 64) * (2 * DE / 64), I_D1 = (DE / 64) * (DM / 64);
    constexpr int NITEMS = I_IN + I_GLU + 2 * I_UP + I_O + NE * I_GU1 + NE * I_D1;
    for (int it = F.gw; it < NITEMS; it += F.NGW) {
        int r = it;
        if (r < NE * I_GU1) { const int e = r / I_GU1; p0_transpose_item(F.in[I_WGU] + (size_t)e * DM * 2 * DE, DM, 2 * DE, (bf16_t*)(F.ws + WS_WGU) + (size_t)e * 2 * DE * DM, true, scr, r % I_GU1, F.lane); continue; } r -= NE * I_GU1;
        if (r < NE * I_D1) { const int e = r / I_D1; p0_transpose_item(F.in[I_WD] + (size_t)e * DE * DM, DE, DM, (bf16_t*)(F.ws + WS_WD) + (size_t)e * DM * DE, false, scr, r % I_D1, F.lane); continue; } r -= NE * I_D1;
        if (r < I_IN) { p0_transpose_item(F.in[I_WIN], DM, INW, (bf16_t*)(F.ws + WS_WIN), false, scr, r, F.lane); continue; } r -= I_IN;
        if (r < I_GLU) { p0_transpose_item(F.in[I_WGLU], SW, 2 * SW, (bf16_t*)(F.ws + WS_WGLU), true, scr, r, F.lane); continue; } r -= I_GLU;
        if (r < I_UP) { p0_transpose_item(F.in[I_WUA], 512, DM, (bf16_t*)(F.ws + WS_WUA), false, scr, r, F.lane); continue; } r -= I_UP;
        if (r < I_UP) { p0_transpose_item(F.in[I_WUS], 512, DM, (bf16_t*)(F.ws + WS_WUS), false, scr, r, F.lane); continue; } r -= I_UP;
        p0_transpose_item(F.in[I_WO], DM, DM, (bf16_t*)(F.ws + WS_WO), false, scr, r, F.lane);
    }
    __syncthreads();
}

__device__ __forceinline__ void ph_inproj_fast(const Frame& F) {
    pg8::Gemm g{(const bf16_t*)(F.ws + WS_H0), (const bf16_t*)(F.ws + WS_WIN), DM};
    pg8::StaticOrder S; S.init(T / 256, INW / 256, F.G, (int)blockIdx.x);
    EpiInProj E{(bf16_t*)(F.ws + WS_Q), (bf16_t*)(F.ws + WS_K), (bf16_t*)(F.ws + WS_V), (bf16_t*)(F.ws + WS_U), (bf16_t*)(F.ws + WS_GA), (bf16_t*)(F.ws + WS_GS), F.in[I_BGATE], (bf16_t*)(F.ws + WS_VT), F.lds + TOKL_OFF, (bf16_t*)(F.ws + WS_UG)};
    pg8::gemm_phase<EpiInProj, pg8::StaticOrder, false>(F.lds, g, S, E);
}
__device__ __forceinline__ void ph_glu_fast(const Frame& F) {
    pg8::Gemm g{(const bf16_t*)(F.ws + WS_GY), (const bf16_t*)(F.ws + WS_WGLU), SW};
    pg8::StaticOrder S; S.init(T / 256, 2 * SW / 256, F.G, (int)blockIdx.x);
    EpiGlu E{(bf16_t*)(F.ws + WS_SG)};
    pg8::gemm_phase<EpiGlu, pg8::StaticOrder, false>(F.lds, g, S, E);
}
__device__ __forceinline__ void ph_up_fast(const Frame& F, bool second) {
    pg8::Gemm g{(const bf16_t*)(F.ws + (second ? WS_SG : WS_AO)), (const bf16_t*)(F.ws + (second ? WS_WUS : WS_WUA)), 512};
    pg8::StaticOrder S; S.init(T / 256, DM / 256, F.G, (int)blockIdx.x);
    EpiUp E{(const bf16_t*)(F.ws + (second ? WS_GS : WS_GA)), (bf16_t*)(F.ws + WS_TMPB), (bf16_t*)(F.ws + WS_Y), second};
    pg8::gemm_phase<EpiUp, pg8::StaticOrder, false>(F.lds, g, S, E);
}
__device__ __forceinline__ void ph_wo_fast(const Frame& F) {
    pg8::Gemm g{(const bf16_t*)(F.ws + WS_Y), (const bf16_t*)(F.ws + WS_WO), DM};
    pg8::StaticOrder S; S.init(T / 256, DM / 256, F.G, (int)blockIdx.x);
    EpiWo E{(const bf16_t*)(F.ws + WS_H0), (float*)(F.ws + WS_R1)};
    pg8::gemm_phase<EpiWo, pg8::StaticOrder, false>(F.lds, g, S, E);
}
__device__ __forceinline__ void ph_moe1_fast(const Frame& F) {
    load_pstart(F);
    const LAS int* ps = (const LAS int*)(F.lds + PS_OFF); LAS unsigned* tokl = (LAS unsigned*)(F.lds + TOKL_OFF);
    MoeOrder S; S.so.init(__builtin_amdgcn_readfirstlane(ps[NE]) / 256, 2 * DE / 256, F.G, (int)blockIdx.x); S.ps = ps; S.tokl = tokl; S.bt_per_e = 2 * DE / 256;
    const int* TOK = (const int*)(F.ws + WS_TOK);
    pg8::Unit u;
    for (int i = 0; i < TOKL_UNITS; ++i) { if (!S.next(i, u)) break; if (F.tid < 256) tokl[i * 256 + F.tid] = (unsigned)TOK[u.pm * 256 + F.tid] * (unsigned)(DM * 2); }
    __syncthreads();
    pg8::Gemm g{(const bf16_t*)(F.ws + WS_H1), (const bf16_t*)(F.ws + WS_WGU), DM};
    EpiMoe1 E{F.in[I_BGU], (bf16_t*)(F.ws + WS_ACT)};
    pg8::gemm_phase<EpiMoe1, MoeOrder, true>(F.lds, g, S, E);
}
__device__ __forceinline__ void ph_moe2_fast(const Frame& F) {
    load_pstart(F);
    const LAS int* ps = (const LAS int*)(F.lds + PS_OFF);
    MoeOrder S; S.so.init(__builtin_amdgcn_readfirstlane(ps[NE]) / 256, DM / 256, F.G, (int)blockIdx.x); S.ps = ps; S.tokl = nullptr; S.bt_per_e = DM / 256;
    pg8::Gemm g{(const bf16_t*)(F.ws + WS_ACT), (const bf16_t*)(F.ws + WS_WD), DE};
    EpiMoe2 E{F.in[I_BD], (bf16_t*)(F.ws + WS_OUTS)};
    pg8::gemm_phase<EpiMoe2, MoeOrder, false>(F.lds, g, S, E);
}
__device__ __forceinline__ void ph_combine(const Frame& F) {
    const bf16_t* H1 = (const bf16_t*)(F.ws + WS_H1); const bf16_t* OUTS = (const bf16_t*)(F.ws + WS_OUTS);
    const int* DEST = (const int*)(F.ws + WS_DEST); const float* TOPG = (const float*)(F.ws + WS_TOPG);
    const int lane = F.lane;
    f32x4 gg[4], bb[4];
#pragma unroll
    for (int j = 0; j < 4; ++j) { gg[j] = ((const f32x4*)F.in[I_LN2G])[lane * 4 + j]; bb[j] = ((const f32x4*)F.in[I_LN2B])[lane * 4 + j]; }
    constexpr int TPW = 8;
    for (int m0 = F.gw * TPW; m0 < T; m0 += F.NGW * TPW) {
        int dsel = 0; float gsel = 0.f;
        if (lane < TPW * TOPK) { dsel = DEST[m0 * TOPK + lane]; gsel = TOPG[m0 * TOPK + lane]; }
        u32x4 rw[2][5][2];
#define CMB_LOAD(buf, i_) do { const int mi_ = m0 + (i_); \
            const u32x4* hp_ = (const u32x4*)(H1 + (size_t)mi_ * DM) + lane * 2; rw[buf][0][0] = hp_[0]; rw[buf][0][1] = hp_[1]; \
            _Pragma("unroll") for (int k = 0; k < TOPK; ++k) { const int d_ = __shfl(dsel, (i_) * TOPK + k); const u32x4* op_ = (const u32x4*)(OUTS + (size_t)d_ * DM) + lane * 2; rw[buf][1 + k][0] = op_[0]; rw[buf][1 + k][1] = op_[1]; } } while (0)
        CMB_LOAD(0, 0);
#pragma unroll
        for (int i = 0; i < TPW; ++i) {
            if (i + 1 < TPW) CMB_LOAD((i + 1) & 1, i + 1);
            float v[16];
#pragma unroll
            for (int q = 0; q < 2; ++q)
#pragma unroll
                for (int e = 0; e < 4; ++e) { const unsigned wv = rw[i & 1][0][q][e]; v[q * 8 + 2 * e] = bf2f(wv & 0xffffu) * ALPHA; v[q * 8 + 2 * e + 1] = bf2f(wv >> 16) * ALPHA; }
#pragma unroll
            for (int k = 0; k < TOPK; ++k) { const float gk = __shfl(gsel, i * TOPK + k);
#pragma unroll
                for (int q = 0; q < 2; ++q)
#pragma unroll
                    for (int e = 0; e < 4; ++e) { const unsigned wv = rw[i & 1][1 + k][q][e]; v[q * 8 + 2 * e] += bf2f(wv & 0xffffu) * gk; v[q * 8 + 2 * e + 1] += bf2f(wv >> 16) * gk; } }
            float s = 0.f;
#pragma unroll
            for (int j = 0; j < 16; ++j) s += v[j];
            const float mean = wave_sum(s) * (1.f / DM); float s2 = 0.f;
#pragma unroll
            for (int j = 0; j < 16; ++j) { v[j] -= mean; s2 += v[j] * v[j]; }
            const float rstd = 1.f / sqrtf(wave_sum(s2) * (1.f / DM) + LN_EPS);
            f32x4* o = (f32x4*)(F.out + (size_t)(m0 + i) * DM) + lane * 4;
#pragma unroll
            for (int j = 0; j < 4; ++j) o[j] = (f32x4){v[4 * j], v[4 * j + 1], v[4 * j + 2], v[4 * j + 3]} * rstd * gg[j] + bb[j];
        }
#undef CMB_LOAD
    }
}


constexpr int N_PHASES = 13;

__global__ void __launch_bounds__(NWAVES * 64, 2) mega_fwd(Args args) {
    extern __shared__ __attribute__((aligned(16))) unsigned char lds[];
    Frame F;
    F.lds = (LAS unsigned char*)lds;
    F.tid = threadIdx.x; F.lane = F.tid & 63; F.wave = __builtin_amdgcn_readfirstlane(F.tid >> 6);
    F.G = gridDim.x; F.gw = blockIdx.x * NWAVES + F.wave; F.NGW = F.G * NWAVES;
    F.in = args.in; F.out = args.out; F.ws = args.ws; F.ctl = (unsigned*)(args.ws + WS_CTL);
    volatile LAS unsigned* MISC = (volatile LAS unsigned*)(F.lds + MISC_OFF);
    for (int u = F.tid; u < 64; u += NWAVES * 64) MISC[u] = 0u;
    __syncthreads();
    const int lo = args.ph_lo, hi = args.ph_hi;
    XcdBarrier bar; bar.bar = F.ctl + CW_BAR; bar.x = 0; bar.st = nullptr;
    if (hi - lo > 1) bar = xcd_barrier_post(F.ctl + CW_BAR, MISC + 8);
    unsigned long long ts0 = 0, ts1 = 0;
#define IN(k) (lo <= (k) && (k) < hi)
#define SEAM(k) do { if (IN(k) && IN((k) + 1)) xcd_barrier(bar); } while (0)
#define PHASE(k, ...) if (PROBE_TS >= 0 && blockIdx.x == 0 && F.tid == 0) { if ((k) == PROBE_TS) ts0 = __builtin_amdgcn_s_memrealtime(); if ((k) == PROBE_TS + 1) ts1 = __builtin_amdgcn_s_memrealtime(); } if (IN(k)) { for (int rep_ = 0; rep_ < ((k) == REPEAT_PHASE ? REPEAT_N : 1); ++rep_) { if (rep_) xcd_barrier(bar); __VA_ARGS__ } } SEAM(k);
    PHASE(0, ph_ln_in(F); ph_convert(F); ph_ssm_tables(F); ph_router_tables(F);)
    PHASE(1, ph_inproj_fast(F);)
    PHASE(2, for (int u = blockIdx.x; u < BATCH * NG * 4; u += F.G) ph_ssm_xe(F, u); ph_attn_fast_b(F, blockIdx.x);)
    PHASE(3, ph_ssm_out2(F);)
    PHASE(4, ph_glu_fast(F);)
    PHASE(5, ph_up_fast(F, false); asm volatile("s_waitcnt vmcnt(0)" ::: "memory"); __syncthreads(); ph_up_fast(F, true);)
    PHASE(7, ph_wo_fast(F);)
    PHASE(8, ph_router(F);)
    PHASE(9, ph_dest2(F);)
    PHASE(10, ph_moe1_fast(F);)
    PHASE(11, ph_moe2_fast(F);)
    PHASE(12, ph_combine(F);)
#undef PHASE
    if (PROBE_TS >= 0 && blockIdx.x == 0) {
        __syncthreads();
        LAS float* dsh = (LAS float*)(F.lds + MISC_OFF + 128);
        if (F.tid == 0) { if (ts1 == 0) ts1 = __builtin_amdgcn_s_memrealtime(); const float us = (float)(ts1 - ts0) * 0.01f; dsh[0] = sqrtf(PROBE_SCALE * us * (float)T); }
        __syncthreads();
        asm volatile("s_waitcnt vmcnt(0)" ::: "memory");
        const float dlt = dsh[0];
        for (int i = F.tid; i < DM; i += 512) F.out[i] += dlt;
    }
#undef IN
#undef SEAM
}

extern "C" void kernel_launch(void* const* d_in, const int* in_sizes, int n_in, void* d_out, int out_size, void* d_ws, size_t ws_size, hipStream_t stream) {
    static int grid = 0;
    if (grid == 0) {
        if (n_in != 28 || out_size != T * DM || ws_size < WS_END) { fprintf(stderr, "kernel_launch: unexpected shapes (n_in %d out %d ws %zu)\n", n_in, out_size, ws_size); grid = -1; return; }
        int dev = 0, cus = 0;
        if (hipGetDevice(&dev) != hipSuccess || hipDeviceGetAttribute(&cus, hipDeviceAttributeMultiprocessorCount, dev) != hipSuccess) { grid = -1; return; }
        if (hipFuncSetAttribute((const void*)mega_fwd, hipFuncAttributeMaxDynamicSharedMemorySize, LDS_BYTES) != hipSuccess) { fprintf(stderr, "kernel_launch: hipFuncSetAttribute failed\n"); grid = -1; return; }
        grid = cus;
    }
    if (grid < 0) return;
    (void)hipMemsetAsync((char*)d_ws + WS_CTL, 0, CTL_ZERO_BYTES, stream);
    Args a{};
    for (int i = 0; i < 28; ++i) a.in[i] = (const float*)d_in[i];
    a.out = (float*)d_out; a.ws = (unsigned char*)d_ws;
#if MK_ONE_LAUNCH
    a.ph_lo = 0; a.ph_hi = N_PHASES;
    hipLaunchKernelGGL(mega_fwd, dim3(grid), dim3(NWAVES * 64), LDS_BYTES, stream, a);
#else
    for (int p = 0; p < N_PHASES; ++p) { a.ph_lo = p; a.ph_hi = p + 1; hipLaunchKernelGGL(mega_fwd, dim3(grid), dim3(NWAVES * 64), LDS_BYTES, stream, a); }
#endif
}
```
